# Optimizing an MI355X kernel written in HIP

```python
import math
import jax, jax.numpy as jnp
from jax import lax
import numpy as np

D_MODEL = 1024
BATCH = 2
SEQ = 8192
DEPTH = 2

N_MEM = 256
EPS = 1e-6
MLA_HEADS = 8
MLA_Q_RANK = 384
MLA_KV_RANK = 256
MLA_NOPE = 64
MLA_ROPE = 32
MLA_V = 64
ROPE_BASE = 10000.0
Q_BLOCK = 128
HG_HEADS = 4
HG_KEY = 128
HG_VAL = 128
HG_CHUNK = 64
HG_KW = HG_HEADS * HG_KEY
HG_VW = HG_HEADS * HG_VAL
GM_GROUPS = 4
GM_GROUP_CH = 128
GM_CHUNK = 128
GM_WIDTH = GM_GROUPS * GM_GROUP_CH
X_HEADS = 4
X_HEAD_DIM = D_MODEL // X_HEADS
D_FF = -(-8 * D_MODEL // (3 * 256)) * 256
IN_SIZES = (MLA_Q_RANK, MLA_KV_RANK, MLA_ROPE,
            HG_KW, HG_KW, HG_VW, HG_VW,
            2 * GM_WIDTH,
            3 * D_MODEL)
IN_WIDTH = sum(IN_SIZES)

kernel_name = "hybrid_mla_hgrn2_gmlp_block"


def rms_norm(x, g):
    xf = x.astype(jnp.float32)
    y = xf * lax.rsqrt(jnp.mean(xf * xf, axis=-1, keepdims=True) + EPS)
    return (y * g.astype(jnp.float32)).astype(x.dtype)


def layer_norm(x, g, b):
    xf = x.astype(jnp.float32)
    mu = jnp.mean(xf, axis=-1, keepdims=True)
    var = jnp.mean(jnp.square(xf - mu), axis=-1, keepdims=True)
    y = (xf - mu) * lax.rsqrt(var + EPS)
    return (y * g.astype(jnp.float32) + b.astype(jnp.float32)).astype(x.dtype)


def split_sizes(z, sizes):
    out, start = [], 0
    for s in sizes:
        out.append(z[..., start:start + s])
        start += s
    return out


def apply_rope(x, cos, sin):
    xf = x.astype(jnp.float32)
    x1, x2 = jnp.split(xf, 2, axis=-1)
    y = jnp.concatenate([x1 * cos - x2 * sin, x1 * sin + x2 * cos], axis=-1)
    return y.astype(x.dtype)


def mla(c_q, c_kv, k_r, q_norm, w_uq, kv_norm, w_ukv, cos, sin):
    B, S, _ = c_q.shape
    q = (rms_norm(c_q, q_norm) @ w_uq).reshape(B, S, MLA_HEADS, MLA_NOPE + MLA_ROPE)
    q_nope, q_rope = q[..., :MLA_NOPE], q[..., MLA_NOPE:]
    q_rope = apply_rope(q_rope, cos[:, :, None, :], sin[:, :, None, :])
    kv = (rms_norm(c_kv, kv_norm) @ w_ukv).reshape(B, S, MLA_HEADS, MLA_NOPE + MLA_V)
    k_nope, v = kv[..., :MLA_NOPE], kv[..., MLA_NOPE:]
    k_rope = apply_rope(k_r, cos, sin)
    q = jnp.concatenate([q_nope, q_rope], axis=-1)
    k = jnp.concatenate([k_nope, jnp.broadcast_to(k_rope[:, :, None, :], (B, S, MLA_HEADS, MLA_ROPE))], axis=-1)
    scale = (MLA_NOPE + MLA_ROPE) ** -0.5
    nb = S // Q_BLOCK
    q_blocks = q.reshape(B, nb, Q_BLOCK, MLA_HEADS, MLA_NOPE + MLA_ROPE).transpose(1, 0, 2, 3, 4)
    key_idx = jnp.arange(S)

    def block(args):
        qb, bi = args
        s = jnp.einsum('bqhd,bkhd->bhqk', qb, k).astype(jnp.float32) * scale
        q_idx = bi * Q_BLOCK + jnp.arange(Q_BLOCK)
        mask = key_idx[None, :] <= q_idx[:, None]
        s = jnp.where(mask[None, None], s, jnp.finfo(jnp.float32).min)
        p = jax.nn.softmax(s, axis=-1).astype(v.dtype)
        return jnp.einsum('bhqk,bkhd->bqhd', p, v)

    o = lax.map(block, (q_blocks, jnp.arange(nb)))
    return o.transpose(1, 0, 2, 3, 4).reshape(B, S, MLA_HEADS * MLA_V)


def hgrn2(q_in, f_in, i_in, g_in, lb, head_norm):
    B, S, _ = q_in.shape
    dt = q_in.dtype
    f32 = jnp.float32
    lb = lb.reshape(HG_HEADS, HG_KEY).astype(f32)
    fr = f_in.reshape(B, S, HG_HEADS, HG_KEY).astype(f32)
    log_f = jnp.logaddexp(jnp.log(lb), jnp.log1p(-lb) + jax.nn.log_sigmoid(fr))
    k = (1.0 - lb) * jax.nn.sigmoid(-fr)
    q = jax.nn.silu(q_in.astype(f32)).reshape(B, S, HG_HEADS, HG_KEY)
    v = i_in.astype(f32).reshape(B, S, HG_HEADS, HG_VAL)
    nc = S // HG_CHUNK

    def to_chunks(t, d):
        return t.reshape(B, nc, HG_CHUNK, HG_HEADS, d).transpose(1, 0, 3, 2, 4)

    causal = jnp.tril(jnp.ones((HG_CHUNK, HG_CHUNK), dtype=bool))

    def step(state, xs):
        qc, kc, vc, lfc = xs
        b = jnp.cumsum(lfc, axis=2)
        o_inter = jnp.einsum('bhck,bhkv->bhcv', qc * jnp.exp(b), state)
        diff = b[:, :, :, None, :] - b[:, :, None, :, :]
        decay = jnp.exp(jnp.where(causal[None, None, :, :, None], diff, -jnp.inf))
        attn = jnp.einsum('bhtk,bhtsk,bhsk->bhts', qc, decay, kc)
        o = o_inter + jnp.einsum('bhts,bhsv->bhtv', attn, vc)
        b_last = b[:, :, -1:, :]
        new_state = jnp.exp(b_last[:, :, 0, :])[..., None] * state + \
            jnp.einsum('bhsk,bhsv->bhkv', kc * jnp.exp(b_last - b), vc)
        return new_state, o

    state0 = jnp.zeros((B, HG_HEADS, HG_KEY, HG_VAL), f32)
    _, o = lax.scan(step, state0, (to_chunks(q, HG_KEY), to_chunks(k, HG_KEY),
                                   to_chunks(v, HG_VAL), to_chunks(log_f, HG_KEY)))
    o = o.transpose(1, 0, 3, 2, 4).reshape(B, S, HG_HEADS, HG_VAL)
    g = g_in.astype(f32).reshape(B, S, HG_HEADS, HG_VAL)
    o = rms_norm(o, head_norm) * jax.nn.silu(g)
    return o.reshape(B, S, HG_VW).astype(dt)


def gmlp(uv_in, ln_g, ln_b, w_s, b_s):
    B, S, _ = uv_in.shape
    u, v = jnp.split(jax.nn.gelu(uv_in, approximate=False), 2, axis=-1)
    v = layer_norm(v, ln_g, ln_b)
    nc = S // GM_CHUNK
    v = v.reshape(B, nc, GM_CHUNK, GM_GROUPS, GM_GROUP_CH)
    w = w_s * jnp.tril(jnp.ones((GM_CHUNK, GM_CHUNK), w_s.dtype))[None]
    mixed = jnp.einsum('gts,bnsgc->bntgc', w, v) + b_s.T[None, None, :, :, None]
    return u * mixed.reshape(B, S, GM_WIDTH)


def cross_attn(h, m, w_q, w_kv, w_o):
    B, S, _ = h.shape
    q = (h @ w_q).reshape(B, S, X_HEADS, X_HEAD_DIM)
    kv = (m @ w_kv).reshape(B, m.shape[1], 2, X_HEADS, X_HEAD_DIM)
    k, v = kv[:, :, 0], kv[:, :, 1]
    s = jnp.einsum('bqhd,bkhd->bhqk', q, k).astype(jnp.float32) * (X_HEAD_DIM ** -0.5)
    p = jax.nn.softmax(s, axis=-1).astype(v.dtype)
    o = jnp.einsum('bhqk,bkhd->bqhd', p, v).reshape(B, S, D_MODEL)
    return o @ w_o


def setup_inputs(seed: int = 0) -> dict:
    key = jax.random.key(seed)
    ks = iter(jax.random.split(key, 40))
    f32 = jnp.float32

    def w(shape, fan_in):
        return jax.random.normal(next(ks), shape, f32) * fan_in ** -0.5

    def gain(shape):
        return 1.0 + 0.05 * jax.random.normal(next(ks), shape, f32)

    L = DEPTH
    x = jax.random.normal(next(ks), (BATCH, SEQ, D_MODEL), f32)
    mem = jax.random.normal(next(ks), (BATCH, N_MEM, D_MODEL), f32)
    offset = jax.random.randint(next(ks), (BATCH, 1), 0, 1024, dtype=jnp.int32)
    positions = offset + jnp.arange(SEQ, dtype=jnp.int32)[None, :]
    return {
        "x": x, "mem": mem, "positions": positions,
        "mix_norm": gain((L, D_MODEL)),
        "w_in": w((L, D_MODEL, IN_WIDTH), D_MODEL),
        "mla_q_norm": gain((L, MLA_Q_RANK)),
        "mla_w_uq": w((L, MLA_Q_RANK, MLA_HEADS * (MLA_NOPE + MLA_ROPE)), MLA_Q_RANK),
        "mla_kv_norm": gain((L, MLA_KV_RANK)),
        "mla_w_ukv": w((L, MLA_KV_RANK, MLA_HEADS * (MLA_NOPE + MLA_V)), MLA_KV_RANK),
        "hg_lower_bounds": 0.5 * jax.random.normal(next(ks), (L, HG_KW), f32),
        "hg_head_norm": gain((L, HG_VAL)),
        "gm_ln_g": gain((L, GM_WIDTH)),
        "gm_ln_b": 0.02 * jax.random.normal(next(ks), (L, GM_WIDTH), f32),
        "gm_w_s": w((L, GM_GROUPS, GM_CHUNK, GM_CHUNK), GM_CHUNK),
        "gm_b_s": 1.0 + 0.02 * jax.random.normal(next(ks), (L, GM_GROUPS, GM_CHUNK), f32),
        "w_branch_a": w((L, MLA_HEADS * MLA_V, D_MODEL), MLA_HEADS * MLA_V),
        "w_branch_b": w((L, HG_VW, D_MODEL), HG_VW),
        "w_branch_c": w((L, GM_WIDTH, D_MODEL), GM_WIDTH),
        "w_mix_out": w((L, D_MODEL, D_MODEL), D_MODEL),
        "xa_norm": gain((L, D_MODEL)),
        "mem_norm": gain((L, D_MODEL)),
        "xa_w_q": w((L, D_MODEL, D_MODEL), D_MODEL),
        "xa_w_kv": w((L, D_MODEL, 2 * D_MODEL), D_MODEL),
        "xa_w_o": w((L, D_MODEL, D_MODEL), D_MODEL),
        "ffn_norm": gain((L, D_MODEL)),
        "ffn_w_in": w((L, D_MODEL, 2 * D_FF), D_MODEL),
        "ffn_w_out": w((L, D_FF, D_MODEL), D_FF),
        "final_norm": gain((D_MODEL,)),
    }


def reference(x, mem, positions, mix_norm, w_in, mla_q_norm, mla_w_uq, mla_kv_norm, mla_w_ukv,
              hg_lower_bounds, hg_head_norm, gm_ln_g, gm_ln_b, gm_w_s, gm_b_s,
              w_branch_a, w_branch_b, w_branch_c, w_mix_out,
              xa_norm, mem_norm, xa_w_q, xa_w_kv, xa_w_o,
              ffn_norm, ffn_w_in, ffn_w_out, final_norm):
    inv_freq = ROPE_BASE ** (-jnp.arange(0, MLA_ROPE, 2, dtype=jnp.float32) / MLA_ROPE)
    ang = positions.astype(jnp.float32)[..., None] * inv_freq
    cos, sin = jnp.cos(ang), jnp.sin(ang)
    gamma = jax.nn.softmax(hg_lower_bounds.astype(jnp.float32), axis=0)
    cums = jnp.cumsum(gamma, axis=0)
    lower_bounds = cums - cums[0:1]

    for l in range(DEPTH):
        h = rms_norm(x, mix_norm[l])
        z = h @ w_in[l]
        c_q, c_kv, k_r, hq, hf, hi, hg, guv, gates = split_sizes(z, IN_SIZES)
        y_a = mla(c_q, c_kv, k_r, mla_q_norm[l], mla_w_uq[l], mla_kv_norm[l], mla_w_ukv[l], cos, sin) @ w_branch_a[l]
        y_b = hgrn2(hq, hf, hi, hg, lower_bounds[l], hg_head_norm[l]) @ w_branch_b[l]
        y_c = gmlp(guv, gm_ln_g[l], gm_ln_b[l], gm_w_s[l], gm_b_s[l]) @ w_branch_c[l]
        g_a, g_b, g_c = jnp.split(jax.nn.sigmoid(gates), 3, axis=-1)
        x = x + (g_a * y_a + g_b * y_b + g_c * y_c) @ w_mix_out[l]
        h = rms_norm(x, xa_norm[l])
        m = rms_norm(mem, mem_norm[l])
        x = x + cross_attn(h, m, xa_w_q[l], xa_w_kv[l], xa_w_o[l])
        h = rms_norm(x, ffn_norm[l])
        gt, up = jnp.split(h @ ffn_w_in[l], 2, axis=-1)
        x = x + (jax.nn.silu(gt) * up) @ ffn_w_out[l]
    return rms_norm(x, final_norm)
```

```cpp
#include <hip/hip_runtime.h>
#include <hip/hip_cooperative_groups.h>
#include <cstdio>
#include <cstdint>
namespace cg = cooperative_groups;

#define LAS __attribute__((address_space(3)))
#define DI __device__ __forceinline__
typedef unsigned short bf16_t;
typedef short bf16x8 __attribute__((ext_vector_type(8)));
typedef float f32x2 __attribute__((ext_vector_type(2)));
typedef float f32x4 __attribute__((ext_vector_type(4)));
typedef float f32x16 __attribute__((ext_vector_type(16)));
typedef unsigned u32x2 __attribute__((ext_vector_type(2)));
typedef unsigned u32x4 __attribute__((ext_vector_type(4)));

constexpr int SEQ = 8192, NB = 2, MTOK = NB * SEQ, DM = 1024, NMEM = 256;
constexpr int INW = 6816, DFF = 2816;
constexpr float EPS = 1e-6f;
constexpr float QSC = 0.10206207261596575f * 1.4426950408889634f;
constexpr float XSC = 0.0625f * 1.4426950408889634f;

DI unsigned cvt_pk(float lo, float hi) {
    typedef __bf16 b2 __attribute__((ext_vector_type(2)));
    f32x2 v = {lo, hi}; b2 b = __builtin_convertvector(v, b2); return __builtin_bit_cast(unsigned, b);
}
DI bf16_t f2bf(float f) { return (bf16_t)(cvt_pk(f, 0.f) & 0xffffu); }
DI float bf2f(bf16_t h) { return __uint_as_float((unsigned)h << 16); }
DI float bflo(unsigned w) { return __uint_as_float(w << 16); }
DI float bfhi(unsigned w) { return __uint_as_float(w & 0xffff0000u); }
DI int olane() { int t = __builtin_amdgcn_mbcnt_hi(~0u, __builtin_amdgcn_mbcnt_lo(~0u, 0u)); asm volatile("" : "+v"(t)); return t; }
DI int otid(int wv) { return wv * 64 + olane(); }
DI float wave_sum(float v) {
#pragma unroll
    for (int o = 1; o < 64; o <<= 1) v += __shfl_xor(v, o);
    return v;
}
DI float sigm(float x) { return __builtin_amdgcn_rcpf(1.f + __expf(-x)); }
DI float gelu_erf(float x) { return 0.5f * x * (1.f + erff(x * 0.7071067811865476f)); }
DI int crow(int r, int h) { return (r & 3) + 8 * (r >> 2) + 4 * h; }
DI float dot4(f32x4 a) { return (a.x * a.x + a.y * a.y) + (a.z * a.z + a.w * a.w); }
DI float sum4(f32x4 a) { return (a.x + a.y) + (a.z + a.w); }
#define MFMA32(a, b, c) __builtin_amdgcn_mfma_f32_32x32x16_bf16((a), (b), (c), 0, 0, 0)
DI bf16x8 mk8(u32x2 lo, u32x2 hi) { u32x4 v = {lo.x, lo.y, hi.x, hi.y}; return __builtin_bit_cast(bf16x8, v); }
DI bf16x8 pack8(float a0, float a1, float a2, float a3, float a4, float a5, float a6, float a7) {
    u32x4 v = {cvt_pk(a0, a1), cvt_pk(a2, a3), cvt_pk(a4, a5), cvt_pk(a6, a7)}; return __builtin_bit_cast(bf16x8, v);
}

namespace pg8 {
constexpr int BM = 256, BK = 64, HALF = 128, HTB = HALF * BK * 2, STAGE_BYTES = 8 * HTB, NXCD = 8, WGM = 8;
DI int lds_byte(int r, int c) { const int st = (r >> 4) * 2 + (c >> 5), rr = r & 15, cc = c & 31, ob = rr * 64 + cc * 2; return st * 1024 + (ob ^ (((ob >> 9) & 1) << 5)); }
DI void stage_rc(int b, int& R, int& C) { const int st = b / 1024, sb = b % 1024, swz = sb ^ (((sb >> 9) & 1) << 5); R = (st >> 1) * 16 + swz / 64; C = (st & 1) * 32 + (swz % 64) / 2; }
DI int perm32(int rho) { const int n = rho >> 4, i = rho & 15; return 8 * (i >> 2) + 4 * n + (i & 3); }
struct Unit { int pm, pn; };
struct Gemm { const bf16_t* A; const bf16_t* Bt; int M, N, K, lda, ldb; };
struct StaticOrder {
    int nM, nN, nwg, G, c;
    DI void init(int M, int N, int G_, int c_) { nM = M / BM; nN = N / BM; nwg = nM * nN; G = G_; c = c_; }
    DI bool next(int i, Unit& u) const {
        const long L = (long)i * G + c; if (L >= nwg) return false;
        int wgid = (int)L; { const int q = nwg / NXCD, r = nwg % NXCD, xcd = wgid % NXCD, off = wgid / NXCD; wgid = (xcd < r ? xcd * (q + 1) : r * (q + 1) + (xcd - r) * q) + off; }
        const int nig = WGM * nN, gid = wgid / nig, fm = gid * WGM, gsz = (nM - fm) < WGM ? (nM - fm) : WGM;
        u.pm = fm + ((wgid % nig) % gsz); u.pn = (wgid % nig) / gsz; return true;
    }
};
template <class Epi>
DI void gemm_phase(LAS unsigned char* lds, const Gemm g, const StaticOrder& S, const Epi& E, int wv) {
    const int tid = otid(wv), wid = __builtin_amdgcn_readfirstlane(tid >> 6), lane = tid & 63, wr = wid >> 2, wc = wid & 3, fr = lane & 15, fq = lane >> 4;
    const int K = g.K, nt = K / BK;
    unsigned voffA[2], voffB[2];
#pragma unroll
    for (int i = 0; i < 2; ++i) { int R, C; stage_rc(tid * 16 + i * 8192, R, C); const int Rb = Epi::PERM ? ((R & ~31) + perm32(R & 31)) : R;
        voffA[i] = (unsigned)(R * g.lda + C) * 2u; voffB[i] = (unsigned)(Rb * g.ldb + C) * 2u; }
    const size_t kstep = (size_t)(BK * 2);
    const size_t hsA = (size_t)HALF * g.lda * 2, hsB = (size_t)HALF * g.ldb * 2;
    const size_t tsA = 2 * hsA, tsB = 2 * hsB;
    const unsigned ldsw = (unsigned)wid * 1024u;
    const int aoff = lds_byte(wr * 64 + fr, fq * 8), boff = lds_byte(wc * 32 + fr, fq * 8);
#define PG8_SA(b, h) (((b) * 2 + (h)) * HTB)
#define PG8_SB(b, h) ((4 + (b) * 2 + (h)) * HTB)
#define PG8_STAGE(bufoff, gbase, voff) do { _Pragma("unroll") for (int _i = 0; _i < 2; ++_i) \
        __builtin_amdgcn_global_load_lds((const unsigned*)((const char*)(gbase) + (voff)[_i]), (LAS unsigned*)(lds + (bufoff) + ldsw + _i * 8192), 16, 0, 0); } while (0)
#define PG8_LDA(dst, b, h) do { _Pragma("unroll") for (int m = 0; m < 4; ++m) _Pragma("unroll") for (int k = 0; k < 2; ++k) dst[m][k] = *(const LAS bf16x8*)(lds + PG8_SA(b, h) + aoff + m * 2048 + k * 1024); } while (0)
#define PG8_LDB(dst, b, h) do { _Pragma("unroll") for (int n = 0; n < 2; ++n) _Pragma("unroll") for (int k = 0; k < 2; ++k) dst[n][k] = *(const LAS bf16x8*)(lds + PG8_SB(b, h) + boff + n * 2048 + k * 1024); } while (0)
#define PG8_MMA(ai, bj, At, Bt) do { __builtin_amdgcn_s_setprio(1); _Pragma("unroll") for (int m = 0; m < 4; ++m) _Pragma("unroll") for (int n = 0; n < 2; ++n) _Pragma("unroll") for (int k = 0; k < 2; ++k) \
        acc[ai][bj][m][n] = __builtin_amdgcn_mfma_f32_16x16x32_bf16(Bt[n][k], At[m][k], acc[ai][bj][m][n], 0, 0, 0); __builtin_amdgcn_s_setprio(0); } while (0)
#define PG8_WAIT_V(n) asm volatile("s_waitcnt vmcnt(" #n ")" ::: "memory")
#define PG8_WAIT_L(n) asm volatile("s_waitcnt lgkmcnt(" #n ")" ::: "memory")
#define PG8_BAR __builtin_amdgcn_s_barrier()
#define PG8_SCHED __builtin_amdgcn_sched_barrier(0)
    Unit cur, nxt; int ui = 0;
    if (!S.next(0, cur)) return;
    f32x4 acc[2][2][4][2];
#pragma unroll
    for (int a = 0; a < 2; ++a)
#pragma unroll
        for (int b = 0; b < 2; ++b)
#pragma unroll
            for (int m = 0; m < 4; ++m)
#pragma unroll
                for (int n = 0; n < 2; ++n) acc[a][b][m][n] = (f32x4){0.f, 0.f, 0.f, 0.f};
    bf16x8 At[4][2], B0[2][2], B1[2][2];
    const char* cA = (const char*)g.A + (size_t)cur.pm * tsA; const char* cB = (const char*)g.Bt + (size_t)cur.pn * tsB;
    PG8_STAGE(PG8_SB(0, 0), cB, voffB); PG8_STAGE(PG8_SB(0, 1), cB + hsB, voffB); PG8_STAGE(PG8_SA(0, 0), cA, voffA); PG8_STAGE(PG8_SA(0, 1), cA + hsA, voffA);
    if (wr == 1) PG8_BAR;
    PG8_WAIT_V(2); PG8_BAR;
    PG8_STAGE(PG8_SB(1, 0), cB + kstep, voffB); PG8_STAGE(PG8_SA(1, 0), cA + kstep, voffA); PG8_STAGE(PG8_SB(1, 1), cB + hsB + kstep, voffB);
    PG8_WAIT_V(6); PG8_BAR;
    for (;;) {
        const bool has_next = S.next(ui + 1, nxt);
        const char* nA = has_next ? (const char*)g.A + (size_t)nxt.pm * tsA : cA; const char* nB = has_next ? (const char*)g.Bt + (size_t)nxt.pn * tsB : cB;
        for (int t = 0; t < nt; t += 2) {
            const bool last = (t == nt - 2);
            const char* a1 = cA + (size_t)(t + 1) * kstep;
            const char* a2 = last ? nA : cA + (size_t)(t + 2) * kstep; const char* b2 = last ? nB : cB + (size_t)(t + 2) * kstep;
            const char* a3 = a2 + kstep; const char* b3 = b2 + kstep;
            PG8_LDB(B0, 0, 0); PG8_LDB(B1, 0, 1); PG8_SCHED; PG8_LDA(At, 0, 0); PG8_STAGE(PG8_SA(1, 1), a1 + hsA, voffA);
            PG8_WAIT_V(8); PG8_WAIT_L(0); PG8_BAR; PG8_MMA(0, 0, At, B0); PG8_MMA(0, 1, At, B1); PG8_BAR; PG8_SCHED;
            PG8_LDA(At, 0, 1); PG8_STAGE(PG8_SB(0, 0), b2, voffB); PG8_STAGE(PG8_SB(0, 1), b2 + hsB, voffB); PG8_STAGE(PG8_SA(0, 0), a2, voffA);
            PG8_WAIT_V(8); PG8_WAIT_L(0); PG8_BAR; PG8_MMA(1, 0, At, B0); PG8_MMA(1, 1, At, B1); PG8_BAR; PG8_SCHED;
            PG8_LDB(B0, 1, 0); PG8_LDB(B1, 1, 1); PG8_SCHED; PG8_LDA(At, 1, 0); PG8_STAGE(PG8_SA(0, 1), a2 + hsA, voffA);
            PG8_WAIT_V(8); PG8_WAIT_L(0); PG8_BAR; PG8_MMA(0, 0, At, B0); PG8_MMA(0, 1, At, B1); PG8_BAR; PG8_SCHED;
            PG8_LDA(At, 1, 1); PG8_STAGE(PG8_SB(1, 0), b3, voffB); PG8_STAGE(PG8_SB(1, 1), b3 + hsB, voffB); PG8_STAGE(PG8_SA(1, 0), a3, voffA);
            PG8_WAIT_V(8); PG8_WAIT_L(0); PG8_BAR; PG8_MMA(1, 0, At, B0); PG8_MMA(1, 1, At, B1); PG8_BAR; PG8_SCHED;
        }
        if (wr == 0) PG8_BAR;
        { const int ln_ = olane(); E(acc, cur, wr, wc, ln_ & 15, ln_ >> 4); }
        if (!has_next) break;
#pragma unroll
        for (int a = 0; a < 2; ++a)
#pragma unroll
            for (int b = 0; b < 2; ++b)
#pragma unroll
                for (int m = 0; m < 4; ++m)
#pragma unroll
                    for (int n = 0; n < 2; ++n) acc[a][b][m][n] = (f32x4){0.f, 0.f, 0.f, 0.f};
        cur = nxt; cA = nA; cB = nB; ++ui;
        if (wr == 1) PG8_BAR;
    }
    PG8_WAIT_V(0);
    PG8_BAR;
#undef PG8_SA
#undef PG8_SB
#undef PG8_STAGE
#undef PG8_LDA
#undef PG8_LDB
#undef PG8_MMA
#undef PG8_WAIT_V
#undef PG8_WAIT_L
#undef PG8_BAR
#undef PG8_SCHED
}
}
typedef const f32x4 (&AccRef)[2][2][4][2];

DI float row_rstd16(const float* P, int row) {
    const f32x4* p = (const f32x4*)(P + (size_t)row * 16);
    const float s = (sum4(p[0]) + sum4(p[1])) + (sum4(p[2]) + sum4(p[3]));
    return rsqrtf(s * (1.0f / 1024.0f) + EPS);
}
DI u32x4 pk16(f32x4 v0, f32x4 v1) { u32x4 w; w.x = cvt_pk(v0[0], v0[1]); w.y = cvt_pk(v0[2], v0[3]); w.z = cvt_pk(v1[0], v1[1]); w.w = cvt_pk(v1[2], v1[3]); return w; }
DI u32x2 pk8(f32x4 v) { u32x2 w; w.x = cvt_pk(v[0], v[1]); w.y = cvt_pk(v[2], v[3]); return w; }

struct EpiA { static constexpr bool PERM = true;
    const float* P; bf16_t* zA; bf16_t* zB; bf16_t* zC; float* PA;
    DI void operator()(AccRef acc, const pg8::Unit& u, int wr, int wc, int fr, int fq) const {
        const int pn = u.pn; bf16_t* base; int ld, colt;
        if (pn < 3) { base = zA; ld = 768; colt = pn * 256; } else if (pn < 11) { base = zB; ld = 2048; colt = (pn - 3) * 256; } else { base = zC; ld = 1024; colt = (pn - 11) * 256; }
        const int row0 = u.pm * 256 + wr * 64 + fr, col0 = colt + wc * 32 + 8 * fq;
#pragma unroll
        for (int ai = 0; ai < 2; ++ai)
#pragma unroll
            for (int m = 0; m < 4; ++m) { const int row = row0 + ai * 128 + m * 16; const float rs = row_rstd16(P, row);
#pragma unroll
                for (int bj = 0; bj < 2; ++bj) { const f32x4 v0 = acc[ai][bj][m][0] * rs, v1 = acc[ai][bj][m][1] * rs;
                    if (pn < 3) { float s = dot4(v0) + dot4(v1); s += __shfl_xor(s, 16); s += __shfl_xor(s, 32); if (fq == 0) PA[(size_t)row * 32 + pn * 8 + bj * 4 + wc] = s; }
                    *(u32x4*)(base + (size_t)row * ld + col0 + bj * 128) = pk16(v0, v1); } }
    }
};
template <bool SIG> struct EpiPlain { static constexpr bool PERM = true;
    const float* P; bf16_t* O; int ldo; float scale;
    DI void operator()(AccRef acc, const pg8::Unit& u, int wr, int wc, int fr, int fq) const {
        const int row0 = u.pm * 256 + wr * 64 + fr, col0 = u.pn * 256 + wc * 32 + 8 * fq;
#pragma unroll
        for (int ai = 0; ai < 2; ++ai)
#pragma unroll
            for (int m = 0; m < 4; ++m) { const int row = row0 + ai * 128 + m * 16; const float rs = row_rstd16(P, row) * scale;
#pragma unroll
                for (int bj = 0; bj < 2; ++bj) { f32x4 v0 = acc[ai][bj][m][0] * rs, v1 = acc[ai][bj][m][1] * rs;
                    if (SIG) {
#pragma unroll
                        for (int e = 0; e < 4; ++e) { v0[e] = sigm(v0[e]); v1[e] = sigm(v1[e]); } }
                    *(u32x4*)(O + (size_t)row * ldo + col0 + bj * 128) = pk16(v0, v1); } }
    }
};
struct EpiQ { static constexpr bool PERM = false;
    const float* PA; const float* CS; bf16_t* Q;
    DI void operator()(AccRef acc, const pg8::Unit& u, int wr, int wc, int fr, int fq) const {
        const int row0 = u.pm * 256 + wr * 64 + fr;
#pragma unroll
        for (int ai = 0; ai < 2; ++ai)
#pragma unroll
            for (int m = 0; m < 4; ++m) { const int row = row0 + ai * 128 + m * 16;
                const f32x4* pp = (const f32x4*)(PA + (size_t)row * 32);
                const float ss = sum4(pp[0]) + sum4(pp[1]) + sum4(pp[2]);
                const float rs = rsqrtf(ss * (1.0f / 384.0f) + EPS);
                const f32x4 cs = *(const f32x4*)(CS + (size_t)row * 32 + 4 * fq), sn = *(const f32x4*)(CS + (size_t)row * 32 + 16 + 4 * fq);
#pragma unroll
                for (int bj = 0; bj < 2; ++bj) { const int g32 = u.pn * 8 + bj * 4 + wc;
                    f32x4 v0 = acc[ai][bj][m][0] * rs, v1 = acc[ai][bj][m][1] * rs;
                    if ((g32 % 3) == 2) { const f32x4 y0 = v0 * cs - v1 * sn, y1 = v0 * sn + v1 * cs; v0 = y0; v1 = y1; }
                    v0 = v0 * QSC; v1 = v1 * QSC;
                    bf16_t* o = Q + (size_t)row * 768 + u.pn * 256 + bj * 128 + wc * 32 + 4 * fq;
                    *(u32x2*)(o) = pk8(v0); *(u32x2*)(o + 16) = pk8(v1); } }
    }
};
struct EpiKV { static constexpr bool PERM = true;
    const float* PA; bf16_t* Kn; bf16_t* Vt;
    DI void operator()(AccRef acc, const pg8::Unit& u, int wr, int wc, int fr, int fq) const {
        const int row0 = u.pm * 256 + wr * 64 + fr;
#pragma unroll
        for (int ai = 0; ai < 2; ++ai)
#pragma unroll
            for (int m = 0; m < 4; ++m) { const int row = row0 + ai * 128 + m * 16;
                const f32x4* pp = (const f32x4*)(PA + (size_t)row * 32 + 12);
                const float ss = sum4(pp[0]) + sum4(pp[1]);
                const float rs = rsqrtf(ss * (1.0f / 256.0f) + EPS);
                const int b = row / SEQ, tok = row % SEQ;
#pragma unroll
                for (int bj = 0; bj < 2; ++bj) { const int h = 2 * u.pn + bj;
                    const f32x4 v0 = acc[ai][bj][m][0] * rs, v1 = acc[ai][bj][m][1] * rs;
                    if (wc < 2) { *(u32x4*)(Kn + (size_t)row * 512 + h * 64 + wc * 32 + 8 * fq) = pk16(v0, v1); }
                    else { bf16_t* vp = Vt + ((size_t)(b * 8 + h) * 64 + (wc - 2) * 32 + 8 * fq) * SEQ + tok;
#pragma unroll
                        for (int e = 0; e < 4; ++e) { vp[(size_t)e * SEQ] = f2bf(v0[e]); vp[(size_t)(4 + e) * SEQ] = f2bf(v1[e]); } } } }
    }
};
struct EpiBr { static constexpr bool PERM = true;
    const bf16_t* G; bf16_t* MX; int j;
    DI void operator()(AccRef acc, const pg8::Unit& u, int wr, int wc, int fr, int fq) const {
        const int row0 = u.pm * 256 + wr * 64 + fr, col0 = u.pn * 256 + wc * 32 + 8 * fq;
#pragma unroll
        for (int ai = 0; ai < 2; ++ai)
#pragma unroll
            for (int m = 0; m < 4; ++m) { const int row = row0 + ai * 128 + m * 16;
#pragma unroll
                for (int bj = 0; bj < 2; ++bj) { const int col = col0 + bj * 128;
                    const u32x4 gw = *(const u32x4*)(G + (size_t)row * 3072 + j * 1024 + col);
                    f32x4 v0 = acc[ai][bj][m][0], v1 = acc[ai][bj][m][1];
                    v0[0] *= bflo(gw.x); v0[1] *= bfhi(gw.x); v0[2] *= bflo(gw.y); v0[3] *= bfhi(gw.y);
                    v1[0] *= bflo(gw.z); v1[1] *= bfhi(gw.z); v1[2] *= bflo(gw.w); v1[3] *= bfhi(gw.w);
                    bf16_t* mp = MX + (size_t)row * 1024 + col;
                    if (j > 0) { const u32x4 ow = *(const u32x4*)mp;
                        v0[0] += bflo(ow.x); v0[1] += bfhi(ow.x); v0[2] += bflo(ow.y); v0[3] += bfhi(ow.y);
                        v1[0] += bflo(ow.z); v1[1] += bfhi(ow.z); v1[2] += bflo(ow.w); v1[3] += bfhi(ow.w); }
                    *(u32x4*)mp = pk16(v0, v1); } }
    }
};
struct EpiRes { static constexpr bool PERM = false;
    const float* xin; float* xout; bf16_t* xb; float* P;
    DI void operator()(AccRef acc, const pg8::Unit& u, int wr, int wc, int fr, int fq) const {
        const int row0 = u.pm * 256 + wr * 64 + fr, col0 = u.pn * 256 + wc * 32 + 4 * fq;
#pragma unroll
        for (int ai = 0; ai < 2; ++ai)
#pragma unroll
            for (int m = 0; m < 4; ++m) { const int row = row0 + ai * 128 + m * 16; float s = 0.f;
#pragma unroll
                for (int bj = 0; bj < 2; ++bj)
#pragma unroll
                    for (int n = 0; n < 2; ++n) { const size_t off = (size_t)row * 1024 + col0 + bj * 128 + n * 16;
                        const f32x4 xo = *(const f32x4*)(xin + off) + acc[ai][bj][m][n];
                        *(f32x4*)(xout + off) = xo; *(u32x2*)(xb + off) = pk8(xo); s += dot4(xo); }
                s += __shfl_xor(s, 16); s += __shfl_xor(s, 32);
                if (fq == 0) P[(size_t)row * 16 + u.pn * 4 + wc] = s; }
    }
};
struct EpiKVm { static constexpr bool PERM = true;
    const float* mrstd; bf16_t* Km; bf16_t* Vmt;
    DI void operator()(AccRef acc, const pg8::Unit& u, int wr, int wc, int fr, int fq) const {
        const int row0 = u.pm * 256 + wr * 64 + fr;
#pragma unroll
        for (int ai = 0; ai < 2; ++ai)
#pragma unroll
            for (int m = 0; m < 4; ++m) { const int row = row0 + ai * 128 + m * 16; const float rs = mrstd[row];
                const int b = row >> 8, key = row & 255;
#pragma unroll
                for (int bj = 0; bj < 2; ++bj) { const f32x4 v0 = acc[ai][bj][m][0] * rs, v1 = acc[ai][bj][m][1] * rs;
                    const int c = u.pn * 256 + bj * 128 + wc * 32 + 8 * fq;
                    if (u.pn < 4) { *(u32x4*)(Km + (size_t)row * 1024 + c) = pk16(v0, v1); }
                    else { const int c2 = c - 1024, h = c2 >> 8, dv = c2 & 255;
                        bf16_t* vp = Vmt + ((size_t)(b * 4 + h) * 256 + dv) * 256 + key;
#pragma unroll
                        for (int e = 0; e < 4; ++e) { vp[e * 256] = f2bf(v0[e]); vp[(4 + e) * 256] = f2bf(v1[e]); } } } }
    }
};
struct EpiFF { static constexpr bool PERM = false;
    const float* P; bf16_t* ACT;
    DI void operator()(AccRef acc, const pg8::Unit& u, int wr, int wc, int fr, int fq) const {
        const int row0 = u.pm * 256 + wr * 64 + fr;
#pragma unroll
        for (int ai = 0; ai < 2; ++ai)
#pragma unroll
            for (int m = 0; m < 4; ++m) { const int row = row0 + ai * 128 + m * 16; const float rs = row_rstd16(P, row);
#pragma unroll
                for (int bj = 0; bj < 2; ++bj) { const int G = u.pn * 8 + bj * 4 + wc;
                    const f32x4 gt = acc[ai][bj][m][0] * rs, up = acc[ai][bj][m][1] * rs; f32x4 a;
#pragma unroll
                    for (int e = 0; e < 4; ++e) a[e] = gt[e] * sigm(gt[e]) * up[e];
                    *(u32x2*)(ACT + (size_t)row * DFF + 16 * G + 4 * fq) = pk8(a); } }
    }
};

DI int srccol(int mode, int np) {
    if (mode == 1) return np < 672 ? np : (np < 768 ? -1 : np - 96);
    if (mode == 2) { const int G = np >> 5, s = (np >> 4) & 1, j = np & 15; return s * DFF + 16 * G + j; }
    return np;
}
DI void conv_item(const float* W, int K, int N, int Np, int mode, const float* gain, bf16_t* WT, LAS float* scr, int item, int lane) {
    const int nblk = Np / 32, kb = item / nblk, nb = item % nblk, k0 = 64 * kb, n0 = 32 * nb;
    const int sc = srccol(mode, n0 + (lane & 31));
#pragma unroll 8
    for (int i = 0; i < 32; ++i) { const int kk = 2 * i + (lane >> 5); float w = 0.f;
        if (sc >= 0) { w = W[(size_t)(k0 + kk) * N + sc]; if (gain) w *= gain[k0 + kk]; }
        scr[kk * 33 + (lane & 31)] = w; }
    asm volatile("s_waitcnt lgkmcnt(0)" ::: "memory");
    const int c = lane & 7;
#pragma unroll
    for (int j = 0; j < 4; ++j) { const int n = (lane >> 3) + 8 * j; const LAS float* s = scr + (8 * c) * 33 + n;
        u32x4 o; o.x = cvt_pk(s[0 * 33], s[1 * 33]); o.y = cvt_pk(s[2 * 33], s[3 * 33]); o.z = cvt_pk(s[4 * 33], s[5 * 33]); o.w = cvt_pk(s[6 * 33], s[7 * 33]);
        *(u32x4*)(WT + (size_t)(n0 + n) * K + k0 + 8 * c) = o; }
    asm volatile("s_waitcnt lgkmcnt(0)" ::: "memory");
}

DI void attn_unit(LAS unsigned char* lds, const bf16_t* Q, const bf16_t* Kn, const bf16_t* Kr, const bf16_t* Vt, bf16_t* Oa, int b, int h, int qb, int wv) {
    const int tid = otid(wv), lane = tid & 63, w = __builtin_amdgcn_readfirstlane(tid >> 6), l32 = lane & 31, hi = lane >> 5;
    constexpr int KST = 208, VST = 136, KBUF = 64 * KST, VBUF = 64 * VST, VOFF = 2 * KBUF;
    const size_t rowb = (size_t)b * SEQ;
    const int qrow = qb * 256 + 32 * w + l32;
    bf16x8 qf[6];
#pragma unroll
    for (int ks = 0; ks < 6; ++ks) qf[ks] = *(const bf16x8*)(Q + (rowb + qrow) * 768 + h * 96 + 16 * ks + 8 * hi);
    f32x16 o0, o1;
#pragma unroll
    for (int r = 0; r < 16; ++r) { o0[r] = 0.f; o1[r] = 0.f; }
    float mrun = -INFINITY, lrun = 0.f;
    const int NT = 4 * qb + 4, tlast = 4 * qb + (w >> 1);
    const int kkey = tid >> 3, kch = tid & 7, rkey = (tid & 255) >> 2, rch = tid & 3;
    const bf16_t* gK = Kn + (rowb + kkey) * 512 + h * 64 + kch * 8;
    const bf16_t* gR = Kr + (rowb + rkey) * 32 + rch * 8;
    const bf16_t* gV = Vt + ((size_t)(b * 8 + h) * 64 + kkey) * SEQ + kch * 8;
    u32x4 rk, rr, rv;
    rr = (u32x4){0u, 0u, 0u, 0u};
    rk = *(const u32x4*)gK; if (tid < 256) rr = *(const u32x4*)gR; rv = *(const u32x4*)gV;
    {
        *(LAS u32x4*)(lds + kkey * KST + kch * 16) = rk;
        if (tid < 256) *(LAS u32x4*)(lds + rkey * KST + 128 + rch * 16) = rr;
        *(LAS u32x2*)(lds + VOFF + kkey * VST + kch * 16) = (u32x2){rv.x, rv.y};
        *(LAS u32x2*)(lds + VOFF + kkey * VST + kch * 16 + 8) = (u32x2){rv.z, rv.w};
    }
    __syncthreads();
    for (int t = 0; t < NT; ++t) {
        const int cur = t & 1;
        if (t + 1 < NT) {
            rk = *(const u32x4*)(gK + (size_t)(t + 1) * 64 * 512);
            if (tid < 256) rr = *(const u32x4*)(gR + (size_t)(t + 1) * 64 * 32);
            rv = *(const u32x4*)(gV + (size_t)(t + 1) * 64);
        }
        if (t <= tlast) {
            const LAS unsigned char* kb_ = lds + cur * KBUF;
            const LAS unsigned char* vb_ = lds + VOFF + cur * VBUF;
            f32x16 s0, s1;
#pragma unroll
            for (int r = 0; r < 16; ++r) { s0[r] = 0.f; s1[r] = 0.f; }
#pragma unroll
            for (int ks = 0; ks < 6; ++ks) {
                const bf16x8 a0 = *(const LAS bf16x8*)(kb_ + l32 * KST + (16 * ks + 8 * hi) * 2);
                const bf16x8 a1 = *(const LAS bf16x8*)(kb_ + (32 + l32) * KST + (16 * ks + 8 * hi) * 2);
                s0 = MFMA32(a0, qf[ks], s0); s1 = MFMA32(a1, qf[ks], s1);
            }
            if (t == tlast) {
#pragma unroll
                for (int r = 0; r < 16; ++r) { const int key = 64 * t + crow(r, hi);
                    if (key > qrow) s0[r] = -INFINITY;
                    if (key + 32 > qrow) s1[r] = -INFINITY; }
            }
            float mx = fmaxf(s0[0], s1[0]);
#pragma unroll
            for (int r = 1; r < 16; ++r) mx = fmaxf(mx, fmaxf(s0[r], s1[r]));
            mx = fmaxf(mx, __shfl_xor(mx, 32));
            const float mnew = fmaxf(mrun, mx);
            const float alpha = __builtin_amdgcn_exp2f(mrun - mnew);
            mrun = mnew;
            float ps = 0.f;
#pragma unroll
            for (int r = 0; r < 16; ++r) { s0[r] = __builtin_amdgcn_exp2f(s0[r] - mnew); s1[r] = __builtin_amdgcn_exp2f(s1[r] - mnew); ps += s0[r] + s1[r]; }
            lrun = lrun * alpha + ps;
#pragma unroll
            for (int r = 0; r < 16; ++r) { o0[r] *= alpha; o1[r] *= alpha; }
#pragma unroll
            for (int s = 0; s < 4; ++s) {
                const int kb = s >> 1, sub = s & 1;
                bf16x8 P;
                if (kb == 0) P = pack8(s0[8 * sub + 0], s0[8 * sub + 1], s0[8 * sub + 2], s0[8 * sub + 3], s0[8 * sub + 4], s0[8 * sub + 5], s0[8 * sub + 6], s0[8 * sub + 7]);
                else         P = pack8(s1[8 * sub + 0], s1[8 * sub + 1], s1[8 * sub + 2], s1[8 * sub + 3], s1[8 * sub + 4], s1[8 * sub + 5], s1[8 * sub + 6], s1[8 * sub + 7]);
                const int koff = (32 * kb + 16 * sub + 4 * hi) * 2;
                const u32x2 a0l = *(const LAS u32x2*)(vb_ + l32 * VST + koff), a0h = *(const LAS u32x2*)(vb_ + l32 * VST + koff + 16);
                const u32x2 a1l = *(const LAS u32x2*)(vb_ + (32 + l32) * VST + koff), a1h = *(const LAS u32x2*)(vb_ + (32 + l32) * VST + koff + 16);
                o0 = MFMA32(mk8(a0l, a0h), P, o0); o1 = MFMA32(mk8(a1l, a1h), P, o1);
            }
        }
        if (t + 1 < NT) {
            LAS unsigned char* kd = lds + (cur ^ 1) * KBUF; LAS unsigned char* vd = lds + VOFF + (cur ^ 1) * VBUF;
            *(LAS u32x4*)(kd + kkey * KST + kch * 16) = rk;
            if (tid < 256) *(LAS u32x4*)(kd + rkey * KST + 128 + rch * 16) = rr;
            *(LAS u32x2*)(vd + kkey * VST + kch * 16) = (u32x2){rv.x, rv.y};
            *(LAS u32x2*)(vd + kkey * VST + kch * 16 + 8) = (u32x2){rv.z, rv.w};
        }
        __syncthreads();
    }
    const float lt = lrun + __shfl_xor(lrun, 32);
    const float inv = 1.0f / lt;
    bf16_t* op = Oa + (rowb + qrow) * 512 + h * 64;
#pragma unroll
    for (int g = 0; g < 4; ++g) {
        u32x2 w0, w1;
        w0.x = cvt_pk(o0[4 * g] * inv, o0[4 * g + 1] * inv); w0.y = cvt_pk(o0[4 * g + 2] * inv, o0[4 * g + 3] * inv);
        w1.x = cvt_pk(o1[4 * g] * inv, o1[4 * g + 1] * inv); w1.y = cvt_pk(o1[4 * g + 2] * inv, o1[4 * g + 3] * inv);
        *(u32x2*)(op + 8 * g + 4 * hi) = w0; *(u32x2*)(op + 32 + 8 * g + 4 * hi) = w1;
    }
}

DI void xattn_unit(LAS unsigned char* lds, bf16_t* QX, const bf16_t* Km, const bf16_t* Vmt, int b, int h, int qb, int wv) {
    const int tid = otid(wv), lane = tid & 63, w = __builtin_amdgcn_readfirstlane(tid >> 6), l32 = lane & 31, hi = lane >> 5;
    constexpr int KST = 272, VST = 520, BUF = 64 * VST;
    const size_t row = (size_t)b * SEQ + qb * 256 + 32 * w + l32;
    bf16_t* qp = QX + row * 1024 + h * 256;
    f32x16 sacc[8];
#pragma unroll
    for (int i = 0; i < 8; ++i)
#pragma unroll
        for (int r = 0; r < 16; ++r) sacc[i][r] = 0.f;
    unsigned pp[8][8];
    bf16x8 qf[8];
    u32x4 pf[4];
#define XLOAD(i) do { if ((i) < 8) { const int dh_ = (i) >> 2, kt_ = (i) & 3; \
        _Pragma("unroll") for (int j = 0; j < 2; ++j) { const int id = tid + 512 * j, key = id >> 4, ch = id & 15; \
            pf[j] = *(const u32x4*)(Km + ((size_t)(b * 256 + 64 * kt_ + key)) * 1024 + h * 256 + 128 * dh_ + 8 * ch); } } \
      else { const int c_ = (i) - 8; \
        _Pragma("unroll") for (int j = 0; j < 4; ++j) { const int id = tid + 512 * j, dv = id >> 5, ch = id & 31; \
            pf[j] = *(const u32x4*)(Vmt + ((size_t)((b * 4 + h) * 256 + 64 * c_ + dv)) * 256 + 8 * ch); } } } while (0)
#define XSTORE(i, bufp) do { if ((i) < 8) { \
        _Pragma("unroll") for (int j = 0; j < 2; ++j) { const int id = tid + 512 * j, key = id >> 4, ch = id & 15; *(LAS u32x4*)((bufp) + key * KST + ch * 16) = pf[j]; } } \
      else { \
        _Pragma("unroll") for (int j = 0; j < 4; ++j) { const int id = tid + 512 * j, dv = id >> 5, ch = id & 31; \
            *(LAS u32x2*)((bufp) + dv * VST + ch * 16) = (u32x2){pf[j].x, pf[j].y}; *(LAS u32x2*)((bufp) + dv * VST + ch * 16 + 8) = (u32x2){pf[j].z, pf[j].w}; } } } while (0)
    XLOAD(0); XSTORE(0, lds);
    __syncthreads();
#pragma unroll
    for (int i = 0; i < 12; ++i) {
        const LAS unsigned char* cb_ = lds + (i & 1) * BUF;
        if (i + 1 < 12) XLOAD(i + 1);
        if (i < 8) {
            const int dh = i >> 2, kt = i & 3;
            if (kt == 0) {
#pragma unroll
                for (int ks = 0; ks < 8; ++ks) qf[ks] = *(const bf16x8*)(qp + 128 * dh + 16 * ks + 8 * hi);
            }
#pragma unroll
            for (int ks = 0; ks < 8; ++ks) {
                const bf16x8 a0 = *(const LAS bf16x8*)(cb_ + l32 * KST + (16 * ks + 8 * hi) * 2);
                const bf16x8 a1 = *(const LAS bf16x8*)(cb_ + (32 + l32) * KST + (16 * ks + 8 * hi) * 2);
                sacc[2 * kt] = MFMA32(a0, qf[ks], sacc[2 * kt]); sacc[2 * kt + 1] = MFMA32(a1, qf[ks], sacc[2 * kt + 1]);
            }
            if (i == 7) {
                float mx = sacc[0][0];
#pragma unroll
                for (int j = 0; j < 8; ++j)
#pragma unroll
                    for (int r = 0; r < 16; ++r) mx = fmaxf(mx, sacc[j][r]);
                mx = fmaxf(mx, __shfl_xor(mx, 32));
                float ps = 0.f;
#pragma unroll
                for (int j = 0; j < 8; ++j)
#pragma unroll
                    for (int r = 0; r < 16; ++r) { sacc[j][r] = __builtin_amdgcn_exp2f(sacc[j][r] - mx); ps += sacc[j][r]; }
                ps += __shfl_xor(ps, 32);
                const float inv = 1.0f / ps;
#pragma unroll
                for (int j = 0; j < 8; ++j)
#pragma unroll
                    for (int r2 = 0; r2 < 8; ++r2) pp[j][r2] = cvt_pk(sacc[j][2 * r2] * inv, sacc[j][2 * r2 + 1] * inv);
            }
        } else {
            const int c = i - 8;
            f32x16 o0, o1;
#pragma unroll
            for (int r = 0; r < 16; ++r) { o0[r] = 0.f; o1[r] = 0.f; }
#pragma unroll
            for (int s = 0; s < 16; ++s) {
                const int kb = s >> 1, sub = s & 1;
                const u32x4 pw = {pp[kb][4 * sub], pp[kb][4 * sub + 1], pp[kb][4 * sub + 2], pp[kb][4 * sub + 3]};
                const bf16x8 P = __builtin_bit_cast(bf16x8, pw);
                const int koff = (32 * kb + 16 * sub + 4 * hi) * 2;
                const u32x2 a0l = *(const LAS u32x2*)(cb_ + l32 * VST + koff), a0h = *(const LAS u32x2*)(cb_ + l32 * VST + koff + 16);
                const u32x2 a1l = *(const LAS u32x2*)(cb_ + (32 + l32) * VST + koff), a1h = *(const LAS u32x2*)(cb_ + (32 + l32) * VST + koff + 16);
                o0 = MFMA32(mk8(a0l, a0h), P, o0); o1 = MFMA32(mk8(a1l, a1h), P, o1);
            }
#pragma unroll
            for (int g = 0; g < 4; ++g) {
                u32x2 w0, w1;
                w0.x = cvt_pk(o0[4 * g], o0[4 * g + 1]); w0.y = cvt_pk(o0[4 * g + 2], o0[4 * g + 3]);
                w1.x = cvt_pk(o1[4 * g], o1[4 * g + 1]); w1.y = cvt_pk(o1[4 * g + 2], o1[4 * g + 3]);
                *(u32x2*)(qp + 64 * c + 8 * g + 4 * hi) = w0; *(u32x2*)(qp + 64 * c + 32 + 8 * g + 4 * hi) = w1;
            }
        }
        if (i + 1 < 12) XSTORE(i + 1, lds + ((i + 1) & 1) * BUF);
        __syncthreads();
    }
#undef XLOAD
#undef XSTORE
}

DI void gmlp_unit(LAS unsigned char* lds, bf16_t* zC, const float* ln_g, const float* ln_b, const float* w_s, const float* b_s, int chunk, int g, int wv) {
    const int tid = otid(wv), lane = tid & 63, w = __builtin_amdgcn_readfirstlane(tid >> 6), l32 = lane & 31, hi = lane >> 5;
    constexpr int VST = 272;
    const size_t row0 = (size_t)chunk * 128;
    LAS bf16_t* vnT = (LAS bf16_t*)lds;
    {
        f32x4 lg0, lg1, lb0, lb1;
        lg0 = *(const f32x4*)(ln_g + 8 * lane); lg1 = *(const f32x4*)(ln_g + 8 * lane + 4);
        lb0 = *(const f32x4*)(ln_b + 8 * lane); lb1 = *(const f32x4*)(ln_b + 8 * lane + 4);
        for (int tt = 0; tt < 16; ++tt) {
            const int t = 16 * w + tt;
            const u32x4 raw = *(const u32x4*)(zC + (row0 + t) * 1024 + 512 + 8 * lane);
            float x[8];
            x[0] = gelu_erf(bflo(raw.x)); x[1] = gelu_erf(bfhi(raw.x)); x[2] = gelu_erf(bflo(raw.y)); x[3] = gelu_erf(bfhi(raw.y));
            x[4] = gelu_erf(bflo(raw.z)); x[5] = gelu_erf(bfhi(raw.z)); x[6] = gelu_erf(bflo(raw.w)); x[7] = gelu_erf(bfhi(raw.w));
            float s = 0.f;
#pragma unroll
            for (int e = 0; e < 8; ++e) s += x[e];
            const float mean = wave_sum(s) * (1.0f / 512.0f);
            float q = 0.f;
#pragma unroll
            for (int e = 0; e < 8; ++e) { x[e] -= mean; q += x[e] * x[e]; }
            const float rstd = rsqrtf(wave_sum(q) * (1.0f / 512.0f) + EPS);
            if ((lane >> 4) == g) {
                const int cl = 8 * (lane & 15);
                vnT[(cl + 0) * (VST / 2) + t] = f2bf(x[0] * rstd * lg0[0] + lb0[0]); vnT[(cl + 1) * (VST / 2) + t] = f2bf(x[1] * rstd * lg0[1] + lb0[1]);
                vnT[(cl + 2) * (VST / 2) + t] = f2bf(x[2] * rstd * lg0[2] + lb0[2]); vnT[(cl + 3) * (VST / 2) + t] = f2bf(x[3] * rstd * lg0[3] + lb0[3]);
                vnT[(cl + 4) * (VST / 2) + t] = f2bf(x[4] * rstd * lg1[0] + lb1[0]); vnT[(cl + 5) * (VST / 2) + t] = f2bf(x[5] * rstd * lg1[1] + lb1[1]);
                vnT[(cl + 6) * (VST / 2) + t] = f2bf(x[6] * rstd * lg1[2] + lb1[2]); vnT[(cl + 7) * (VST / 2) + t] = f2bf(x[7] * rstd * lg1[3] + lb1[3]);
            }
        }
    }
    __syncthreads();
    {
        const int tb = w >> 1, cb0 = 2 * (w & 1);
        f32x16 a0, a1;
#pragma unroll
        for (int r = 0; r < 16; ++r) { a0[r] = 0.f; a1[r] = 0.f; }
        const int trow = 32 * tb + l32;
        const float* wrow = w_s + ((size_t)(g * 128 + trow)) * 128;
        for (int ks = 0; ks <= 2 * tb + 1; ++ks) {
            const int s0 = 16 * ks + 8 * hi;
            f32x4 w0 = *(const f32x4*)(wrow + s0), w1 = *(const f32x4*)(wrow + s0 + 4);
#pragma unroll
            for (int e = 0; e < 4; ++e) { if (s0 + e > trow) w0[e] = 0.f; if (s0 + 4 + e > trow) w1[e] = 0.f; }
            const bf16x8 A = pack8(w0[0], w0[1], w0[2], w0[3], w1[0], w1[1], w1[2], w1[3]);
            const bf16x8 B0 = *(const LAS bf16x8*)(lds + (32 * cb0 + l32) * VST + s0 * 2);
            const bf16x8 B1 = *(const LAS bf16x8*)(lds + (32 * (cb0 + 1) + l32) * VST + s0 * 2);
            a0 = MFMA32(A, B0, a0); a1 = MFMA32(A, B1, a1);
        }
#pragma unroll
        for (int r = 0; r < 16; ++r) {
            const int t = 32 * tb + crow(r, hi);
            const float bs = b_s[g * 128 + t];
            bf16_t* up0 = zC + (row0 + t) * 1024 + g * 128 + 32 * cb0 + l32;
            const float u0 = gelu_erf(bf2f(up0[0])), u1 = gelu_erf(bf2f(up0[32]));
            up0[0] = f2bf((a0[r] + bs) * u0); up0[32] = f2bf((a1[r] + bs) * u1);
        }
    }
    __syncthreads();
}

#define HG_PREP() \
    const int k = tid & 127, seg = tid >> 7; \
    const size_t row0 = (size_t)b * SEQ + (size_t)c * 64 + 16 * seg; \
    float cum[16], kv[16]; float bref, blast; \
    { const float lb = lbv[h * 128 + k]; float run = 0.f; \
      _Pragma("unroll") for (int i = 0; i < 16; ++i) { const float fr_ = bf2f(zB[(row0 + i) * 2048 + 512 + h * 128 + k]); \
          const float e_ = __expf(-fr_), sg_ = __builtin_amdgcn_rcpf(1.f + e_); const float f_ = lb + (1.f - lb) * sg_; \
          run += __logf(f_); cum[i] = run; kv[i] = (1.f - lb) * e_ * sg_; } \
      segs[seg * 128 + k] = run; __syncthreads(); \
      const float s0_ = segs[k], s1_ = segs[128 + k], s2_ = segs[256 + k], s3_ = segs[384 + k]; \
      const float off_ = (seg > 0 ? s0_ : 0.f) + (seg > 1 ? s1_ : 0.f) + (seg > 2 ? s2_ : 0.f); \
      bref = s0_ + s1_; blast = (s0_ + s1_) + (s2_ + s3_); \
      _Pragma("unroll") for (int i = 0; i < 16; ++i) cum[i] += off_; }

constexpr int HG_QR = 0, HG_KR = 17408, HG_QD = 34816, HG_VT = 52224, HG_KDT = 70656, HG_SEG = 89088, HG_SSL = 91136;

DI void hg_u_unit(LAS unsigned char* lds, const bf16_t* zB, const float* lbv, bf16_t* ST, float* dC, int b, int h, int c, int wv) {
    const int tid = otid(wv), lane = tid & 63, w = __builtin_amdgcn_readfirstlane(tid >> 6), l32 = lane & 31, hi = lane >> 5;
    LAS float* segs = (LAS float*)(lds + HG_SEG);
    HG_PREP();
    const int unit = (b * 4 + h) * 128 + c;
    {
        float kd[16]; unsigned vr[8];
#pragma unroll
        for (int i = 0; i < 16; ++i) kd[i] = kv[i] * __expf(blast - cum[i]);
#pragma unroll
        for (int i = 0; i < 8; ++i) { const unsigned lo = zB[(row0 + 2 * i) * 2048 + 1024 + h * 128 + k], hi2 = zB[(row0 + 2 * i + 1) * 2048 + 1024 + h * 128 + k]; vr[i] = lo | (hi2 << 16); }
        LAS unsigned char* kp = lds + HG_KDT + k * 144 + seg * 32;
        *(LAS u32x4*)kp = (u32x4){cvt_pk(kd[0], kd[1]), cvt_pk(kd[2], kd[3]), cvt_pk(kd[4], kd[5]), cvt_pk(kd[6], kd[7])};
        *(LAS u32x4*)(kp + 16) = (u32x4){cvt_pk(kd[8], kd[9]), cvt_pk(kd[10], kd[11]), cvt_pk(kd[12], kd[13]), cvt_pk(kd[14], kd[15])};
        LAS unsigned char* vp = lds + HG_VT + k * 144 + seg * 32;
        *(LAS u32x4*)vp = (u32x4){vr[0], vr[1], vr[2], vr[3]};
        *(LAS u32x4*)(vp + 16) = (u32x4){vr[4], vr[5], vr[6], vr[7]};
        if (seg == 0) dC[(size_t)unit * 128 + k] = __expf(blast);
    }
    __syncthreads();
    {
        const int vb = w & 3;
#pragma unroll
        for (int kbi = 0; kbi < 2; ++kbi) {
            const int kb = 2 * (w >> 2) + kbi;
            f32x16 acc;
#pragma unroll
            for (int r = 0; r < 16; ++r) acc[r] = 0.f;
#pragma unroll
            for (int ks = 0; ks < 4; ++ks) {
                const bf16x8 A = *(const LAS bf16x8*)(lds + HG_VT + (32 * vb + l32) * 144 + (16 * ks + 8 * hi) * 2);
                const bf16x8 B = *(const LAS bf16x8*)(lds + HG_KDT + (32 * kb + l32) * 144 + (16 * ks + 8 * hi) * 2);
                acc = MFMA32(A, B, acc);
            }
            bf16_t* sp = ST + (size_t)unit * 16384 + 32 * kb + l32;
#pragma unroll
            for (int r = 0; r < 16; ++r) sp[(32 * vb + crow(r, hi)) * 128] = f2bf(acc[r]);
        }
    }
    __syncthreads();
}

DI void hg_out_unit(LAS unsigned char* lds, const bf16_t* zB, const float* lbv, const bf16_t* ST, const float* hnorm, bf16_t* Ob, int b, int h, int c, int wv) {
    const int tid = otid(wv), lane = tid & 63, w = __builtin_amdgcn_readfirstlane(tid >> 6), l32 = lane & 31, hi = lane >> 5;
    LAS float* segs = (LAS float*)(lds + HG_SEG);
    LAS float* ssl = (LAS float*)(lds + HG_SSL);
    HG_PREP();
    const int unit = (b * 4 + h) * 128 + c;
    {
        LAS bf16_t* Qr = (LAS bf16_t*)(lds + HG_QR); LAS bf16_t* Kr = (LAS bf16_t*)(lds + HG_KR); LAS bf16_t* Qd = (LAS bf16_t*)(lds + HG_QD);
        unsigned vr[8];
#pragma unroll
        for (int i = 0; i < 16; ++i) { const int t = 16 * seg + i;
            const float qraw = bf2f(zB[(row0 + i) * 2048 + h * 128 + k]); const float q = qraw * sigm(qraw);
            Qr[t * 136 + k] = f2bf(q * __expf(cum[i] - bref)); Kr[t * 136 + k] = f2bf(kv[i] * __expf(bref - cum[i])); Qd[t * 136 + k] = f2bf(q * __expf(cum[i])); }
#pragma unroll
        for (int i = 0; i < 8; ++i) { const unsigned lo = zB[(row0 + 2 * i) * 2048 + 1024 + h * 128 + k], hi2 = zB[(row0 + 2 * i + 1) * 2048 + 1024 + h * 128 + k]; vr[i] = lo | (hi2 << 16); }
        LAS unsigned char* vp = lds + HG_VT + k * 144 + seg * 32;
        *(LAS u32x4*)vp = (u32x4){vr[0], vr[1], vr[2], vr[3]};
        *(LAS u32x4*)(vp + 16) = (u32x4){vr[4], vr[5], vr[6], vr[7]};
    }
    __syncthreads();
    const int vb = w & 3, tb = w >> 2;
    f32x16 o;
#pragma unroll
    for (int r = 0; r < 16; ++r) o[r] = 0.f;
    {
        const bf16_t* sp = ST + (size_t)unit * 16384 + (size_t)(32 * vb + l32) * 128 + 8 * hi;
#pragma unroll
        for (int ks = 0; ks < 8; ++ks) {
            const bf16x8 A = *(const bf16x8*)(sp + 16 * ks);
            const bf16x8 B = *(const LAS bf16x8*)(lds + HG_QD + (32 * tb + l32) * 272 + (16 * ks + 8 * hi) * 2);
            o = MFMA32(A, B, o);
        }
    }
#pragma unroll
    for (int sb = 0; sb < 2; ++sb) {
        if (sb <= tb) {
            f32x16 at;
#pragma unroll
            for (int r = 0; r < 16; ++r) at[r] = 0.f;
#pragma unroll
            for (int ks = 0; ks < 8; ++ks) {
                const bf16x8 A = *(const LAS bf16x8*)(lds + HG_KR + (32 * sb + l32) * 272 + (16 * ks + 8 * hi) * 2);
                const bf16x8 B = *(const LAS bf16x8*)(lds + HG_QR + (32 * tb + l32) * 272 + (16 * ks + 8 * hi) * 2);
                at = MFMA32(A, B, at);
            }
            if (sb == tb) {
#pragma unroll
                for (int r = 0; r < 16; ++r) if (crow(r, hi) > l32) at[r] = 0.f;
            }
#pragma unroll
            for (int sub = 0; sub < 2; ++sub) {
                const bf16x8 P = pack8(at[8 * sub + 0], at[8 * sub + 1], at[8 * sub + 2], at[8 * sub + 3], at[8 * sub + 4], at[8 * sub + 5], at[8 * sub + 6], at[8 * sub + 7]);
                const int koff = (32 * sb + 16 * sub + 4 * hi) * 2;
                const u32x2 al = *(const LAS u32x2*)(lds + HG_VT + (32 * vb + l32) * 144 + koff), ah = *(const LAS u32x2*)(lds + HG_VT + (32 * vb + l32) * 144 + koff + 16);
                o = MFMA32(mk8(al, ah), P, o);
            }
        }
    }
    float ss = 0.f;
#pragma unroll
    for (int r = 0; r < 16; ++r) ss += o[r] * o[r];
    ss += __shfl_xor(ss, 32);
    if (hi == 0) ssl[vb * 64 + 32 * tb + l32] = ss;
    __syncthreads();
    {
        const int t = 32 * tb + l32;
        const float tot = (ssl[t] + ssl[64 + t]) + (ssl[128 + t] + ssl[192 + t]);
        const float rstd = rsqrtf(tot * (1.0f / 128.0f) + EPS);
        const size_t row = (size_t)b * SEQ + (size_t)c * 64 + t;
#pragma unroll
        for (int g = 0; g < 4; ++g) {
            const int v0 = 32 * vb + 8 * g + 4 * hi;
            const u32x2 gr = *(const u32x2*)(zB + row * 2048 + 1536 + h * 128 + v0);
            const f32x4 hn = *(const f32x4*)(hnorm + v0);
            const float g0 = bflo(gr.x), g1 = bfhi(gr.x), g2 = bflo(gr.y), g3 = bfhi(gr.y);
            u32x2 ow;
            ow.x = cvt_pk(o[4 * g] * rstd * hn[0] * (g0 * sigm(g0)), o[4 * g + 1] * rstd * hn[1] * (g1 * sigm(g1)));
            ow.y = cvt_pk(o[4 * g + 2] * rstd * hn[2] * (g2 * sigm(g2)), o[4 * g + 3] * rstd * hn[3] * (g3 * sigm(g3)));
            *(u32x2*)(Ob + row * 512 + h * 128 + v0) = ow;
        }
    }
    __syncthreads();
}

constexpr size_t MiB = 1u << 20;
constexpr size_t WS_X0 = 0, WS_R2 = 32 * MiB, WS_R3 = 96 * MiB, WS_X1 = 128 * MiB, WS_R1 = 160 * MiB, WS_R4 = 184 * MiB, WS_RW = 216 * MiB;
constexpr size_t WS_P = 241 * MiB, WS_PA = 242 * MiB, WS_CS = 244 * MiB, WS_DC = 246 * MiB, WS_MEMB = 247 * MiB, WS_KM = 248 * MiB, WS_VMT = 249 * MiB, WS_MISC = 250 * MiB, WS_END = 251 * MiB;
constexpr size_t W1_IN = 0, W1_UQ = W1_IN + (size_t)6912 * 1024, W1_UKV = W1_UQ + (size_t)768 * 384, W1_BA = W1_UKV + (size_t)1024 * 256, W1_BB = W1_BA + (size_t)1024 * 512,
                 W1_BC = W1_BB + (size_t)1024 * 512, W1_MIX = W1_BC + (size_t)1024 * 512, W1_END = W1_MIX + (size_t)1024 * 1024;
constexpr size_t W2_XQ = 0, W2_XKV = W2_XQ + (size_t)1024 * 1024, W2_XO = W2_XKV + (size_t)2048 * 1024, W2_FI = W2_XO + (size_t)1024 * 1024, W2_FO = W2_FI + (size_t)5632 * 1024, W2_END = W2_FO + (size_t)1024 * 2816;
static_assert(W1_END * 2 <= 25 * MiB && W2_END * 2 <= 25 * MiB, "weight region");

constexpr int LDS_BYTES = 147456;

struct Args { const float* in[28]; float* out; unsigned char* ws; };

constexpr int PTAB_OFF = 135168;
DI void* ldptr(LAS unsigned char* lds, int i) {
    unsigned off_ = PTAB_OFF + 8 * i; asm volatile("" : "+v"(off_));
    const LAS unsigned* t = (const LAS unsigned*)(lds + off_);
    const unsigned lo = __builtin_amdgcn_readfirstlane(t[0]), hi = __builtin_amdgcn_readfirstlane(t[1]);
    return (void*)(((unsigned long long)hi << 32) | (unsigned long long)lo);
}
#define INP(i) ((const float*)ldptr(lds, (i)))
#define PH_HEAD() \
    int G = G0_, bid = bid0_; asm volatile("" : "+s"(G), "+s"(bid)); \
    int wv = wv0_; asm volatile("" : "+s"(wv)); const int tid = otid(wv), lane = tid & 63, wave = wv; \
    const int gw = bid * 8 + wave, NGW = G * 8; (void)lane; (void)gw; (void)NGW; \
    unsigned char* ws = (unsigned char*)ldptr(lds, 29); \
    bf16_t* const X0 = (bf16_t*)(ws + WS_X0); bf16_t* const X1 = (bf16_t*)(ws + WS_X1); \
    bf16_t* const R1 = (bf16_t*)(ws + WS_R1); bf16_t* const R2 = (bf16_t*)(ws + WS_R2); bf16_t* const R3 = (bf16_t*)(ws + WS_R3); bf16_t* const R4 = (bf16_t*)(ws + WS_R4); \
    bf16_t* const RW = (bf16_t*)(ws + WS_RW); \
    float* const P = (float*)(ws + WS_P); float* const PA = (float*)(ws + WS_PA); float* const CS = (float*)(ws + WS_CS); float* const dC = (float*)(ws + WS_DC); \
    bf16_t* const memb = (bf16_t*)(ws + WS_MEMB); bf16_t* const Km = (bf16_t*)(ws + WS_KM); bf16_t* const Vmt = (bf16_t*)(ws + WS_VMT); \
    float* const mrstd = (float*)(ws + WS_MISC); float* const lbv = mrstd + 512; \
    bf16_t* const xcur = par ? X1 : X0; bf16_t* const xfree = par ? X0 : X1; \
    bf16_t* const zA = R1; bf16_t* const zB = R2; bf16_t* const zC = R4; \
    bf16_t* const Qb = R3; bf16_t* const Krb = R3 + (size_t)MTOK * 768; \
    bf16_t* const Knb = xfree; bf16_t* const Vtb = xfree + (size_t)MTOK * 512; \
    bf16_t* const Oa = R1; bf16_t* const Ob = xfree; bf16_t* const STb = R3; bf16_t* const Gt = R2; bf16_t* const MX = xcur; \
    bf16_t* const QX = R2; bf16_t* const ACT = R2; float* const xres = (float*)ldptr(lds, 28); \
    (void)X0; (void)X1; (void)R1; (void)R2; (void)R3; (void)R4; (void)RW; (void)P; (void)PA; (void)CS; (void)dC; (void)memb; (void)Km; (void)Vmt; (void)mrstd; (void)lbv; \
    (void)xcur; (void)xfree; (void)zA; (void)zB; (void)zC; (void)Qb; (void)Krb; (void)Knb; (void)Vtb; (void)Oa; (void)Ob; (void)STb; (void)Gt; (void)MX; (void)QX; (void)ACT; (void)xres;

__global__ void __launch_bounds__(512, 2) mega_fwd(Args args) {
    extern __shared__ __attribute__((aligned(16))) unsigned char lds_raw[];
    LAS unsigned char* lds = (LAS unsigned char*)lds_raw;
    cg::grid_group grid = cg::this_grid();
    const int G0_ = gridDim.x, bid0_ = blockIdx.x, wv0_ = __builtin_amdgcn_readfirstlane(threadIdx.x >> 6);
    int par = 0;
    if (threadIdx.x == 0) {
        LAS unsigned long long* pt = (LAS unsigned long long*)(lds + PTAB_OFF);
#pragma unroll
        for (int i = 0; i < 28; ++i) pt[i] = (unsigned long long)args.in[i];
        pt[28] = (unsigned long long)args.out; pt[29] = (unsigned long long)args.ws;
    }
    __syncthreads();

    for (int l = 0; l < 2; ++l) {
        {
            PH_HEAD();
            LAS float* scr = (LAS float*)(lds + wave * 8448);
            const float* w_in = INP(4) + (size_t)l * 1024 * INW; const float* mixn = INP(3) + l * 1024;
            const float* wuq = INP(6) + (size_t)l * 384 * 768; const float* qn = INP(5) + l * 384;
            const float* wukv = INP(8) + (size_t)l * 256 * 1024; const float* kvn = INP(7) + l * 256;
            const float* wba = INP(15) + (size_t)l * 512 * 1024; const float* wbb = INP(16) + (size_t)l * 512 * 1024; const float* wbc = INP(17) + (size_t)l * 512 * 1024;
            const float* wmx = INP(18) + (size_t)l * 1024 * 1024;
            constexpr int I_IN = 16 * 216, I_UQ = 6 * 24, I_UKV = 4 * 32, I_B = 8 * 32, I_MX = 16 * 32;
            constexpr int NIT = I_IN + I_UQ + I_UKV + 3 * I_B + I_MX;
            for (int it = gw; it < NIT; it += NGW) {
                int r = it;
                if (r < I_IN) { conv_item(w_in, 1024, INW, 6912, 1, mixn, RW + W1_IN, scr, r, lane); continue; } r -= I_IN;
                if (r < I_UQ) { conv_item(wuq, 384, 768, 768, 0, qn, RW + W1_UQ, scr, r, lane); continue; } r -= I_UQ;
                if (r < I_UKV) { conv_item(wukv, 256, 1024, 1024, 0, kvn, RW + W1_UKV, scr, r, lane); continue; } r -= I_UKV;
                if (r < I_B) { conv_item(wba, 512, 1024, 1024, 0, nullptr, RW + W1_BA, scr, r, lane); continue; } r -= I_B;
                if (r < I_B) { conv_item(wbb, 512, 1024, 1024, 0, nullptr, RW + W1_BB, scr, r, lane); continue; } r -= I_B;
                if (r < I_B) { conv_item(wbc, 512, 1024, 1024, 0, nullptr, RW + W1_BC, scr, r, lane); continue; } r -= I_B;
                conv_item(wmx, 1024, 1024, 1024, 0, nullptr, RW + W1_MIX, scr, r, lane);
            }
            if (l == 0) {
                const float* xin0 = INP(0);
                for (int m = gw; m < MTOK; m += NGW) {
                    const f32x4* xr = (const f32x4*)(xin0 + (size_t)m * 1024) + lane; float s = 0.f;
                    unsigned long long* o8 = (unsigned long long*)(xcur + (size_t)m * 1024) + lane;
#pragma unroll
                    for (int j = 0; j < 4; ++j) { const f32x4 v = xr[64 * j]; s += dot4(v); o8[64 * j] = (unsigned long long)cvt_pk(v.x, v.y) | ((unsigned long long)cvt_pk(v.z, v.w) << 32); }
                    s = wave_sum(s);
                    if (lane < 16) P[(size_t)m * 16 + lane] = (lane == 0) ? s : 0.f;
                }
                for (int m = gw; m < NB * NMEM; m += NGW) {
                    const f32x4* xr = (const f32x4*)(INP(1) + (size_t)m * 1024) + lane; float s = 0.f;
                    unsigned long long* o8 = (unsigned long long*)(memb + (size_t)m * 1024) + lane;
#pragma unroll
                    for (int j = 0; j < 4; ++j) { const f32x4 v = xr[64 * j]; s += dot4(v); o8[64 * j] = (unsigned long long)cvt_pk(v.x, v.y) | ((unsigned long long)cvt_pk(v.z, v.w) << 32); }
                    s = wave_sum(s);
                    if (lane == 0) mrstd[m] = rsqrtf(s * (1.0f / 1024.0f) + EPS);
                }
                const int* pos = (const int*)INP(2);
                for (int idx = bid * 512 + tid; idx < MTOK * 16; idx += G * 512) {
                    const int row = idx >> 4, j = idx & 15;
                    const float invf = powf(10000.0f, -(float)(2 * j) / 32.0f);
                    const float ang = (float)pos[row] * invf;
                    double tt = (double)ang * 0.15915494309189535; tt -= rint(tt);
                    const float rv = (float)tt;
                    CS[(size_t)row * 32 + j] = __builtin_amdgcn_cosf(rv); CS[(size_t)row * 32 + 16 + j] = __builtin_amdgcn_sinf(rv);
                }
                for (int idx = bid * 512 + tid; idx < 512; idx += G * 512) {
                    const float p0 = INP(9)[idx], p1 = INP(9)[512 + idx];
                    lbv[idx] = 0.f; lbv[512 + idx] = 1.0f / (1.0f + expf(p0 - p1));
                }
            }
        }
        __syncthreads();
        grid.sync();
        {
            PH_HEAD();
            pg8::Gemm g{xcur, RW + W1_IN, MTOK, 3840, 1024, 1024, 1024}; pg8::StaticOrder S; S.init(MTOK, 3840, G, bid);
            EpiA E{P, zA, zB, zC, PA};
            pg8::gemm_phase<EpiA>(lds, g, S, E, wv);
        }
        grid.sync();
        {
            PH_HEAD();
            for (int idx = bid * 512 + tid; idx < MTOK * 16; idx += G * 512) {
                const int row = idx >> 4, j = idx & 15;
                const float x1 = bf2f(zA[(size_t)row * 768 + 640 + j]), x2 = bf2f(zA[(size_t)row * 768 + 656 + j]);
                const float cs = CS[(size_t)row * 32 + j], sn = CS[(size_t)row * 32 + 16 + j];
                Krb[(size_t)row * 32 + j] = f2bf(x1 * cs - x2 * sn); Krb[(size_t)row * 32 + 16 + j] = f2bf(x1 * sn + x2 * cs);
            }
            { pg8::Gemm g{zA, RW + W1_UQ, MTOK, 768, 384, 768, 384}; pg8::StaticOrder S; S.init(MTOK, 768, G, bid);
              EpiQ E{PA, CS, Qb}; pg8::gemm_phase<EpiQ>(lds, g, S, E, wv); }
            { pg8::Gemm g{zA + 384, RW + W1_UKV, MTOK, 1024, 256, 768, 256}; pg8::StaticOrder S; S.init(MTOK, 1024, G, bid);
              EpiKV E{PA, Knb, Vtb}; pg8::gemm_phase<EpiKV>(lds, g, S, E, wv); }
        }
        __syncthreads();
        grid.sync();
        {
            PH_HEAD();
            for (int item = bid; item < 256; item += G) {
                const int b = item >> 7, h = (item >> 4) & 7, s = item & 15;
                attn_unit(lds, Qb, Knb, Krb, Vtb, Oa, b, h, 31 - s, wv);
                attn_unit(lds, Qb, Knb, Krb, Vtb, Oa, b, h, s, wv);
            }
            const float* lng = INP(11) + l * 512; const float* lnb = INP(12) + l * 512;
            const float* wsp = INP(13) + (size_t)l * 4 * 128 * 128; const float* bsp = INP(14) + l * 512;
            for (int u = bid; u < 512; u += G) gmlp_unit(lds, zC, lng, lnb, wsp, bsp, u >> 2, u & 3, wv);
        }
        grid.sync();
        {
            PH_HEAD();
            for (int u = bid; u < 1024; u += G) hg_u_unit(lds, zB, lbv + l * 512, STb, dC, u >> 9, (u >> 7) & 3, u & 127, wv);
        }
        grid.sync();
        {
            PH_HEAD();
            if (tid < 256) {
                for (int p = bid * 256 + tid; p < 65536; p += G * 256) {
                    const int bh = p >> 13, e2 = p & 8191;
                    unsigned* sp = (unsigned*)STb + (size_t)bh * 128 * 8192 + e2;
                    const float* dp = dC + (size_t)bh * 128 * 128 + ((2 * e2) & 127);
                    float S0 = 0.f, S1 = 0.f;
                    for (int c0 = 0; c0 < 128; c0 += 16) {
                        unsigned uu[16]; f32x2 dd[16];
#pragma unroll
                        for (int i = 0; i < 16; ++i) { uu[i] = sp[(size_t)(c0 + i) * 8192]; dd[i] = *(const f32x2*)(dp + (size_t)(c0 + i) * 128); }
#pragma unroll
                        for (int i = 0; i < 16; ++i) { sp[(size_t)(c0 + i) * 8192] = cvt_pk(S0, S1); S0 = dd[i].x * S0 + bflo(uu[i]); S1 = dd[i].y * S1 + bfhi(uu[i]); }
                    }
                }
            }
        }
        grid.sync();
        {
            PH_HEAD();
            for (int u = bid; u < 1024; u += G) hg_out_unit(lds, zB, lbv + l * 512, STb, INP(10) + l * 128, Ob, u >> 9, (u >> 7) & 3, u & 127, wv);
        }
        grid.sync();
        {
            PH_HEAD();
            pg8::Gemm g{xcur, RW + W1_IN + (size_t)3840 * 1024, MTOK, 3072, 1024, 1024, 1024}; pg8::StaticOrder S; S.init(MTOK, 3072, G, bid);
            EpiPlain<true> E{P, Gt, 3072, 1.0f};
            pg8::gemm_phase<EpiPlain<true>>(lds, g, S, E, wv);
        }
        grid.sync();
        {
            PH_HEAD();
            pg8::StaticOrder S; S.init(MTOK, 1024, G, bid);
            { pg8::Gemm g{Oa, RW + W1_BA, MTOK, 1024, 512, 512, 512}; EpiBr E{Gt, MX, 0}; pg8::gemm_phase<EpiBr>(lds, g, S, E, wv); }
            { pg8::Gemm g{Ob, RW + W1_BB, MTOK, 1024, 512, 512, 512}; EpiBr E{Gt, MX, 1}; pg8::gemm_phase<EpiBr>(lds, g, S, E, wv); }
            { pg8::Gemm g{zC, RW + W1_BC, MTOK, 1024, 512, 1024, 512}; EpiBr E{Gt, MX, 2}; pg8::gemm_phase<EpiBr>(lds, g, S, E, wv); }
        }
        grid.sync();
        {
            PH_HEAD();
            pg8::Gemm g{MX, RW + W1_MIX, MTOK, 1024, 1024, 1024, 1024}; pg8::StaticOrder S; S.init(MTOK, 1024, G, bid);
            EpiRes E{l == 0 ? INP(0) : (const float*)xres, xres, xfree, P};
            pg8::gemm_phase<EpiRes>(lds, g, S, E, wv);
        }
        par ^= 1;
        grid.sync();
        {
            PH_HEAD();
            LAS float* scr = (LAS float*)(lds + wave * 8448);
            const float* wxq = INP(21) + (size_t)l * 1024 * 1024; const float* xan = INP(19) + l * 1024;
            const float* wxkv = INP(22) + (size_t)l * 1024 * 2048; const float* memn = INP(20) + l * 1024;
            const float* wxo = INP(23) + (size_t)l * 1024 * 1024;
            const float* wfi = INP(25) + (size_t)l * 1024 * 2 * DFF; const float* ffn = INP(24) + l * 1024;
            const float* wfo = INP(26) + (size_t)l * DFF * 1024;
            constexpr int I_XQ = 16 * 32, I_XKV = 16 * 64, I_FI = 16 * 176, I_FO = 44 * 32;
            constexpr int NIT = 2 * I_XQ + I_XKV + I_FI + I_FO;
            for (int it = gw; it < NIT; it += NGW) {
                int r = it;
                if (r < I_XQ) { conv_item(wxq, 1024, 1024, 1024, 0, xan, RW + W2_XQ, scr, r, lane); continue; } r -= I_XQ;
                if (r < I_XKV) { conv_item(wxkv, 1024, 2048, 2048, 0, memn, RW + W2_XKV, scr, r, lane); continue; } r -= I_XKV;
                if (r < I_XQ) { conv_item(wxo, 1024, 1024, 1024, 0, nullptr, RW + W2_XO, scr, r, lane); continue; } r -= I_XQ;
                if (r < I_FI) { conv_item(wfi, 1024, 2 * DFF, 2 * DFF, 2, ffn, RW + W2_FI, scr, r, lane); continue; } r -= I_FI;
                conv_item(wfo, DFF, 1024, 1024, 0, nullptr, RW + W2_FO, scr, r, lane);
            }
        }
        __syncthreads();
        grid.sync();
        {
            PH_HEAD();
            { pg8::Gemm g{xcur, RW + W2_XQ, MTOK, 1024, 1024, 1024, 1024}; pg8::StaticOrder S; S.init(MTOK, 1024, G, bid);
              EpiPlain<false> E{P, QX, 1024, XSC}; pg8::gemm_phase<EpiPlain<false>>(lds, g, S, E, wv); }
            { pg8::Gemm g{memb, RW + W2_XKV, NB * NMEM, 2048, 1024, 1024, 1024}; pg8::StaticOrder S; S.init(NB * NMEM, 2048, G, bid);
              EpiKVm E{mrstd, Km, Vmt}; pg8::gemm_phase<EpiKVm>(lds, g, S, E, wv); }
        }
        grid.sync();
        {
            PH_HEAD();
            for (int u = bid; u < 256; u += G) xattn_unit(lds, QX, Km, Vmt, u >> 7, (u >> 5) & 3, u & 31, wv);
        }
        grid.sync();
        {
            PH_HEAD();
            pg8::Gemm g{QX, RW + W2_XO, MTOK, 1024, 1024, 1024, 1024}; pg8::StaticOrder S; S.init(MTOK, 1024, G, bid);
            EpiRes E{xres, xres, xcur, P};
            pg8::gemm_phase<EpiRes>(lds, g, S, E, wv);
        }
        grid.sync();
        {
            PH_HEAD();
            pg8::Gemm g{xcur, RW + W2_FI, MTOK, 2 * DFF, 1024, 1024, 1024}; pg8::StaticOrder S; S.init(MTOK, 2 * DFF, G, bid);
            EpiFF E{P, ACT};
            pg8::gemm_phase<EpiFF>(lds, g, S, E, wv);
        }
        grid.sync();
        {
            PH_HEAD();
            pg8::Gemm g{ACT, RW + W2_FO, MTOK, 1024, DFF, DFF, DFF}; pg8::StaticOrder S; S.init(MTOK, 1024, G, bid);
            EpiRes E{xres, xres, xcur, P};
            pg8::gemm_phase<EpiRes>(lds, g, S, E, wv);
        }
        grid.sync();
    }
    {
        PH_HEAD();
        const float* fn = INP(27);
        for (int m = gw; m < MTOK; m += NGW) {
            const float rs = row_rstd16(P, m);
            f32x4* xr = (f32x4*)(xres + (size_t)m * 1024) + lane; const f32x4* gp = (const f32x4*)fn + lane;
#pragma unroll
            for (int j = 0; j < 4; ++j) { const f32x4 v = xr[64 * j], gg = gp[64 * j]; xr[64 * j] = v * rs * gg; }
        }
    }
}

extern "C" void kernel_launch(void* const* d_in, const int* in_sizes, int n_in, void* d_out, int out_size, void* d_ws, size_t ws_size, hipStream_t stream) {
    static int grid = 0;
    if (grid == 0) {
        if (n_in != 28 || out_size != MTOK * DM || ws_size < WS_END) { fprintf(stderr, "kernel_launch: unexpected problem (n_in %d out %d ws %zu)\n", n_in, out_size, ws_size); grid = -1; return; }
        int dev = 0, cus = 0, per_cu = 0;
        (void)hipGetDevice(&dev);
        (void)hipDeviceGetAttribute(&cus, hipDeviceAttributeMultiprocessorCount, dev);
        (void)hipFuncSetAttribute((const void*)mega_fwd, hipFuncAttributeMaxDynamicSharedMemorySize, LDS_BYTES);
        (void)hipOccupancyMaxActiveBlocksPerMultiprocessor(&per_cu, (const void*)mega_fwd, 512, LDS_BYTES);
        if (per_cu < 1 || cus < 1) { fprintf(stderr, "kernel_launch: occupancy query gave %d blocks/CU on %d CUs\n", per_cu, cus); grid = -1; return; }
        grid = cus;
    }
    if (grid < 0) return;
    Args a{};
    for (int i = 0; i < 28; ++i) a.in[i] = (const float*)d_in[i];
    a.out = (float*)d_out; a.ws = (unsigned char*)d_ws;
    void* kargs[] = {&a};
    hipError_t e = hipLaunchCooperativeKernel((const void*)mega_fwd, dim3(grid), dim3(512), kargs, LDS_BYTES, stream);
    if (e != hipSuccess) fprintf(stderr, "cooperative launch failed: %s (grid %d)\n", hipGetErrorString(e), grid);
}
```

```cpp
#include <hip/hip_runtime.h>
#include <hip/hip_cooperative_groups.h>
#include <cstdio>
#include <cstdint>
namespace cg = cooperative_groups;

#define LAS __attribute__((address_space(3)))
#define DI __device__ __forceinline__
typedef unsigned short bf16_t;
typedef short bf16x8 __attribute__((ext_vector_type(8)));
typedef float f32x2 __attribute__((ext_vector_type(2)));
typedef float f32x4 __attribute__((ext_vector_type(4)));
typedef float f32x16 __attribute__((ext_vector_type(16)));
typedef unsigned u32x2 __attribute__((ext_vector_type(2)));
typedef unsigned u32x4 __attribute__((ext_vector_type(4)));

constexpr int SEQ = 8192, NB = 2, MTOK = NB * SEQ, DM = 1024, NMEM = 256;
constexpr int INW = 6816, DFF = 2816;
constexpr float EPS = 1e-6f;
constexpr float QSC = 0.10206207261596575f * 1.4426950408889634f;
constexpr float XSC = 0.0625f * 1.4426950408889634f;

DI unsigned cvt_pk(float lo, float hi) {
    typedef __bf16 b2 __attribute__((ext_vector_type(2)));
    f32x2 v = {lo, hi}; b2 b = __builtin_convertvector(v, b2); return __builtin_bit_cast(unsigned, b);
}
DI bf16_t f2bf(float f) { return (bf16_t)(cvt_pk(f, 0.f) & 0xffffu); }
DI float bf2f(bf16_t h) { return __uint_as_float((unsigned)h << 16); }
DI float bflo(unsigned w) { return __uint_as_float(w << 16); }
DI float bfhi(unsigned w) { return __uint_as_float(w & 0xffff0000u); }
DI int olane() { int t = __builtin_amdgcn_mbcnt_hi(~0u, __builtin_amdgcn_mbcnt_lo(~0u, 0u)); asm volatile("" : "+v"(t)); return t; }
DI int otid(int wv) { return wv * 64 + olane(); }
DI float wave_sum(float v) {
#pragma unroll
    for (int o = 1; o < 64; o <<= 1) v += __shfl_xor(v, o);
    return v;
}
DI float sigm(float x) { return __builtin_amdgcn_rcpf(1.f + __expf(-x)); }
DI float gelu_erf(float x) { return 0.5f * x * (1.f + erff(x * 0.7071067811865476f)); }
DI int crow(int r, int h) { return (r & 3) + 8 * (r >> 2) + 4 * h; }
DI float dot4(f32x4 a) { return (a.x * a.x + a.y * a.y) + (a.z * a.z + a.w * a.w); }
DI float sum4(f32x4 a) { return (a.x + a.y) + (a.z + a.w); }
#define MFMA32(a, b, c) __builtin_amdgcn_mfma_f32_32x32x16_bf16((a), (b), (c), 0, 0, 0)
DI bf16x8 mk8(u32x2 lo, u32x2 hi) { u32x4 v = {lo.x, lo.y, hi.x, hi.y}; return __builtin_bit_cast(bf16x8, v); }
DI bf16x8 pack8(float a0, float a1, float a2, float a3, float a4, float a5, float a6, float a7) {
    u32x4 v = {cvt_pk(a0, a1), cvt_pk(a2, a3), cvt_pk(a4, a5), cvt_pk(a6, a7)}; return __builtin_bit_cast(bf16x8, v);
}

namespace pg8 {
constexpr int BM = 256, BK = 64, HALF = 128, HTB = HALF * BK * 2, STAGE_BYTES = 8 * HTB, NXCD = 8, WGM = 8;
DI int lds_byte(int r, int c) { const int st = (r >> 4) * 2 + (c >> 5), rr = r & 15, cc = c & 31, ob = rr * 64 + cc * 2; return st * 1024 + (ob ^ (((ob >> 9) & 1) << 5)); }
DI void stage_rc(int b, int& R, int& C) { const int st = b / 1024, sb = b % 1024, swz = sb ^ (((sb >> 9) & 1) << 5); R = (st >> 1) * 16 + swz / 64; C = (st & 1) * 32 + (swz % 64) / 2; }
DI int perm32(int rho) { const int n = rho >> 4, i = rho & 15; return 8 * (i >> 2) + 4 * n + (i & 3); }
struct Unit { int pm, pn; };
struct Gemm { const bf16_t* A; const bf16_t* Bt; int M, N, K, lda, ldb; };
struct StaticOrder {
    int nM, nN, nwg, G, c;
    DI void init(int M, int N, int G_, int c_) { nM = M / BM; nN = N / BM; nwg = nM * nN; G = G_; c = c_; }
    DI bool next(int i, Unit& u) const {
        const long L = (long)i * G + c; if (L >= nwg) return false;
        int wgid = (int)L; { const int q = nwg / NXCD, r = nwg % NXCD, xcd = wgid % NXCD, off = wgid / NXCD; wgid = (xcd < r ? xcd * (q + 1) : r * (q + 1) + (xcd - r) * q) + off; }
        const int nig = WGM * nN, gid = wgid / nig, fm = gid * WGM, gsz = (nM - fm) < WGM ? (nM - fm) : WGM;
        u.pm = fm + ((wgid % nig) % gsz); u.pn = (wgid % nig) / gsz; return true;
    }
};
template <class Epi>
DI void gemm_phase(LAS unsigned char* lds, const Gemm g, const StaticOrder& S, const Epi& E, int wv) {
    const int tid = otid(wv), wid = __builtin_amdgcn_readfirstlane(tid >> 6), lane = tid & 63, wr = wid >> 2, wc = wid & 3, fr = lane & 15, fq = lane >> 4;
    const int K = g.K, nt = K / BK;
    unsigned voffA[2], voffB[2];
#pragma unroll
    for (int i = 0; i < 2; ++i) { int R, C; stage_rc(tid * 16 + i * 8192, R, C); const int Rb = Epi::PERM ? ((R & ~31) + perm32(R & 31)) : R;
        voffA[i] = (unsigned)(R * g.lda + C) * 2u; voffB[i] = (unsigned)(Rb * g.ldb + C) * 2u; }
    const size_t kstep = (size_t)(BK * 2);
    const size_t hsA = (size_t)HALF * g.lda * 2, hsB = (size_t)HALF * g.ldb * 2;
    const size_t tsA = 2 * hsA, tsB = 2 * hsB;
    const unsigned ldsw = (unsigned)wid * 1024u;
    const int aoff = lds_byte(wr * 64 + fr, fq * 8), boff = lds_byte(wc * 32 + fr, fq * 8);
#define PG8_SA(b, h) (((b) * 2 + (h)) * HTB)
#define PG8_SB(b, h) ((4 + (b) * 2 + (h)) * HTB)
#define PG8_STAGE(bufoff, gbase, voff) do { _Pragma("unroll") for (int _i = 0; _i < 2; ++_i) \
        __builtin_amdgcn_global_load_lds((const unsigned*)((const char*)(gbase) + (voff)[_i]), (LAS unsigned*)(lds + (bufoff) + ldsw + _i * 8192), 16, 0, 0); } while (0)
#define PG8_LDA(dst, b, h) do { _Pragma("unroll") for (int m = 0; m < 4; ++m) _Pragma("unroll") for (int k = 0; k < 2; ++k) dst[m][k] = *(const LAS bf16x8*)(lds + PG8_SA(b, h) + aoff + m * 2048 + k * 1024); } while (0)
#define PG8_LDB(dst, b, h) do { _Pragma("unroll") for (int n = 0; n < 2; ++n) _Pragma("unroll") for (int k = 0; k < 2; ++k) dst[n][k] = *(const LAS bf16x8*)(lds + PG8_SB(b, h) + boff + n * 2048 + k * 1024); } while (0)
#define PG8_MMA(ai, bj, At, Bt) do { __builtin_amdgcn_s_setprio(1); _Pragma("unroll") for (int m = 0; m < 4; ++m) _Pragma("unroll") for (int n = 0; n < 2; ++n) _Pragma("unroll") for (int k = 0; k < 2; ++k) \
        acc[ai][bj][m][n] = __builtin_amdgcn_mfma_f32_16x16x32_bf16(Bt[n][k], At[m][k], acc[ai][bj][m][n], 0, 0, 0); __builtin_amdgcn_s_setprio(0); } while (0)
#define PG8_WAIT_V(n) asm volatile("s_waitcnt vmcnt(" #n ")" ::: "memory")
#define PG8_WAIT_L(n) asm volatile("s_waitcnt lgkmcnt(" #n ")" ::: "memory")
#define PG8_BAR __builtin_amdgcn_s_barrier()
#define PG8_SCHED __builtin_amdgcn_sched_barrier(0)
    Unit cur, nxt; int ui = 0;
    if (!S.next(0, cur)) return;
    f32x4 acc[2][2][4][2];
#pragma unroll
    for (int a = 0; a < 2; ++a)
#pragma unroll
        for (int b = 0; b < 2; ++b)
#pragma unroll
            for (int m = 0; m < 4; ++m)
#pragma unroll
                for (int n = 0; n < 2; ++n) acc[a][b][m][n] = (f32x4){0.f, 0.f, 0.f, 0.f};
    bf16x8 At[4][2], B0[2][2], B1[2][2];
    const char* cA = (const char*)g.A + (size_t)cur.pm * tsA; const char* cB = (const char*)g.Bt + (size_t)cur.pn * tsB;
    PG8_STAGE(PG8_SB(0, 0), cB, voffB); PG8_STAGE(PG8_SB(0, 1), cB + hsB, voffB); PG8_STAGE(PG8_SA(0, 0), cA, voffA); PG8_STAGE(PG8_SA(0, 1), cA + hsA, voffA);
    if (wr == 1) PG8_BAR;
    PG8_WAIT_V(2); PG8_BAR;
    PG8_STAGE(PG8_SB(1, 0), cB + kstep, voffB); PG8_STAGE(PG8_SA(1, 0), cA + kstep, voffA); PG8_STAGE(PG8_SB(1, 1), cB + hsB + kstep, voffB);
    PG8_WAIT_V(6); PG8_BAR;
    for (;;) {
        const bool has_next = S.next(ui + 1, nxt);
        const char* nA = has_next ? (const char*)g.A + (size_t)nxt.pm * tsA : cA; const char* nB = has_next ? (const char*)g.Bt + (size_t)nxt.pn * tsB : cB;
        for (int t = 0; t < nt; t += 2) {
            const bool last = (t == nt - 2);
            const char* a1 = cA + (size_t)(t + 1) * kstep;
            const char* a2 = last ? nA : cA + (size_t)(t + 2) * kstep; const char* b2 = last ? nB : cB + (size_t)(t + 2) * kstep;
            const char* a3 = a2 + kstep; const char* b3 = b2 + kstep;
            PG8_LDB(B0, 0, 0); PG8_LDB(B1, 0, 1); PG8_SCHED; PG8_LDA(At, 0, 0); PG8_STAGE(PG8_SA(1, 1), a1 + hsA, voffA);
            PG8_WAIT_V(8); PG8_WAIT_L(0); PG8_BAR; PG8_MMA(0, 0, At, B0); PG8_MMA(0, 1, At, B1); PG8_BAR; PG8_SCHED;
            PG8_LDA(At, 0, 1); PG8_STAGE(PG8_SB(0, 0), b2, voffB); PG8_STAGE(PG8_SB(0, 1), b2 + hsB, voffB); PG8_STAGE(PG8_SA(0, 0), a2, voffA);
            PG8_WAIT_V(8); PG8_WAIT_L(0); PG8_BAR; PG8_MMA(1, 0, At, B0); PG8_MMA(1, 1, At, B1); PG8_BAR; PG8_SCHED;
            PG8_LDB(B0, 1, 0); PG8_LDB(B1, 1, 1); PG8_SCHED; PG8_LDA(At, 1, 0); PG8_STAGE(PG8_SA(0, 1), a2 + hsA, voffA);
            PG8_WAIT_V(8); PG8_WAIT_L(0); PG8_BAR; PG8_MMA(0, 0, At, B0); PG8_MMA(0, 1, At, B1); PG8_BAR; PG8_SCHED;
            PG8_LDA(At, 1, 1); PG8_STAGE(PG8_SB(1, 0), b3, voffB); PG8_STAGE(PG8_SB(1, 1), b3 + hsB, voffB); PG8_STAGE(PG8_SA(1, 0), a3, voffA);
            PG8_WAIT_V(8); PG8_WAIT_L(0); PG8_BAR; PG8_MMA(1, 0, At, B0); PG8_MMA(1, 1, At, B1); PG8_BAR; PG8_SCHED;
        }
        if (wr == 0) PG8_BAR;
        { const int ln_ = olane(); E(acc, cur, wr, wc, ln_ & 15, ln_ >> 4); }
        if (!has_next) break;
#pragma unroll
        for (int a = 0; a < 2; ++a)
#pragma unroll
            for (int b = 0; b < 2; ++b)
#pragma unroll
                for (int m = 0; m < 4; ++m)
#pragma unroll
                    for (int n = 0; n < 2; ++n) acc[a][b][m][n] = (f32x4){0.f, 0.f, 0.f, 0.f};
        cur = nxt; cA = nA; cB = nB; ++ui;
        if (wr == 1) PG8_BAR;
    }
    PG8_WAIT_V(0);
    PG8_BAR;
#undef PG8_SA
#undef PG8_SB
#undef PG8_STAGE
#undef PG8_LDA
#undef PG8_LDB
#undef PG8_MMA
#undef PG8_WAIT_V
#undef PG8_WAIT_L
#undef PG8_BAR
#undef PG8_SCHED
}
}
typedef const f32x4 (&AccRef)[2][2][4][2];

DI float row_rstd16(const float* P, int row) {
    const f32x4* p = (const f32x4*)(P + (size_t)row * 16);
    const float s = (sum4(p[0]) + sum4(p[1])) + (sum4(p[2]) + sum4(p[3]));
    return rsqrtf(s * (1.0f / 1024.0f) + EPS);
}
DI u32x4 pk16(f32x4 v0, f32x4 v1) { u32x4 w; w.x = cvt_pk(v0[0], v0[1]); w.y = cvt_pk(v0[2], v0[3]); w.z = cvt_pk(v1[0], v1[1]); w.w = cvt_pk(v1[2], v1[3]); return w; }
DI u32x2 pk8(f32x4 v) { u32x2 w; w.x = cvt_pk(v[0], v[1]); w.y = cvt_pk(v[2], v[3]); return w; }

struct EpiA { static constexpr bool PERM = true;
    const float* P; bf16_t* zA; bf16_t* zB; bf16_t* zC; float* PA;
    DI void operator()(AccRef acc, const pg8::Unit& u, int wr, int wc, int fr, int fq) const {
        const int pn = u.pn; bf16_t* base; int ld, colt;
        if (pn < 3) { base = zA; ld = 768; colt = pn * 256; } else if (pn < 11) { base = zB; ld = 2048; colt = (pn - 3) * 256; } else { base = zC; ld = 1024; colt = (pn - 11) * 256; }
        const int row0 = u.pm * 256 + wr * 64 + fr, col0 = colt + wc * 32 + 8 * fq;
#pragma unroll
        for (int ai = 0; ai < 2; ++ai)
#pragma unroll
            for (int m = 0; m < 4; ++m) { const int row = row0 + ai * 128 + m * 16; const float rs = row_rstd16(P, row);
#pragma unroll
                for (int bj = 0; bj < 2; ++bj) { const f32x4 v0 = acc[ai][bj][m][0] * rs, v1 = acc[ai][bj][m][1] * rs;
                    if (pn < 3) { float s = dot4(v0) + dot4(v1); s += __shfl_xor(s, 16); s += __shfl_xor(s, 32); if (fq == 0) PA[(size_t)row * 32 + pn * 8 + bj * 4 + wc] = s; }
                    *(u32x4*)(base + (size_t)row * ld + col0 + bj * 128) = pk16(v0, v1); } }
    }
};
template <bool SIG> struct EpiPlain { static constexpr bool PERM = true;
    const float* P; bf16_t* O; int ldo; float scale;
    DI void operator()(AccRef acc, const pg8::Unit& u, int wr, int wc, int fr, int fq) const {
        const int row0 = u.pm * 256 + wr * 64 + fr, col0 = u.pn * 256 + wc * 32 + 8 * fq;
#pragma unroll
        for (int ai = 0; ai < 2; ++ai)
#pragma unroll
            for (int m = 0; m < 4; ++m) { const int row = row0 + ai * 128 + m * 16; const float rs = row_rstd16(P, row) * scale;
#pragma unroll
                for (int bj = 0; bj < 2; ++bj) { f32x4 v0 = acc[ai][bj][m][0] * rs, v1 = acc[ai][bj][m][1] * rs;
                    if (SIG) {
#pragma unroll
                        for (int e = 0; e < 4; ++e) { v0[e] = sigm(v0[e]); v1[e] = sigm(v1[e]); } }
                    *(u32x4*)(O + (size_t)row * ldo + col0 + bj * 128) = pk16(v0, v1); } }
    }
};
struct EpiQ { static constexpr bool PERM = false;
    const float* PA; const float* CS; bf16_t* Q;
    DI void operator()(AccRef acc, const pg8::Unit& u, int wr, int wc, int fr, int fq) const {
        const int row0 = u.pm * 256 + wr * 64 + fr;
#pragma unroll
        for (int ai = 0; ai < 2; ++ai)
#pragma unroll
            for (int m = 0; m < 4; ++m) { const int row = row0 + ai * 128 + m * 16;
                const f32x4* pp = (const f32x4*)(PA + (size_t)row * 32);
                const float ss = sum4(pp[0]) + sum4(pp[1]) + sum4(pp[2]);
                const float rs = rsqrtf(ss * (1.0f / 384.0f) + EPS);
                const f32x4 cs = *(const f32x4*)(CS + (size_t)row * 32 + 4 * fq), sn = *(const f32x4*)(CS + (size_t)row * 32 + 16 + 4 * fq);
#pragma unroll
                for (int bj = 0; bj < 2; ++bj) { const int g32 = u.pn * 8 + bj * 4 + wc;
                    f32x4 v0 = acc[ai][bj][m][0] * rs, v1 = acc[ai][bj][m][1] * rs;
                    if ((g32 % 3) == 2) { const f32x4 y0 = v0 * cs - v1 * sn, y1 = v0 * sn + v1 * cs; v0 = y0; v1 = y1; }
                    v0 = v0 * QSC; v1 = v1 * QSC;
                    bf16_t* o = Q + (size_t)row * 768 + u.pn * 256 + bj * 128 + wc * 32 + 4 * fq;
                    *(u32x2*)(o) = pk8(v0); *(u32x2*)(o + 16) = pk8(v1); } }
    }
};
struct EpiKV { static constexpr bool PERM = true;
    const float* PA; bf16_t* Kn; bf16_t* Vt;
    DI void operator()(AccRef acc, const pg8::Unit& u, int wr, int wc, int fr, int fq) const {
        const int row0 = u.pm * 256 + wr * 64 + fr;
#pragma unroll
        for (int ai = 0; ai < 2; ++ai)
#pragma unroll
            for (int m = 0; m < 4; ++m) { const int row = row0 + ai * 128 + m * 16;
                const f32x4* pp = (const f32x4*)(PA + (size_t)row * 32 + 12);
                const float ss = sum4(pp[0]) + sum4(pp[1]);
                const float rs = rsqrtf(ss * (1.0f / 256.0f) + EPS);
                const int b = row / SEQ, tok = row % SEQ;
#pragma unroll
                for (int bj = 0; bj < 2; ++bj) { const int h = 2 * u.pn + bj;
                    const f32x4 v0 = acc[ai][bj][m][0] * rs, v1 = acc[ai][bj][m][1] * rs;
                    if (wc < 2) { *(u32x4*)(Kn + (size_t)row * 512 + h * 64 + wc * 32 + 8 * fq) = pk16(v0, v1); }
                    else { bf16_t* vp = Vt + ((size_t)(b * 8 + h) * 64 + (wc - 2) * 32 + 8 * fq) * SEQ + tok;
#pragma unroll
                        for (int e = 0; e < 4; ++e) { vp[(size_t)e * SEQ] = f2bf(v0[e]); vp[(size_t)(4 + e) * SEQ] = f2bf(v1[e]); } } } }
    }
};
struct EpiBr { static constexpr bool PERM = true;
    const bf16_t* G; bf16_t* MX; int j;
    DI void operator()(AccRef acc, const pg8::Unit& u, int wr, int wc, int fr, int fq) const {
        const int row0 = u.pm * 256 + wr * 64 + fr, col0 = u.pn * 256 + wc * 32 + 8 * fq;
#pragma unroll
        for (int ai = 0; ai < 2; ++ai)
#pragma unroll
            for (int m = 0; m < 4; ++m) { const int row = row0 + ai * 128 + m * 16;
#pragma unroll
                for (int bj = 0; bj < 2; ++bj) { const int col = col0 + bj * 128;
                    const u32x4 gw = *(const u32x4*)(G + (size_t)row * 3072 + j * 1024 + col);
                    f32x4 v0 = acc[ai][bj][m][0], v1 = acc[ai][bj][m][1];
                    v0[0] *= bflo(gw.x); v0[1] *= bfhi(gw.x); v0[2] *= bflo(gw.y); v0[3] *= bfhi(gw.y);
                    v1[0] *= bflo(gw.z); v1[1] *= bfhi(gw.z); v1[2] *= bflo(gw.w); v1[3] *= bfhi(gw.w);
                    bf16_t* mp = MX + (size_t)row * 1024 + col;
                    if (j > 0) { const u32x4 ow = *(const u32x4*)mp;
                        v0[0] += bflo(ow.x); v0[1] += bfhi(ow.x); v0[2] += bflo(ow.y); v0[3] += bfhi(ow.y);
                        v1[0] += bflo(ow.z); v1[1] += bfhi(ow.z); v1[2] += bflo(ow.w); v1[3] += bfhi(ow.w); }
                    *(u32x4*)mp = pk16(v0, v1); } }
    }
};
struct EpiRes { static constexpr bool PERM = false;
    const float* xin; float* xout; bf16_t* xb; float* P;
    DI void operator()(AccRef acc, const pg8::Unit& u, int wr, int wc, int fr, int fq) const {
        const int row0 = u.pm * 256 + wr * 64 + fr, col0 = u.pn * 256 + wc * 32 + 4 * fq;
#pragma unroll
        for (int ai = 0; ai < 2; ++ai)
#pragma unroll
            for (int m = 0; m < 4; ++m) { const int row = row0 + ai * 128 + m * 16; float s = 0.f;
#pragma unroll
                for (int bj = 0; bj < 2; ++bj)
#pragma unroll
                    for (int n = 0; n < 2; ++n) { const size_t off = (size_t)row * 1024 + col0 + bj * 128 + n * 16;
                        const f32x4 xo = *(const f32x4*)(xin + off) + acc[ai][bj][m][n];
                        *(f32x4*)(xout + off) = xo; *(u32x2*)(xb + off) = pk8(xo); s += dot4(xo); }
                s += __shfl_xor(s, 16); s += __shfl_xor(s, 32);
                if (fq == 0) P[(size_t)row * 16 + u.pn * 4 + wc] = s; }
    }
};
struct EpiKVm { static constexpr bool PERM = true;
    const float* mrstd; bf16_t* Km; bf16_t* Vmt;
    DI void operator()(AccRef acc, const pg8::Unit& u, int wr, int wc, int fr, int fq) const {
        const int row0 = u.pm * 256 + wr * 64 + fr;
#pragma unroll
        for (int ai = 0; ai < 2; ++ai)
#pragma unroll
            for (int m = 0; m < 4; ++m) { const int row = row0 + ai * 128 + m * 16; const float rs = mrstd[row];
                const int b = row >> 8, key = row & 255;
#pragma unroll
                for (int bj = 0; bj < 2; ++bj) { const f32x4 v0 = acc[ai][bj][m][0] * rs, v1 = acc[ai][bj][m][1] * rs;
                    const int c = u.pn * 256 + bj * 128 + wc * 32 + 8 * fq;
                    if (u.pn < 4) { *(u32x4*)(Km + (size_t)row * 1024 + c) = pk16(v0, v1); }
                    else { const int c2 = c - 1024, h = c2 >> 8, dv = c2 & 255;
                        bf16_t* vp = Vmt + ((size_t)(b * 4 + h) * 256 + dv) * 256 + key;
#pragma unroll
                        for (int e = 0; e < 4; ++e) { vp[e * 256] = f2bf(v0[e]); vp[(4 + e) * 256] = f2bf(v1[e]); } } } }
    }
};
struct EpiFF { static constexpr bool PERM = false;
    const float* P; bf16_t* ACT;
    DI void operator()(AccRef acc, const pg8::Unit& u, int wr, int wc, int fr, int fq) const {
        const int row0 = u.pm * 256 + wr * 64 + fr;
#pragma unroll
        for (int ai = 0; ai < 2; ++ai)
#pragma unroll
            for (int m = 0; m < 4; ++m) { const int row = row0 + ai * 128 + m * 16; const float rs = row_rstd16(P, row);
#pragma unroll
                for (int bj = 0; bj < 2; ++bj) { const int G = u.pn * 8 + bj * 4 + wc;
                    const f32x4 gt = acc[ai][bj][m][0] * rs, up = acc[ai][bj][m][1] * rs; f32x4 a;
#pragma unroll
                    for (int e = 0; e < 4; ++e) a[e] = gt[e] * sigm(gt[e]) * up[e];
                    *(u32x2*)(ACT + (size_t)row * DFF + 16 * G + 4 * fq) = pk8(a); } }
    }
};

DI int srccol(int mode, int np) {
    if (mode == 1) return np < 672 ? np : (np < 768 ? -1 : np - 96);
    if (mode == 2) { const int G = np >> 5, s = (np >> 4) & 1, j = np & 15; return s * DFF + 16 * G + j; }
    return np;
}
DI void conv_item(const float* W, int K, int N, int Np, int mode, const float* gain, bf16_t* WT, LAS float* scr, int item, int lane) {
    const int nblk = Np / 32, kb = item / nblk, nb = item % nblk, k0 = 64 * kb, n0 = 32 * nb;
    const int sc = srccol(mode, n0 + (lane & 31));
#pragma unroll 8
    for (int i = 0; i < 32; ++i) { const int kk = 2 * i + (lane >> 5); float w = 0.f;
        if (sc >= 0) { w = W[(size_t)(k0 + kk) * N + sc]; if (gain) w *= gain[k0 + kk]; }
        scr[kk * 33 + (lane & 31)] = w; }
    asm volatile("s_waitcnt lgkmcnt(0)" ::: "memory");
    const int c = lane & 7;
#pragma unroll
    for (int j = 0; j < 4; ++j) { const int n = (lane >> 3) + 8 * j; const LAS float* s = scr + (8 * c) * 33 + n;
        u32x4 o; o.x = cvt_pk(s[0 * 33], s[1 * 33]); o.y = cvt_pk(s[2 * 33], s[3 * 33]); o.z = cvt_pk(s[4 * 33], s[5 * 33]); o.w = cvt_pk(s[6 * 33], s[7 * 33]);
        *(u32x4*)(WT + (size_t)(n0 + n) * K + k0 + 8 * c) = o; }
    asm volatile("s_waitcnt lgkmcnt(0)" ::: "memory");
}

DI void attn_unit(LAS unsigned char* lds, const bf16_t* Q, const bf16_t* Kn, const bf16_t* Kr, const bf16_t* Vt, bf16_t* Oa, int b, int h, int qb, int wv) {
    const int tid = otid(wv), lane = tid & 63, w = __builtin_amdgcn_readfirstlane(tid >> 6), l32 = lane & 31, hi = lane >> 5;
    constexpr int KST = 208, VST = 136, KBUF = 64 * KST, VBUF = 64 * VST, VOFF = 2 * KBUF;
    const size_t rowb = (size_t)b * SEQ;
    const int qrow = qb * 256 + 32 * w + l32;
    bf16x8 qf[6];
#pragma unroll
    for (int ks = 0; ks < 6; ++ks) qf[ks] = *(const bf16x8*)(Q + (rowb + qrow) * 768 + h * 96 + 16 * ks + 8 * hi);
    f32x16 o0, o1;
#pragma unroll
    for (int r = 0; r < 16; ++r) { o0[r] = 0.f; o1[r] = 0.f; }
    float mrun = -INFINITY, lrun = 0.f;
    const int NT = 4 * qb + 4, tlast = 4 * qb + (w >> 1);
    const int kkey = tid >> 3, kch = tid & 7, rkey = (tid & 255) >> 2, rch = tid & 3;
    const bf16_t* gK = Kn + (rowb + kkey) * 512 + h * 64 + kch * 8;
    const bf16_t* gR = Kr + (rowb + rkey) * 32 + rch * 8;
    const bf16_t* gV = Vt + ((size_t)(b * 8 + h) * 64 + kkey) * SEQ + kch * 8;
    u32x4 rk, rr, rv;
    rr = (u32x4){0u, 0u, 0u, 0u};
    rk = *(const u32x4*)gK; if (tid < 256) rr = *(const u32x4*)gR; rv = *(const u32x4*)gV;
    {
        *(LAS u32x4*)(lds + kkey * KST + kch * 16) = rk;
        if (tid < 256) *(LAS u32x4*)(lds + rkey * KST + 128 + rch * 16) = rr;
        *(LAS u32x2*)(lds + VOFF + kkey * VST + kch * 16) = (u32x2){rv.x, rv.y};
        *(LAS u32x2*)(lds + VOFF + kkey * VST + kch * 16 + 8) = (u32x2){rv.z, rv.w};
    }
    __syncthreads();
    for (int t = 0; t < NT; ++t) {
        const int cur = t & 1;
        if (t + 1 < NT) {
            rk = *(const u32x4*)(gK + (size_t)(t + 1) * 64 * 512);
            if (tid < 256) rr = *(const u32x4*)(gR + (size_t)(t + 1) * 64 * 32);
            rv = *(const u32x4*)(gV + (size_t)(t + 1) * 64);
        }
        if (t <= tlast) {
            const LAS unsigned char* kb_ = lds + cur * KBUF;
            const LAS unsigned char* vb_ = lds + VOFF + cur * VBUF;
            f32x16 s0, s1;
#pragma unroll
            for (int r = 0; r < 16; ++r) { s0[r] = 0.f; s1[r] = 0.f; }
#pragma unroll
            for (int ks = 0; ks < 6; ++ks) {
                const bf16x8 a0 = *(const LAS bf16x8*)(kb_ + l32 * KST + (16 * ks + 8 * hi) * 2);
                const bf16x8 a1 = *(const LAS bf16x8*)(kb_ + (32 + l32) * KST + (16 * ks + 8 * hi) * 2);
                s0 = MFMA32(a0, qf[ks], s0); s1 = MFMA32(a1, qf[ks], s1);
            }
            if (t == tlast) {
#pragma unroll
                for (int r = 0; r < 16; ++r) { const int key = 64 * t + crow(r, hi);
                    if (key > qrow) s0[r] = -INFINITY;
                    if (key + 32 > qrow) s1[r] = -INFINITY; }
            }
            float mx = fmaxf(s0[0], s1[0]);
#pragma unroll
            for (int r = 1; r < 16; ++r) mx = fmaxf(mx, fmaxf(s0[r], s1[r]));
            mx = fmaxf(mx, __shfl_xor(mx, 32));
            const float mnew = fmaxf(mrun, mx);
            const float alpha = __builtin_amdgcn_exp2f(mrun - mnew);
            mrun = mnew;
            float ps = 0.f;
#pragma unroll
            for (int r = 0; r < 16; ++r) { s0[r] = __builtin_amdgcn_exp2f(s0[r] - mnew); s1[r] = __builtin_amdgcn_exp2f(s1[r] - mnew); ps += s0[r] + s1[r]; }
            lrun = lrun * alpha + ps;
#pragma unroll
            for (int r = 0; r < 16; ++r) { o0[r] *= alpha; o1[r] *= alpha; }
#pragma unroll
            for (int s = 0; s < 4; ++s) {
                const int kb = s >> 1, sub = s & 1;
                bf16x8 P;
                if (kb == 0) P = pack8(s0[8 * sub + 0], s0[8 * sub + 1], s0[8 * sub + 2], s0[8 * sub + 3], s0[8 * sub + 4], s0[8 * sub + 5], s0[8 * sub + 6], s0[8 * sub + 7]);
                else         P = pack8(s1[8 * sub + 0], s1[8 * sub + 1], s1[8 * sub + 2], s1[8 * sub + 3], s1[8 * sub + 4], s1[8 * sub + 5], s1[8 * sub + 6], s1[8 * sub + 7]);
                const int koff = (32 * kb + 16 * sub + 4 * hi) * 2;
                const u32x2 a0l = *(const LAS u32x2*)(vb_ + l32 * VST + koff), a0h = *(const LAS u32x2*)(vb_ + l32 * VST + koff + 16);
                const u32x2 a1l = *(const LAS u32x2*)(vb_ + (32 + l32) * VST + koff), a1h = *(const LAS u32x2*)(vb_ + (32 + l32) * VST + koff + 16);
                o0 = MFMA32(mk8(a0l, a0h), P, o0); o1 = MFMA32(mk8(a1l, a1h), P, o1);
            }
        }
        if (t + 1 < NT) {
            LAS unsigned char* kd = lds + (cur ^ 1) * KBUF; LAS unsigned char* vd = lds + VOFF + (cur ^ 1) * VBUF;
            *(LAS u32x4*)(kd + kkey * KST + kch * 16) = rk;
            if (tid < 256) *(LAS u32x4*)(kd + rkey * KST + 128 + rch * 16) = rr;
            *(LAS u32x2*)(vd + kkey * VST + kch * 16) = (u32x2){rv.x, rv.y};
            *(LAS u32x2*)(vd + kkey * VST + kch * 16 + 8) = (u32x2){rv.z, rv.w};
        }
        __syncthreads();
    }
    const float lt = lrun + __shfl_xor(lrun, 32);
    const float inv = 1.0f / lt;
    bf16_t* op = Oa + (rowb + qrow) * 512 + h * 64;
#pragma unroll
    for (int g = 0; g < 4; ++g) {
        u32x2 w0, w1;
        w0.x = cvt_pk(o0[4 * g] * inv, o0[4 * g + 1] * inv); w0.y = cvt_pk(o0[4 * g + 2] * inv, o0[4 * g + 3] * inv);
        w1.x = cvt_pk(o1[4 * g] * inv, o1[4 * g + 1] * inv); w1.y = cvt_pk(o1[4 * g + 2] * inv, o1[4 * g + 3] * inv);
        *(u32x2*)(op + 8 * g + 4 * hi) = w0; *(u32x2*)(op + 32 + 8 * g + 4 * hi) = w1;
    }
}

DI void xattn_unit(LAS unsigned char* lds, bf16_t* QX, const bf16_t* Km, const bf16_t* Vmt, int b, int h, int qb, int wv) {
    const int tid = otid(wv), lane = tid & 63, w = __builtin_amdgcn_readfirstlane(tid >> 6), l32 = lane & 31, hi = lane >> 5;
    constexpr int KST = 272, VST = 520, BUF = 64 * VST;
    const size_t row = (size_t)b * SEQ + qb * 256 + 32 * w + l32;
    bf16_t* qp = QX + row * 1024 + h * 256;
    f32x16 sacc[8];
#pragma unroll
    for (int i = 0; i < 8; ++i)
#pragma unroll
        for (int r = 0; r < 16; ++r) sacc[i][r] = 0.f;
    unsigned pp[8][8];
    bf16x8 qf[8];
    u32x4 pf[4];
#define XLOAD(i) do { if ((i) < 8) { const int dh_ = (i) >> 2, kt_ = (i) & 3; \
        _Pragma("unroll") for (int j = 0; j < 2; ++j) { const int id = tid + 512 * j, key = id >> 4, ch = id & 15; \
            pf[j] = *(const u32x4*)(Km + ((size_t)(b * 256 + 64 * kt_ + key)) * 1024 + h * 256 + 128 * dh_ + 8 * ch); } } \
      else { const int c_ = (i) - 8; \
        _Pragma("unroll") for (int j = 0; j < 4; ++j) { const int id = tid + 512 * j, dv = id >> 5, ch = id & 31; \
            pf[j] = *(const u32x4*)(Vmt + ((size_t)((b * 4 + h) * 256 + 64 * c_ + dv)) * 256 + 8 * ch); } } } while (0)
#define XSTORE(i, bufp) do { if ((i) < 8) { \
        _Pragma("unroll") for (int j = 0; j < 2; ++j) { const int id = tid + 512 * j, key = id >> 4, ch = id & 15; *(LAS u32x4*)((bufp) + key * KST + ch * 16) = pf[j]; } } \
      else { \
        _Pragma("unroll") for (int j = 0; j < 4; ++j) { const int id = tid + 512 * j, dv = id >> 5, ch = id & 31; \
            *(LAS u32x2*)((bufp) + dv * VST + ch * 16) = (u32x2){pf[j].x, pf[j].y}; *(LAS u32x2*)((bufp) + dv * VST + ch * 16 + 8) = (u32x2){pf[j].z, pf[j].w}; } } } while (0)
    XLOAD(0); XSTORE(0, lds);
    __syncthreads();
#pragma unroll
    for (int i = 0; i < 12; ++i) {
        const LAS unsigned char* cb_ = lds + (i & 1) * BUF;
        if (i + 1 < 12) XLOAD(i + 1);
        if (i < 8) {
            const int dh = i >> 2, kt = i & 3;
            if (kt == 0) {
#pragma unroll
                for (int ks = 0; ks < 8; ++ks) qf[ks] = *(const bf16x8*)(qp + 128 * dh + 16 * ks + 8 * hi);
            }
#pragma unroll
            for (int ks = 0; ks < 8; ++ks) {
                const bf16x8 a0 = *(const LAS bf16x8*)(cb_ + l32 * KST + (16 * ks + 8 * hi) * 2);
                const bf16x8 a1 = *(const LAS bf16x8*)(cb_ + (32 + l32) * KST + (16 * ks + 8 * hi) * 2);
                sacc[2 * kt] = MFMA32(a0, qf[ks], sacc[2 * kt]); sacc[2 * kt + 1] = MFMA32(a1, qf[ks], sacc[2 * kt + 1]);
            }
            if (i == 7) {
                float mx = sacc[0][0];
#pragma unroll
                for (int j = 0; j < 8; ++j)
#pragma unroll
                    for (int r = 0; r < 16; ++r) mx = fmaxf(mx, sacc[j][r]);
                mx = fmaxf(mx, __shfl_xor(mx, 32));
                float ps = 0.f;
#pragma unroll
                for (int j = 0; j < 8; ++j)
#pragma unroll
                    for (int r = 0; r < 16; ++r) { sacc[j][r] = __builtin_amdgcn_exp2f(sacc[j][r] - mx); ps += sacc[j][r]; }
                ps += __shfl_xor(ps, 32);
                const float inv = 1.0f / ps;
#pragma unroll
                for (int j = 0; j < 8; ++j)
#pragma unroll
                    for (int r2 = 0; r2 < 8; ++r2) pp[j][r2] = cvt_pk(sacc[j][2 * r2] * inv, sacc[j][2 * r2 + 1] * inv);
            }
        } else {
            const int c = i - 8;
            f32x16 o0, o1;
#pragma unroll
            for (int r = 0; r < 16; ++r) { o0[r] = 0.f; o1[r] = 0.f; }
#pragma unroll
            for (int s = 0; s < 16; ++s) {
                const int kb = s >> 1, sub = s & 1;
                const u32x4 pw = {pp[kb][4 * sub], pp[kb][4 * sub + 1], pp[kb][4 * sub + 2], pp[kb][4 * sub + 3]};
                const bf16x8 P = __builtin_bit_cast(bf16x8, pw);
                const int koff = (32 * kb + 16 * sub + 4 * hi) * 2;
                const u32x2 a0l = *(const LAS u32x2*)(cb_ + l32 * VST + koff), a0h = *(const LAS u32x2*)(cb_ + l32 * VST + koff + 16);
                const u32x2 a1l = *(const LAS u32x2*)(cb_ + (32 + l32) * VST + koff), a1h = *(const LAS u32x2*)(cb_ + (32 + l32) * VST + koff + 16);
                o0 = MFMA32(mk8(a0l, a0h), P, o0); o1 = MFMA32(mk8(a1l, a1h), P, o1);
            }
#pragma unroll
            for (int g = 0; g < 4; ++g) {
                u32x2 w0, w1;
                w0.x = cvt_pk(o0[4 * g], o0[4 * g + 1]); w0.y = cvt_pk(o0[4 * g + 2], o0[4 * g + 3]);
                w1.x = cvt_pk(o1[4 * g], o1[4 * g + 1]); w1.y = cvt_pk(o1[4 * g + 2], o1[4 * g + 3]);
                *(u32x2*)(qp + 64 * c + 8 * g + 4 * hi) = w0; *(u32x2*)(qp + 64 * c + 32 + 8 * g + 4 * hi) = w1;
            }
        }
        if (i + 1 < 12) XSTORE(i + 1, lds + ((i + 1) & 1) * BUF);
        __syncthreads();
    }
#undef XLOAD
#undef XSTORE
}

DI void gmlp_unit(LAS unsigned char* lds, bf16_t* zC, const float* ln_g, const float* ln_b, const float* w_s, const float* b_s, int chunk, int g, int wv) {
    const int tid = otid(wv), lane = tid & 63, w = __builtin_amdgcn_readfirstlane(tid >> 6), l32 = lane & 31, hi = lane >> 5;
    constexpr int VST = 272;
    const size_t row0 = (size_t)chunk * 128;
    LAS bf16_t* vnT = (LAS bf16_t*)lds;
    {
        f32x4 lg0, lg1, lb0, lb1;
        lg0 = *(const f32x4*)(ln_g + 8 * lane); lg1 = *(const f32x4*)(ln_g + 8 * lane + 4);
        lb0 = *(const f32x4*)(ln_b + 8 * lane); lb1 = *(const f32x4*)(ln_b + 8 * lane + 4);
        for (int tt = 0; tt < 16; ++tt) {
            const int t = 16 * w + tt;
            const u32x4 raw = *(const u32x4*)(zC + (row0 + t) * 1024 + 512 + 8 * lane);
            float x[8];
            x[0] = gelu_erf(bflo(raw.x)); x[1] = gelu_erf(bfhi(raw.x)); x[2] = gelu_erf(bflo(raw.y)); x[3] = gelu_erf(bfhi(raw.y));
            x[4] = gelu_erf(bflo(raw.z)); x[5] = gelu_erf(bfhi(raw.z)); x[6] = gelu_erf(bflo(raw.w)); x[7] = gelu_erf(bfhi(raw.w));
            float s = 0.f;
#pragma unroll
            for (int e = 0; e < 8; ++e) s += x[e];
            const float mean = wave_sum(s) * (1.0f / 512.0f);
            float q = 0.f;
#pragma unroll
            for (int e = 0; e < 8; ++e) { x[e] -= mean; q += x[e] * x[e]; }
            const float rstd = rsqrtf(wave_sum(q) * (1.0f / 512.0f) + EPS);
            if ((lane >> 4) == g) {
                const int cl = 8 * (lane & 15);
                vnT[(cl + 0) * (VST / 2) + t] = f2bf(x[0] * rstd * lg0[0] + lb0[0]); vnT[(cl + 1) * (VST / 2) + t] = f2bf(x[1] * rstd * lg0[1] + lb0[1]);
                vnT[(cl + 2) * (VST / 2) + t] = f2bf(x[2] * rstd * lg0[2] + lb0[2]); vnT[(cl + 3) * (VST / 2) + t] = f2bf(x[3] * rstd * lg0[3] + lb0[3]);
                vnT[(cl + 4) * (VST / 2) + t] = f2bf(x[4] * rstd * lg1[0] + lb1[0]); vnT[(cl + 5) * (VST / 2) + t] = f2bf(x[5] * rstd * lg1[1] + lb1[1]);
                vnT[(cl + 6) * (VST / 2) + t] = f2bf(x[6] * rstd * lg1[2] + lb1[2]); vnT[(cl + 7) * (VST / 2) + t] = f2bf(x[7] * rstd * lg1[3] + lb1[3]);
            }
        }
    }
    __syncthreads();
    {
        const int tb = w >> 1, cb0 = 2 * (w & 1);
        f32x16 a0, a1;
#pragma unroll
        for (int r = 0; r < 16; ++r) { a0[r] = 0.f; a1[r] = 0.f; }
        const int trow = 32 * tb + l32;
        const float* wrow = w_s + ((size_t)(g * 128 + trow)) * 128;
        for (int ks = 0; ks <= 2 * tb + 1; ++ks) {
            const int s0 = 16 * ks + 8 * hi;
            f32x4 w0 = *(const f32x4*)(wrow + s0), w1 = *(const f32x4*)(wrow + s0 + 4);
#pragma unroll
            for (int e = 0; e < 4; ++e) { if (s0 + e > trow) w0[e] = 0.f; if (s0 + 4 + e > trow) w1[e] = 0.f; }
            const bf16x8 A = pack8(w0[0], w0[1], w0[2], w0[3], w1[0], w1[1], w1[2], w1[3]);
            const bf16x8 B0 = *(const LAS bf16x8*)(lds + (32 * cb0 + l32) * VST + s0 * 2);
            const bf16x8 B1 = *(const LAS bf16x8*)(lds + (32 * (cb0 + 1) + l32) * VST + s0 * 2);
            a0 = MFMA32(A, B0, a0); a1 = MFMA32(A, B1, a1);
        }
#pragma unroll
        for (int r = 0; r < 16; ++r) {
            const int t = 32 * tb + crow(r, hi);
            const float bs = b_s[g * 128 + t];
            bf16_t* up0 = zC + (row0 + t) * 1024 + g * 128 + 32 * cb0 + l32;
            const float u0 = gelu_erf(bf2f(up0[0])), u1 = gelu_erf(bf2f(up0[32]));
            up0[0] = f2bf((a0[r] + bs) * u0); up0[32] = f2bf((a1[r] + bs) * u1);
        }
    }
    __syncthreads();
}

#define HG_PREP() \
    const int k = tid & 127, seg = tid >> 7; \
    const size_t row0 = (size_t)b * SEQ + (size_t)c * 64 + 16 * seg; \
    float cum[16], kv[16]; float bref, blast; \
    { const float lb = lbv[h * 128 + k]; float run = 0.f; \
      _Pragma("unroll") for (int i = 0; i < 16; ++i) { const float fr_ = bf2f(zB[(row0 + i) * 2048 + 512 + h * 128 + k]); \
          const float e_ = __expf(-fr_), sg_ = __builtin_amdgcn_rcpf(1.f + e_); const float f_ = lb + (1.f - lb) * sg_; \
          run += __logf(f_); cum[i] = run; kv[i] = (1.f - lb) * e_ * sg_; } \
      segs[seg * 128 + k] = run; __syncthreads(); \
      const float s0_ = segs[k], s1_ = segs[128 + k], s2_ = segs[256 + k], s3_ = segs[384 + k]; \
      const float off_ = (seg > 0 ? s0_ : 0.f) + (seg > 1 ? s1_ : 0.f) + (seg > 2 ? s2_ : 0.f); \
      bref = s0_ + s1_; blast = (s0_ + s1_) + (s2_ + s3_); \
      _Pragma("unroll") for (int i = 0; i < 16; ++i) cum[i] += off_; }

constexpr int HG_QR = 0, HG_KR = 17408, HG_QD = 34816, HG_VT = 52224, HG_KDT = 70656, HG_SEG = 89088, HG_SSL = 91136;

DI void hg_u_unit(LAS unsigned char* lds, const bf16_t* zB, const float* lbv, bf16_t* ST, float* dC, int b, int h, int c, int wv) {
    const int tid = otid(wv), lane = tid & 63, w = __builtin_amdgcn_readfirstlane(tid >> 6), l32 = lane & 31, hi = lane >> 5;
    LAS float* segs = (LAS float*)(lds + HG_SEG);
    HG_PREP();
    const int unit = (b * 4 + h) * 128 + c;
    {
        float kd[16]; unsigned vr[8];
#pragma unroll
        for (int i = 0; i < 16; ++i) kd[i] = kv[i] * __expf(blast - cum[i]);
#pragma unroll
        for (int i = 0; i < 8; ++i) { const unsigned lo = zB[(row0 + 2 * i) * 2048 + 1024 + h * 128 + k], hi2 = zB[(row0 + 2 * i + 1) * 2048 + 1024 + h * 128 + k]; vr[i] = lo | (hi2 << 16); }
        LAS unsigned char* kp = lds + HG_KDT + k * 144 + seg * 32;
        *(LAS u32x4*)kp = (u32x4){cvt_pk(kd[0], kd[1]), cvt_pk(kd[2], kd[3]), cvt_pk(kd[4], kd[5]), cvt_pk(kd[6], kd[7])};
        *(LAS u32x4*)(kp + 16) = (u32x4){cvt_pk(kd[8], kd[9]), cvt_pk(kd[10], kd[11]), cvt_pk(kd[12], kd[13]), cvt_pk(kd[14], kd[15])};
        LAS unsigned char* vp = lds + HG_VT + k * 144 + seg * 32;
        *(LAS u32x4*)vp = (u32x4){vr[0], vr[1], vr[2], vr[3]};
        *(LAS u32x4*)(vp + 16) = (u32x4){vr[4], vr[5], vr[6], vr[7]};
        if (seg == 0) dC[(size_t)unit * 128 + k] = __expf(blast);
    }
    __syncthreads();
    {
        const int vb = w & 3;
#pragma unroll
        for (int kbi = 0; kbi < 2; ++kbi) {
            const int kb = 2 * (w >> 2) + kbi;
            f32x16 acc;
#pragma unroll
            for (int r = 0; r < 16; ++r) acc[r] = 0.f;
#pragma unroll
            for (int ks = 0; ks < 4; ++ks) {
                const bf16x8 A = *(const LAS bf16x8*)(lds + HG_VT + (32 * vb + l32) * 144 + (16 * ks + 8 * hi) * 2);
                const bf16x8 B = *(const LAS bf16x8*)(lds + HG_KDT + (32 * kb + l32) * 144 + (16 * ks + 8 * hi) * 2);
                acc = MFMA32(A, B, acc);
            }
            bf16_t* sp = ST + (size_t)unit * 16384 + 32 * kb + l32;
#pragma unroll
            for (int r = 0; r < 16; ++r) sp[(32 * vb + crow(r, hi)) * 128] = f2bf(acc[r]);
        }
    }
    __syncthreads();
}

DI void hg_out_unit(LAS unsigned char* lds, const bf16_t* zB, const float* lbv, const bf16_t* ST, const float* hnorm, bf16_t* Ob, int b, int h, int c, int wv) {
    const int tid = otid(wv), lane = tid & 63, w = __builtin_amdgcn_readfirstlane(tid >> 6), l32 = lane & 31, hi = lane >> 5;
    LAS float* segs = (LAS float*)(lds + HG_SEG);
    LAS float* ssl = (LAS float*)(lds + HG_SSL);
    HG_PREP();
    const int unit = (b * 4 + h) * 128 + c;
    {
        LAS bf16_t* Qr = (LAS bf16_t*)(lds + HG_QR); LAS bf16_t* Kr = (LAS bf16_t*)(lds + HG_KR); LAS bf16_t* Qd = (LAS bf16_t*)(lds + HG_QD);
        unsigned vr[8];
#pragma unroll
        for (int i = 0; i < 16; ++i) { const int t = 16 * seg + i;
            const float qraw = bf2f(zB[(row0 + i) * 2048 + h * 128 + k]); const float q = qraw * sigm(qraw);
            Qr[t * 136 + k] = f2bf(q * __expf(cum[i] - bref)); Kr[t * 136 + k] = f2bf(kv[i] * __expf(bref - cum[i])); Qd[t * 136 + k] = f2bf(q * __expf(cum[i])); }
#pragma unroll
        for (int i = 0; i < 8; ++i) { const unsigned lo = zB[(row0 + 2 * i) * 2048 + 1024 + h * 128 + k], hi2 = zB[(row0 + 2 * i + 1) * 2048 + 1024 + h * 128 + k]; vr[i] = lo | (hi2 << 16); }
        LAS unsigned char* vp = lds + HG_VT + k * 144 + seg * 32;
        *(LAS u32x4*)vp = (u32x4){vr[0], vr[1], vr[2], vr[3]};
        *(LAS u32x4*)(vp + 16) = (u32x4){vr[4], vr[5], vr[6], vr[7]};
    }
    __syncthreads();
    const int vb = w & 3, tb = w >> 2;
    f32x16 o;
#pragma unroll
    for (int r = 0; r < 16; ++r) o[r] = 0.f;
    {
        const bf16_t* sp = ST + (size_t)unit * 16384 + (size_t)(32 * vb + l32) * 128 + 8 * hi;
#pragma unroll
        for (int ks = 0; ks < 8; ++ks) {
            const bf16x8 A = *(const bf16x8*)(sp + 16 * ks);
            const bf16x8 B = *(const LAS bf16x8*)(lds + HG_QD + (32 * tb + l32) * 272 + (16 * ks + 8 * hi) * 2);
            o = MFMA32(A, B, o);
        }
    }
#pragma unroll
    for (int sb = 0; sb < 2; ++sb) {
        if (sb <= tb) {
            f32x16 at;
#pragma unroll
            for (int r = 0; r < 16; ++r) at[r] = 0.f;
#pragma unroll
            for (int ks = 0; ks < 8; ++ks) {
                const bf16x8 A = *(const LAS bf16x8*)(lds + HG_KR + (32 * sb + l32) * 272 + (16 * ks + 8 * hi) * 2);
                const bf16x8 B = *(const LAS bf16x8*)(lds + HG_QR + (32 * tb + l32) * 272 + (16 * ks + 8 * hi) * 2);
                at = MFMA32(A, B, at);
            }
            if (sb == tb) {
#pragma unroll
                for (int r = 0; r < 16; ++r) if (crow(r, hi) > l32) at[r] = 0.f;
            }
#pragma unroll
            for (int sub = 0; sub < 2; ++sub) {
                const bf16x8 P = pack8(at[8 * sub + 0], at[8 * sub + 1], at[8 * sub + 2], at[8 * sub + 3], at[8 * sub + 4], at[8 * sub + 5], at[8 * sub + 6], at[8 * sub + 7]);
                const int koff = (32 * sb + 16 * sub + 4 * hi) * 2;
                const u32x2 al = *(const LAS u32x2*)(lds + HG_VT + (32 * vb + l32) * 144 + koff), ah = *(const LAS u32x2*)(lds + HG_VT + (32 * vb + l32) * 144 + koff + 16);
                o = MFMA32(mk8(al, ah), P, o);
            }
        }
    }
    float ss = 0.f;
#pragma unroll
    for (int r = 0; r < 16; ++r) ss += o[r] * o[r];
    ss += __shfl_xor(ss, 32);
    if (hi == 0) ssl[vb * 64 + 32 * tb + l32] = ss;
    __syncthreads();
    {
        const int t = 32 * tb + l32;
        const float tot = (ssl[t] + ssl[64 + t]) + (ssl[128 + t] + ssl[192 + t]);
        const float rstd = rsqrtf(tot * (1.0f / 128.0f) + EPS);
        const size_t row = (size_t)b * SEQ + (size_t)c * 64 + t;
#pragma unroll
        for (int g = 0; g < 4; ++g) {
            const int v0 = 32 * vb + 8 * g + 4 * hi;
            const u32x2 gr = *(const u32x2*)(zB + row * 2048 + 1536 + h * 128 + v0);
            const f32x4 hn = *(const f32x4*)(hnorm + v0);
            const float g0 = bflo(gr.x), g1 = bfhi(gr.x), g2 = bflo(gr.y), g3 = bfhi(gr.y);
            u32x2 ow;
            ow.x = cvt_pk(o[4 * g] * rstd * hn[0] * (g0 * sigm(g0)), o[4 * g + 1] * rstd * hn[1] * (g1 * sigm(g1)));
            ow.y = cvt_pk(o[4 * g + 2] * rstd * hn[2] * (g2 * sigm(g2)), o[4 * g + 3] * rstd * hn[3] * (g3 * sigm(g3)));
            *(u32x2*)(Ob + row * 512 + h * 128 + v0) = ow;
        }
    }
    __syncthreads();
}


#define XB_TMO      128
#define XB_XCNT(j)  (256  + 64 * (j))
#define XB_XSUB(j)  (1280 + 64 * (j))
#define XB_XGEN(j)  (2304 + 64 * (j))
#define XB_TOP      3328
#define XB_TOPGEN   3392
#define XCD_BAR_WORDS 3456
#define XB_SPIN_CAP (1u << 18)
DI unsigned xb_ld(unsigned* p)              { return __hip_atomic_load(p, __ATOMIC_RELAXED, __HIP_MEMORY_SCOPE_AGENT); }
DI unsigned xb_add(unsigned* p, unsigned v) { return __hip_atomic_fetch_add(p, v, __ATOMIC_RELAXED, __HIP_MEMORY_SCOPE_AGENT); }
DI unsigned xb_xcc_id() { return (unsigned)__builtin_amdgcn_s_getreg((3 << 11) | 20) & 0xFu; }
#define XB_SPIN(cond, bar) do { unsigned _sp = 0; while (cond) { __builtin_amdgcn_s_sleep(1); \
    if ((++_sp & 255u) == 0u) { if (xb_ld(&(bar)[XB_TMO])) break; if (_sp > XB_SPIN_CAP) { atomicAdd(&(bar)[XB_TMO], 1u); break; } } } } while (0)
DI void xcd_barrier_complete(unsigned* bar, unsigned x, unsigned& nloc, unsigned& nx) {
    const unsigned G = gridDim.x * gridDim.y * gridDim.z;
    unsigned sum, cnt, mine, sp = 0u;
    for (;;) {
        sum = 0u; cnt = 0u; mine = 0u;
#pragma unroll
        for (unsigned j = 0; j < 16; ++j) { const unsigned c = xb_ld(&bar[XB_XCNT(j)]); sum += c; cnt += (c > 0u) ? 1u : 0u; mine = (j == x) ? c : mine; }
        if (sum == G) break;
        __builtin_amdgcn_s_sleep(1);
        if ((++sp & 255u) == 0u) { if (xb_ld(&bar[XB_TMO])) break; if (sp > XB_SPIN_CAP) { atomicAdd(&bar[XB_TMO], 1u); break; } }
    }
    nloc = mine > 0u ? mine : 1u; nx = cnt > 0u ? cnt : 1u;
}
DI void xcd_barrier(unsigned* bar, volatile LAS unsigned* st) {
    asm volatile("s_waitcnt vmcnt(0)" ::: "memory");
    __syncthreads();
    if (threadIdx.x == 0) {
        const unsigned x = xb_xcc_id();
        __builtin_amdgcn_s_waitcnt(0);
        unsigned nloc = st[0], nx = st[1];
        if (nloc == 0u) { xcd_barrier_complete(bar, x, nloc, nx); st[0] = nloc; st[1] = nx; }
        const unsigned old = xb_add(&bar[XB_XSUB(x)], 1u);
        const unsigned gen = old / nloc;
        if (old + 1u == (gen + 1u) * nloc) {
            __builtin_amdgcn_fence(__ATOMIC_RELEASE, "agent");
            asm volatile("s_waitcnt vmcnt(0)" ::: "memory");
            const unsigned og = xb_add(&bar[XB_TOP], 1u);
            const unsigned tg = og / nx;
            if (og + 1u == (tg + 1u) * nx) xb_add(&bar[XB_TOPGEN], 1u);
            else XB_SPIN(xb_ld(&bar[XB_TOPGEN]) == tg, bar);
            __builtin_amdgcn_fence(__ATOMIC_ACQUIRE, "agent");
            xb_add(&bar[XB_XGEN(x)], 1u);
            asm volatile("s_waitcnt vmcnt(0)" ::: "memory");
        } else {
            XB_SPIN(xb_ld(&bar[XB_XGEN(x)]) == gen, bar);
            __builtin_amdgcn_fence(__ATOMIC_ACQUIRE, "agent");
            asm volatile("s_waitcnt vmcnt(0)" ::: "memory");
        }
    }
    __syncthreads();
}

constexpr size_t MiB = 1u << 20;
constexpr size_t WS_X0 = 0, WS_R2 = 32 * MiB, WS_R3 = 96 * MiB, WS_X1 = 128 * MiB, WS_R1 = 160 * MiB, WS_R4 = 184 * MiB, WS_RW = 216 * MiB;
constexpr size_t WS_CTL = 250 * MiB + 512 * 1024, CTL_BYTES = 16384;
constexpr size_t WS_P = 241 * MiB, WS_PA = 242 * MiB, WS_CS = 244 * MiB, WS_DC = 246 * MiB, WS_MEMB = 247 * MiB, WS_KM = 248 * MiB, WS_VMT = 249 * MiB, WS_MISC = 250 * MiB, WS_END = 251 * MiB;
constexpr size_t W1_IN = 0, W1_UQ = W1_IN + (size_t)6912 * 1024, W1_UKV = W1_UQ + (size_t)768 * 384, W1_BA = W1_UKV + (size_t)1024 * 256, W1_BB = W1_BA + (size_t)1024 * 512,
                 W1_BC = W1_BB + (size_t)1024 * 512, W1_MIX = W1_BC + (size_t)1024 * 512, W1_END = W1_MIX + (size_t)1024 * 1024;
constexpr size_t W2_XQ = 0, W2_XKV = W2_XQ + (size_t)1024 * 1024, W2_XO = W2_XKV + (size_t)2048 * 1024, W2_FI = W2_XO + (size_t)1024 * 1024, W2_FO = W2_FI + (size_t)5632 * 1024, W2_END = W2_FO + (size_t)1024 * 2816;
static_assert(W1_END * 2 <= 25 * MiB && W2_END * 2 <= 25 * MiB, "weight region");

constexpr int LDS_BYTES = 147456;

struct Args { const float* in[28]; float* out; unsigned char* ws; };

constexpr int PTAB_OFF = 135168;
DI void* ldptr(LAS unsigned char* lds, int i) {
    unsigned off_ = PTAB_OFF + 8 * i; asm volatile("" : "+v"(off_));
    const LAS unsigned* t = (const LAS unsigned*)(lds + off_);
    const unsigned lo = __builtin_amdgcn_readfirstlane(t[0]), hi = __builtin_amdgcn_readfirstlane(t[1]);
    return (void*)(((unsigned long long)hi << 32) | (unsigned long long)lo);
}
#define INP(i) ((const float*)ldptr(lds, (i)))
#define PH_HEAD() \
    int G = G0_, bid = bid0_; asm volatile("" : "+s"(G), "+s"(bid)); \
    int wv = wv0_; asm volatile("" : "+s"(wv)); const int tid = otid(wv), lane = tid & 63, wave = wv; \
    const int gw = bid * 8 + wave, NGW = G * 8; (void)lane; (void)gw; (void)NGW; \
    unsigned char* ws = (unsigned char*)ldptr(lds, 29); \
    bf16_t* const X0 = (bf16_t*)(ws + WS_X0); bf16_t* const X1 = (bf16_t*)(ws + WS_X1); \
    bf16_t* const R1 = (bf16_t*)(ws + WS_R1); bf16_t* const R2 = (bf16_t*)(ws + WS_R2); bf16_t* const R3 = (bf16_t*)(ws + WS_R3); bf16_t* const R4 = (bf16_t*)(ws + WS_R4); \
    bf16_t* const RW = (bf16_t*)(ws + WS_RW); \
    float* const P = (float*)(ws + WS_P); float* const PA = (float*)(ws + WS_PA); float* const CS = (float*)(ws + WS_CS); float* const dC = (float*)(ws + WS_DC); \
    bf16_t* const memb = (bf16_t*)(ws + WS_MEMB); bf16_t* const Km = (bf16_t*)(ws + WS_KM); bf16_t* const Vmt = (bf16_t*)(ws + WS_VMT); \
    float* const mrstd = (float*)(ws + WS_MISC); float* const lbv = mrstd + 512; \
    bf16_t* const xcur = par ? X1 : X0; bf16_t* const xfree = par ? X0 : X1; \
    bf16_t* const zA = R1; bf16_t* const zB = R2; bf16_t* const zC = R4; \
    bf16_t* const Qb = R3; bf16_t* const Krb = R3 + (size_t)MTOK * 768; \
    bf16_t* const Knb = xfree; bf16_t* const Vtb = xfree + (size_t)MTOK * 512; \
    bf16_t* const Oa = R1; bf16_t* const Ob = xfree; bf16_t* const STb = R3; bf16_t* const Gt = R2; bf16_t* const MX = xcur; \
    bf16_t* const QX = R2; bf16_t* const ACT = R2; float* const xres = (float*)ldptr(lds, 28); \
    (void)X0; (void)X1; (void)R1; (void)R2; (void)R3; (void)R4; (void)RW; (void)P; (void)PA; (void)CS; (void)dC; (void)memb; (void)Km; (void)Vmt; (void)mrstd; (void)lbv; \
    (void)xcur; (void)xfree; (void)zA; (void)zB; (void)zC; (void)Qb; (void)Krb; (void)Knb; (void)Vtb; (void)Oa; (void)Ob; (void)STb; (void)Gt; (void)MX; (void)QX; (void)ACT; (void)xres;

#define GSYNC() xcd_barrier((unsigned*)((unsigned char*)ldptr(lds, 29) + WS_CTL), (volatile LAS unsigned*)(lds + PTAB_OFF + 256))
__global__ void __launch_bounds__(512, 2) mega_fwd(Args args) {
    extern __shared__ __attribute__((aligned(16))) unsigned char lds_raw[];
    LAS unsigned char* lds = (LAS unsigned char*)lds_raw;
    cg::grid_group grid = cg::this_grid();
    const int G0_ = gridDim.x, bid0_ = blockIdx.x, wv0_ = __builtin_amdgcn_readfirstlane(threadIdx.x >> 6);
    int par = 0;
    if (threadIdx.x == 0) {
        LAS unsigned long long* pt = (LAS unsigned long long*)(lds + PTAB_OFF);
#pragma unroll
        for (int i = 0; i < 28; ++i) pt[i] = (unsigned long long)args.in[i];
        pt[28] = (unsigned long long)args.out; pt[29] = (unsigned long long)args.ws;
        pt[32] = 0ull;
        (void)xb_add((unsigned*)(args.ws + WS_CTL) + XB_XCNT(xb_xcc_id()), 1u);
    }
    __syncthreads();

    for (int l = 0; l < 2; ++l) {
        {
            PH_HEAD();
            LAS float* scr = (LAS float*)(lds + wave * 8448);
            const float* w_in = INP(4) + (size_t)l * 1024 * INW; const float* mixn = INP(3) + l * 1024;
            const float* wuq = INP(6) + (size_t)l * 384 * 768; const float* qn = INP(5) + l * 384;
            const float* wukv = INP(8) + (size_t)l * 256 * 1024; const float* kvn = INP(7) + l * 256;
            const float* wba = INP(15) + (size_t)l * 512 * 1024; const float* wbb = INP(16) + (size_t)l * 512 * 1024; const float* wbc = INP(17) + (size_t)l * 512 * 1024;
            const float* wmx = INP(18) + (size_t)l * 1024 * 1024;
            constexpr int I_IN = 16 * 216, I_UQ = 6 * 24, I_UKV = 4 * 32, I_B = 8 * 32, I_MX = 16 * 32;
            constexpr int NIT = I_IN + I_UQ + I_UKV + 3 * I_B + I_MX;
            for (int it = gw; it < NIT; it += NGW) {
                int r = it;
                if (r < I_IN) { conv_item(w_in, 1024, INW, 6912, 1, mixn, RW + W1_IN, scr, r, lane); continue; } r -= I_IN;
                if (r < I_UQ) { conv_item(wuq, 384, 768, 768, 0, qn, RW + W1_UQ, scr, r, lane); continue; } r -= I_UQ;
                if (r < I_UKV) { conv_item(wukv, 256, 1024, 1024, 0, kvn, RW + W1_UKV, scr, r, lane); continue; } r -= I_UKV;
                if (r < I_B) { conv_item(wba, 512, 1024, 1024, 0, nullptr, RW + W1_BA, scr, r, lane); continue; } r -= I_B;
                if (r < I_B) { conv_item(wbb, 512, 1024, 1024, 0, nullptr, RW + W1_BB, scr, r, lane); continue; } r -= I_B;
                if (r < I_B) { conv_item(wbc, 512, 1024, 1024, 0, nullptr, RW + W1_BC, scr, r, lane); continue; } r -= I_B;
                conv_item(wmx, 1024, 1024, 1024, 0, nullptr, RW + W1_MIX, scr, r, lane);
            }
            if (l == 0) {
                const float* xin0 = INP(0);
                for (int m = gw; m < MTOK; m += NGW) {
                    const f32x4* xr = (const f32x4*)(xin0 + (size_t)m * 1024) + lane; float s = 0.f;
                    unsigned long long* o8 = (unsigned long long*)(xcur + (size_t)m * 1024) + lane;
#pragma unroll
                    for (int j = 0; j < 4; ++j) { const f32x4 v = xr[64 * j]; s += dot4(v); o8[64 * j] = (unsigned long long)cvt_pk(v.x, v.y) | ((unsigned long long)cvt_pk(v.z, v.w) << 32); }
                    s = wave_sum(s);
                    if (lane < 16) P[(size_t)m * 16 + lane] = (lane == 0) ? s : 0.f;
                }
                for (int m = gw; m < NB * NMEM; m += NGW) {
                    const f32x4* xr = (const f32x4*)(INP(1) + (size_t)m * 1024) + lane; float s = 0.f;
                    unsigned long long* o8 = (unsigned long long*)(memb + (size_t)m * 1024) + lane;
#pragma unroll
                    for (int j = 0; j < 4; ++j) { const f32x4 v = xr[64 * j]; s += dot4(v); o8[64 * j] = (unsigned long long)cvt_pk(v.x, v.y) | ((unsigned long long)cvt_pk(v.z, v.w) << 32); }
                    s = wave_sum(s);
                    if (lane == 0) mrstd[m] = rsqrtf(s * (1.0f / 1024.0f) + EPS);
                }
                const int* pos = (const int*)INP(2);
                for (int idx = bid * 512 + tid; idx < MTOK * 16; idx += G * 512) {
                    const int row = idx >> 4, j = idx & 15;
                    const float invf = powf(10000.0f, -(float)(2 * j) / 32.0f);
                    const float ang = (float)pos[row] * invf;
                    double tt = (double)ang * 0.15915494309189535; tt -= rint(tt);
                    const float rv = (float)tt;
                    CS[(size_t)row * 32 + j] = __builtin_amdgcn_cosf(rv); CS[(size_t)row * 32 + 16 + j] = __builtin_amdgcn_sinf(rv);
                }
                for (int idx = bid * 512 + tid; idx < 512; idx += G * 512) {
                    const float p0 = INP(9)[idx], p1 = INP(9)[512 + idx];
                    lbv[idx] = 0.f; lbv[512 + idx] = 1.0f / (1.0f + expf(p0 - p1));
                }
            }
        }
        __syncthreads();
        grid.sync();
        {
            PH_HEAD();
            pg8::Gemm g{xcur, RW + W1_IN, MTOK, 3840, 1024, 1024, 1024}; pg8::StaticOrder S; S.init(MTOK, 3840, G, bid);
            EpiA E{P, zA, zB, zC, PA};
            pg8::gemm_phase<EpiA>(lds, g, S, E, wv);
        }
        GSYNC();
        {
            PH_HEAD();
            for (int idx = bid * 512 + tid; idx < MTOK * 16; idx += G * 512) {
                const int row = idx >> 4, j = idx & 15;
                const float x1 = bf2f(zA[(size_t)row * 768 + 640 + j]), x2 = bf2f(zA[(size_t)row * 768 + 656 + j]);
                const float cs = CS[(size_t)row * 32 + j], sn = CS[(size_t)row * 32 + 16 + j];
                Krb[(size_t)row * 32 + j] = f2bf(x1 * cs - x2 * sn); Krb[(size_t)row * 32 + 16 + j] = f2bf(x1 * sn + x2 * cs);
            }
            { pg8::Gemm g{zA, RW + W1_UQ, MTOK, 768, 384, 768, 384}; pg8::StaticOrder S; S.init(MTOK, 768, G, bid);
              EpiQ E{PA, CS, Qb}; pg8::gemm_phase<EpiQ>(lds, g, S, E, wv); }
            { pg8::Gemm g{zA + 384, RW + W1_UKV, MTOK, 1024, 256, 768, 256}; pg8::StaticOrder S; S.init(MTOK, 1024, G, bid);
              EpiKV E{PA, Knb, Vtb}; pg8::gemm_phase<EpiKV>(lds, g, S, E, wv); }
        }
        __syncthreads();
        GSYNC();
        {
            PH_HEAD();
            for (int item = bid; item < 256; item += G) {
                const int b = item >> 7, h = (item >> 4) & 7, s = item & 15;
                attn_unit(lds, Qb, Knb, Krb, Vtb, Oa, b, h, 31 - s, wv);
                attn_unit(lds, Qb, Knb, Krb, Vtb, Oa, b, h, s, wv);
            }
            const float* lng = INP(11) + l * 512; const float* lnb = INP(12) + l * 512;
            const float* wsp = INP(13) + (size_t)l * 4 * 128 * 128; const float* bsp = INP(14) + l * 512;
            for (int u = bid; u < 512; u += G) gmlp_unit(lds, zC, lng, lnb, wsp, bsp, u >> 2, u & 3, wv);
        }
        GSYNC();
        {
            PH_HEAD();
            for (int u = bid; u < 1024; u += G) hg_u_unit(lds, zB, lbv + l * 512, STb, dC, u >> 9, (u >> 7) & 3, u & 127, wv);
        }
        GSYNC();
        {
            PH_HEAD();
            if (tid < 256) {
                for (int p = bid * 256 + tid; p < 65536; p += G * 256) {
                    const int bh = p >> 13, e2 = p & 8191;
                    unsigned* sp = (unsigned*)STb + (size_t)bh * 128 * 8192 + e2;
                    const float* dp = dC + (size_t)bh * 128 * 128 + ((2 * e2) & 127);
                    float S0 = 0.f, S1 = 0.f;
                    for (int c0 = 0; c0 < 128; c0 += 16) {
                        unsigned uu[16]; f32x2 dd[16];
#pragma unroll
                        for (int i = 0; i < 16; ++i) { uu[i] = sp[(size_t)(c0 + i) * 8192]; dd[i] = *(const f32x2*)(dp + (size_t)(c0 + i) * 128); }
#pragma unroll
                        for (int i = 0; i < 16; ++i) { sp[(size_t)(c0 + i) * 8192] = cvt_pk(S0, S1); S0 = dd[i].x * S0 + bflo(uu[i]); S1 = dd[i].y * S1 + bfhi(uu[i]); }
                    }
                }
            }
        }
        GSYNC();
        {
            PH_HEAD();
            for (int u = bid; u < 1024; u += G) hg_out_unit(lds, zB, lbv + l * 512, STb, INP(10) + l * 128, Ob, u >> 9, (u >> 7) & 3, u & 127, wv);
        }
        GSYNC();
        {
            PH_HEAD();
            pg8::Gemm g{xcur, RW + W1_IN + (size_t)3840 * 1024, MTOK, 3072, 1024, 1024, 1024}; pg8::StaticOrder S; S.init(MTOK, 3072, G, bid);
            EpiPlain<true> E{P, Gt, 3072, 1.0f};
            pg8::gemm_phase<EpiPlain<true>>(lds, g, S, E, wv);
        }
        GSYNC();
        {
            PH_HEAD();
            pg8::StaticOrder S; S.init(MTOK, 1024, G, bid);
            { pg8::Gemm g{Oa, RW + W1_BA, MTOK, 1024, 512, 512, 512}; EpiBr E{Gt, MX, 0}; pg8::gemm_phase<EpiBr>(lds, g, S, E, wv); }
            { pg8::Gemm g{Ob, RW + W1_BB, MTOK, 1024, 512, 512, 512}; EpiBr E{Gt, MX, 1}; pg8::gemm_phase<EpiBr>(lds, g, S, E, wv); }
            { pg8::Gemm g{zC, RW + W1_BC, MTOK, 1024, 512, 1024, 512}; EpiBr E{Gt, MX, 2}; pg8::gemm_phase<EpiBr>(lds, g, S, E, wv); }
        }
        GSYNC();
        {
            PH_HEAD();
            pg8::Gemm g{MX, RW + W1_MIX, MTOK, 1024, 1024, 1024, 1024}; pg8::StaticOrder S; S.init(MTOK, 1024, G, bid);
            EpiRes E{l == 0 ? INP(0) : (const float*)xres, xres, xfree, P};
            pg8::gemm_phase<EpiRes>(lds, g, S, E, wv);
        }
        par ^= 1;
        GSYNC();
        {
            PH_HEAD();
            LAS float* scr = (LAS float*)(lds + wave * 8448);
            const float* wxq = INP(21) + (size_t)l * 1024 * 1024; const float* xan = INP(19) + l * 1024;
            const float* wxkv = INP(22) + (size_t)l * 1024 * 2048; const float* memn = INP(20) + l * 1024;
            const float* wxo = INP(23) + (size_t)l * 1024 * 1024;
            const float* wfi = INP(25) + (size_t)l * 1024 * 2 * DFF; const float* ffn = INP(24) + l * 1024;
            const float* wfo = INP(26) + (size_t)l * DFF * 1024;
            constexpr int I_XQ = 16 * 32, I_XKV = 16 * 64, I_FI = 16 * 176, I_FO = 44 * 32;
            constexpr int NIT = 2 * I_XQ + I_XKV + I_FI + I_FO;
            for (int it = gw; it < NIT; it += NGW) {
                int r = it;
                if (r < I_XQ) { conv_item(wxq, 1024, 1024, 1024, 0, xan, RW + W2_XQ, scr, r, lane); continue; } r -= I_XQ;
                if (r < I_XKV) { conv_item(wxkv, 1024, 2048, 2048, 0, memn, RW + W2_XKV, scr, r, lane); continue; } r -= I_XKV;
                if (r < I_XQ) { conv_item(wxo, 1024, 1024, 1024, 0, nullptr, RW + W2_XO, scr, r, lane); continue; } r -= I_XQ;
                if (r < I_FI) { conv_item(wfi, 1024, 2 * DFF, 2 * DFF, 2, ffn, RW + W2_FI, scr, r, lane); continue; } r -= I_FI;
                conv_item(wfo, DFF, 1024, 1024, 0, nullptr, RW + W2_FO, scr, r, lane);
            }
        }
        __syncthreads();
        GSYNC();
        {
            PH_HEAD();
            { pg8::Gemm g{xcur, RW + W2_XQ, MTOK, 1024, 1024, 1024, 1024}; pg8::StaticOrder S; S.init(MTOK, 1024, G, bid);
              EpiPlain<false> E{P, QX, 1024, XSC}; pg8::gemm_phase<EpiPlain<false>>(lds, g, S, E, wv); }
            { pg8::Gemm g{memb, RW + W2_XKV, NB * NMEM, 2048, 1024, 1024, 1024}; pg8::StaticOrder S; S.init(NB * NMEM, 2048, G, bid);
              EpiKVm E{mrstd, Km, Vmt}; pg8::gemm_phase<EpiKVm>(lds, g, S, E, wv); }
        }
        GSYNC();
        {
            PH_HEAD();
            for (int u = bid; u < 256; u += G) xattn_unit(lds, QX, Km, Vmt, u >> 7, (u >> 5) & 3, u & 31, wv);
        }
        GSYNC();
        {
            PH_HEAD();
            pg8::Gemm g{QX, RW + W2_XO, MTOK, 1024, 1024, 1024, 1024}; pg8::StaticOrder S; S.init(MTOK, 1024, G, bid);
            EpiRes E{xres, xres, xcur, P};
            pg8::gemm_phase<EpiRes>(lds, g, S, E, wv);
        }
        GSYNC();
        {
            PH_HEAD();
            pg8::Gemm g{xcur, RW + W2_FI, MTOK, 2 * DFF, 1024, 1024, 1024}; pg8::StaticOrder S; S.init(MTOK, 2 * DFF, G, bid);
            EpiFF E{P, ACT};
            pg8::gemm_phase<EpiFF>(lds, g, S, E, wv);
        }
        GSYNC();
        {
            PH_HEAD();
            pg8::Gemm g{ACT, RW + W2_FO, MTOK, 1024, DFF, DFF, DFF}; pg8::StaticOrder S; S.init(MTOK, 1024, G, bid);
            EpiRes E{xres, xres, xcur, P};
            pg8::gemm_phase<EpiRes>(lds, g, S, E, wv);
        }
        GSYNC();
    }
    {
        PH_HEAD();
        const float* fn = INP(27);
        for (int m = gw; m < MTOK; m += NGW) {
            const float rs = row_rstd16(P, m);
            f32x4* xr = (f32x4*)(xres + (size_t)m * 1024) + lane; const f32x4* gp = (const f32x4*)fn + lane;
#pragma unroll
            for (int j = 0; j < 4; ++j) { const f32x4 v = xr[64 * j], gg = gp[64 * j]; xr[64 * j] = v * rs * gg; }
        }
    }
}

extern "C" void kernel_launch(void* const* d_in, const int* in_sizes, int n_in, void* d_out, int out_size, void* d_ws, size_t ws_size, hipStream_t stream) {
    static int grid = 0;
    if (grid == 0) {
        if (n_in != 28 || out_size != MTOK * DM || ws_size < WS_END) { fprintf(stderr, "kernel_launch: unexpected problem (n_in %d out %d ws %zu)\n", n_in, out_size, ws_size); grid = -1; return; }
        int dev = 0, cus = 0, per_cu = 0;
        (void)hipGetDevice(&dev);
        (void)hipDeviceGetAttribute(&cus, hipDeviceAttributeMultiprocessorCount, dev);
        (void)hipFuncSetAttribute((const void*)mega_fwd, hipFuncAttributeMaxDynamicSharedMemorySize, LDS_BYTES);
        (void)hipOccupancyMaxActiveBlocksPerMultiprocessor(&per_cu, (const void*)mega_fwd, 512, LDS_BYTES);
        if (per_cu < 1 || cus < 1) { fprintf(stderr, "kernel_launch: occupancy query gave %d blocks/CU on %d CUs\n", per_cu, cus); grid = -1; return; }
        grid = cus;
    }
    if (grid < 0) return;
    (void)hipMemsetAsync((char*)d_ws + WS_CTL, 0, CTL_BYTES, stream);
    Args a{};
    for (int i = 0; i < 28; ++i) a.in[i] = (const float*)d_in[i];
    a.out = (float*)d_out; a.ws = (unsigned char*)d_ws;
    void* kargs[] = {&a};
    hipError_t e = hipLaunchCooperativeKernel((const void*)mega_fwd, dim3(grid), dim3(512), kargs, LDS_BYTES, stream);
    if (e != hipSuccess) fprintf(stderr, "cooperative launch failed: %s (grid %d)\n", hipGetErrorString(e), grid);
}
```

```cpp
#include <hip/hip_runtime.h>
#include <hip/hip_cooperative_groups.h>
#include <cstdio>
#include <cstdint>
namespace cg = cooperative_groups;

#define LAS __attribute__((address_space(3)))
#define DI __device__ __forceinline__
typedef unsigned short bf16_t;
typedef short bf16x8 __attribute__((ext_vector_type(8)));
typedef float f32x2 __attribute__((ext_vector_type(2)));
typedef float f32x4 __attribute__((ext_vector_type(4)));
typedef float f32x16 __attribute__((ext_vector_type(16)));
typedef unsigned u32x2 __attribute__((ext_vector_type(2)));
typedef unsigned u32x4 __attribute__((ext_vector_type(4)));

constexpr int SEQ = 8192, NB = 2, MTOK = NB * SEQ, DM = 1024, NMEM = 256;
constexpr int INW = 6816, DFF = 2816;
constexpr float EPS = 1e-6f;
constexpr float QSC = 0.10206207261596575f * 1.4426950408889634f;
constexpr float XSC = 0.0625f * 1.4426950408889634f;

DI unsigned cvt_pk(float lo, float hi) {
    typedef __bf16 b2 __attribute__((ext_vector_type(2)));
    f32x2 v = {lo, hi}; b2 b = __builtin_convertvector(v, b2); return __builtin_bit_cast(unsigned, b);
}
DI bf16_t f2bf(float f) { return (bf16_t)(cvt_pk(f, 0.f) & 0xffffu); }
DI float bf2f(bf16_t h) { return __uint_as_float((unsigned)h << 16); }
DI float bflo(unsigned w) { return __uint_as_float(w << 16); }
DI float bfhi(unsigned w) { return __uint_as_float(w & 0xffff0000u); }
DI int olane() { int t = __builtin_amdgcn_mbcnt_hi(~0u, __builtin_amdgcn_mbcnt_lo(~0u, 0u)); asm volatile("" : "+v"(t)); return t; }
DI int otid(int wv) { return wv * 64 + olane(); }
DI float wave_sum(float v) {
#pragma unroll
    for (int o = 1; o < 64; o <<= 1) v += __shfl_xor(v, o);
    return v;
}
DI float sigm(float x) { return __builtin_amdgcn_rcpf(1.f + __expf(-x)); }
DI float gelu_erf(float v) {
    const float av = fabsf(v), t = __builtin_amdgcn_rcpf(av * 0.2316418882f + 1.0f);
    float q = t * 0.5307027145f + (-0.7265760135f); q = q * t + 0.7107068705f; q = q * t + (-0.142248368f); q = q * t + 0.127414796f; q = q * t;
    const float e = __builtin_amdgcn_exp2f((v * v) * (-0.72134752044f));
    const float m = v * (q * e);
    return v < 0.f ? m : v - m;
}
DI int crow(int r, int h) { return (r & 3) + 8 * (r >> 2) + 4 * h; }
DI float dot4(f32x4 a) { return (a.x * a.x + a.y * a.y) + (a.z * a.z + a.w * a.w); }
DI float sum4(f32x4 a) { return (a.x + a.y) + (a.z + a.w); }
#define MFMA32(a, b, c) __builtin_amdgcn_mfma_f32_32x32x16_bf16((a), (b), (c), 0, 0, 0)
DI bf16x8 mk8(u32x2 lo, u32x2 hi) { u32x4 v = {lo.x, lo.y, hi.x, hi.y}; return __builtin_bit_cast(bf16x8, v); }
DI bf16x8 pack8(float a0, float a1, float a2, float a3, float a4, float a5, float a6, float a7) {
    u32x4 v = {cvt_pk(a0, a1), cvt_pk(a2, a3), cvt_pk(a4, a5), cvt_pk(a6, a7)}; return __builtin_bit_cast(bf16x8, v);
}

namespace pg8 {
constexpr int BM = 256, BK = 64, HALF = 128, HTB = HALF * BK * 2, STAGE_BYTES = 8 * HTB, NXCD = 8, WGM = 8;
DI int lds_byte(int r, int c) { const int st = (r >> 4) * 2 + (c >> 5), rr = r & 15, cc = c & 31, ob = rr * 64 + cc * 2; return st * 1024 + (ob ^ (((ob >> 9) & 1) << 5)); }
DI void stage_rc(int b, int& R, int& C) { const int st = b / 1024, sb = b % 1024, swz = sb ^ (((sb >> 9) & 1) << 5); R = (st >> 1) * 16 + swz / 64; C = (st & 1) * 32 + (swz % 64) / 2; }
DI int perm32(int rho) { const int n = rho >> 4, i = rho & 15; return 8 * (i >> 2) + 4 * n + (i & 3); }
struct Unit { int pm, pn; };
struct Gemm { const bf16_t* A; const bf16_t* Bt; int M, N, K, lda, ldb; };
struct StaticOrder {
    int nM, nN, nwg, G, c;
    DI void init(int M, int N, int G_, int c_) { nM = M / BM; nN = N / BM; nwg = nM * nN; G = G_; c = c_; }
    DI bool next(int i, Unit& u) const {
        const long L = (long)i * G + c; if (L >= nwg) return false;
        int wgid = (int)L; { const int q = nwg / NXCD, r = nwg % NXCD, xcd = wgid % NXCD, off = wgid / NXCD; wgid = (xcd < r ? xcd * (q + 1) : r * (q + 1) + (xcd - r) * q) + off; }
        const int nig = WGM * nN, gid = wgid / nig, fm = gid * WGM, gsz = (nM - fm) < WGM ? (nM - fm) : WGM;
        u.pm = fm + ((wgid % nig) % gsz); u.pn = (wgid % nig) / gsz; return true;
    }
};
template <class Epi>
DI void gemm_phase(LAS unsigned char* lds, const Gemm g, const StaticOrder& S, const Epi& E, int wv) {
    const int tid = otid(wv), wid = __builtin_amdgcn_readfirstlane(tid >> 6), lane = tid & 63, wr = wid >> 2, wc = wid & 3, fr = lane & 15, fq = lane >> 4;
    const int K = g.K, nt = K / BK;
    unsigned voffA[2], voffB[2];
#pragma unroll
    for (int i = 0; i < 2; ++i) { int R, C; stage_rc(tid * 16 + i * 8192, R, C); const int Rb = Epi::PERM ? ((R & ~31) + perm32(R & 31)) : R;
        voffA[i] = (unsigned)(R * g.lda + C) * 2u; voffB[i] = (unsigned)(Rb * g.ldb + C) * 2u; }
    const size_t kstep = (size_t)(BK * 2);
    const size_t hsA = (size_t)HALF * g.lda * 2, hsB = (size_t)HALF * g.ldb * 2;
    const size_t tsA = 2 * hsA, tsB = 2 * hsB;
    const unsigned ldsw = (unsigned)wid * 1024u;
    const int aoff = lds_byte(wr * 64 + fr, fq * 8), boff = lds_byte(wc * 32 + fr, fq * 8);
#define PG8_SA(b, h) (((b) * 2 + (h)) * HTB)
#define PG8_SB(b, h) ((4 + (b) * 2 + (h)) * HTB)
#define PG8_STAGE(bufoff, gbase, voff) do { const char* gb_ = (const char*)(gbase); asm volatile("" : "+s"(gb_)); _Pragma("unroll") for (int _i = 0; _i < 2; ++_i) { unsigned vo_ = (voff)[_i]; asm volatile("" : "+v"(vo_)); \
        __builtin_amdgcn_global_load_lds((const unsigned*)(gb_ + vo_), (LAS unsigned*)(lds + (bufoff) + ldsw + _i * 8192), 16, 0, 0); } } while (0)
#define PG8_LDA(dst, b, h) do { _Pragma("unroll") for (int m = 0; m < 4; ++m) _Pragma("unroll") for (int k = 0; k < 2; ++k) dst[m][k] = *(const LAS bf16x8*)(lds + PG8_SA(b, h) + aoff + m * 2048 + k * 1024); } while (0)
#define PG8_LDB(dst, b, h) do { _Pragma("unroll") for (int n = 0; n < 2; ++n) _Pragma("unroll") for (int k = 0; k < 2; ++k) dst[n][k] = *(const LAS bf16x8*)(lds + PG8_SB(b, h) + boff + n * 2048 + k * 1024); } while (0)
#define PG8_MMA(ai, bj, At, Bt) do { __builtin_amdgcn_s_setprio(1); _Pragma("unroll") for (int m = 0; m < 4; ++m) _Pragma("unroll") for (int n = 0; n < 2; ++n) _Pragma("unroll") for (int k = 0; k < 2; ++k) \
        acc[ai][bj][m][n] = __builtin_amdgcn_mfma_f32_16x16x32_bf16(Bt[n][k], At[m][k], acc[ai][bj][m][n], 0, 0, 0); __builtin_amdgcn_s_setprio(0); } while (0)
#define PG8_WAIT_V(n) asm volatile("s_waitcnt vmcnt(" #n ")" ::: "memory")
#define PG8_WAIT_L(n) asm volatile("s_waitcnt lgkmcnt(" #n ")" ::: "memory")
#define PG8_BAR __builtin_amdgcn_s_barrier()
#define PG8_SCHED __builtin_amdgcn_sched_barrier(0)
    Unit cur, nxt; int ui = 0;
    if (!S.next(0, cur)) return;
    f32x4 acc[2][2][4][2];
#pragma unroll
    for (int a = 0; a < 2; ++a)
#pragma unroll
        for (int b = 0; b < 2; ++b)
#pragma unroll
            for (int m = 0; m < 4; ++m)
#pragma unroll
                for (int n = 0; n < 2; ++n) acc[a][b][m][n] = (f32x4){0.f, 0.f, 0.f, 0.f};
    bf16x8 At[4][2], B0[2][2], B1[2][2];
    const char* cA = (const char*)g.A + (size_t)cur.pm * tsA; const char* cB = (const char*)g.Bt + (size_t)cur.pn * tsB;
    PG8_STAGE(PG8_SB(0, 0), cB, voffB); PG8_STAGE(PG8_SB(0, 1), cB + hsB, voffB); PG8_STAGE(PG8_SA(0, 0), cA, voffA); PG8_STAGE(PG8_SA(0, 1), cA + hsA, voffA);
    if (wr == 1) PG8_BAR;
    PG8_WAIT_V(2); PG8_BAR;
    PG8_STAGE(PG8_SB(1, 0), cB + kstep, voffB); PG8_STAGE(PG8_SA(1, 0), cA + kstep, voffA); PG8_STAGE(PG8_SB(1, 1), cB + hsB + kstep, voffB);
    PG8_WAIT_V(6); PG8_BAR;
    for (;;) {
        const bool has_next = S.next(ui + 1, nxt);
        const char* nA = has_next ? (const char*)g.A + (size_t)nxt.pm * tsA : cA; const char* nB = has_next ? (const char*)g.Bt + (size_t)nxt.pn * tsB : cB;
        for (int t = 0; t < nt; t += 2) {
            const bool last = (t == nt - 2);
            const char* a1 = cA + (size_t)(t + 1) * kstep;
            const char* a2 = last ? nA : cA + (size_t)(t + 2) * kstep; const char* b2 = last ? nB : cB + (size_t)(t + 2) * kstep;
            const char* a3 = a2 + kstep; const char* b3 = b2 + kstep;
            PG8_LDB(B0, 0, 0); PG8_LDB(B1, 0, 1); PG8_SCHED; PG8_LDA(At, 0, 0); PG8_STAGE(PG8_SA(1, 1), a1 + hsA, voffA);
            PG8_WAIT_V(8); PG8_WAIT_L(0); PG8_BAR; PG8_MMA(0, 0, At, B0); PG8_MMA(0, 1, At, B1); PG8_BAR; PG8_SCHED;
            PG8_LDA(At, 0, 1); PG8_STAGE(PG8_SB(0, 0), b2, voffB); PG8_STAGE(PG8_SB(0, 1), b2 + hsB, voffB); PG8_STAGE(PG8_SA(0, 0), a2, voffA);
            PG8_WAIT_V(8); PG8_WAIT_L(0); PG8_BAR; PG8_MMA(1, 0, At, B0); PG8_MMA(1, 1, At, B1); PG8_BAR; PG8_SCHED;
            PG8_LDB(B0, 1, 0); PG8_LDB(B1, 1, 1); PG8_SCHED; PG8_LDA(At, 1, 0); PG8_STAGE(PG8_SA(0, 1), a2 + hsA, voffA);
            PG8_WAIT_V(8); PG8_WAIT_L(0); PG8_BAR; PG8_MMA(0, 0, At, B0); PG8_MMA(0, 1, At, B1); PG8_BAR; PG8_SCHED;
            PG8_LDA(At, 1, 1); PG8_STAGE(PG8_SB(1, 0), b3, voffB); PG8_STAGE(PG8_SB(1, 1), b3 + hsB, voffB); PG8_STAGE(PG8_SA(1, 0), a3, voffA);
            PG8_WAIT_V(8); PG8_WAIT_L(0); PG8_BAR; PG8_MMA(1, 0, At, B0); PG8_MMA(1, 1, At, B1); PG8_BAR; PG8_SCHED;
        }
        if (wr == 0) PG8_BAR;
        { const int ln_ = olane(); E(acc, cur, wr, wc, ln_ & 15, ln_ >> 4); }
        if (!has_next) break;
#pragma unroll
        for (int a = 0; a < 2; ++a)
#pragma unroll
            for (int b = 0; b < 2; ++b)
#pragma unroll
                for (int m = 0; m < 4; ++m)
#pragma unroll
                    for (int n = 0; n < 2; ++n) acc[a][b][m][n] = (f32x4){0.f, 0.f, 0.f, 0.f};
        cur = nxt; cA = nA; cB = nB; ++ui;
        if (wr == 1) PG8_BAR;
    }
    PG8_WAIT_V(0);
    PG8_BAR;
#undef PG8_SA
#undef PG8_SB
#undef PG8_STAGE
#undef PG8_LDA
#undef PG8_LDB
#undef PG8_MMA
#undef PG8_WAIT_V
#undef PG8_WAIT_L
#undef PG8_BAR
#undef PG8_SCHED
}
}
typedef const f32x4 (&AccRef)[2][2][4][2];

DI float row_rstd16(const float* P, int row) {
    const f32x4* p = (const f32x4*)(P + (size_t)row * 16);
    const float s = (sum4(p[0]) + sum4(p[1])) + (sum4(p[2]) + sum4(p[3]));
    return rsqrtf(s * (1.0f / 1024.0f) + EPS);
}
DI u32x4 pk16(f32x4 v0, f32x4 v1) { u32x4 w; w.x = cvt_pk(v0[0], v0[1]); w.y = cvt_pk(v0[2], v0[3]); w.z = cvt_pk(v1[0], v1[1]); w.w = cvt_pk(v1[2], v1[3]); return w; }
DI u32x2 pk8(f32x4 v) { u32x2 w; w.x = cvt_pk(v[0], v[1]); w.y = cvt_pk(v[2], v[3]); return w; }

struct EpiA { static constexpr bool PERM = true;
    const float* P; bf16_t* zA; bf16_t* zB; bf16_t* zC; float* PA;
    DI void operator()(AccRef acc, const pg8::Unit& u, int wr, int wc, int fr, int fq) const {
        const int pn = u.pn; bf16_t* base; int ld, colt;
        if (pn < 3) { base = zA; ld = 768; colt = pn * 256; } else if (pn < 11) { base = zB; ld = 2048; colt = (pn - 3) * 256; } else { base = zC; ld = 1024; colt = (pn - 11) * 256; }
        const int row0 = u.pm * 256 + wr * 64 + fr, col0 = colt + wc * 32 + 8 * fq;
#pragma unroll
        for (int ai = 0; ai < 2; ++ai)
#pragma unroll
            for (int m = 0; m < 4; ++m) { const int row = row0 + ai * 128 + m * 16; const float rs = row_rstd16(P, row);
#pragma unroll
                for (int bj = 0; bj < 2; ++bj) { const f32x4 v0 = acc[ai][bj][m][0] * rs, v1 = acc[ai][bj][m][1] * rs;
                    if (pn < 3) { float s = dot4(v0) + dot4(v1); s += __shfl_xor(s, 16); s += __shfl_xor(s, 32); if (fq == 0) PA[(size_t)row * 32 + pn * 8 + bj * 4 + wc] = s; }
                    *(u32x4*)(base + (size_t)row * ld + col0 + bj * 128) = pk16(v0, v1); } }
    }
};
template <bool SIG> struct EpiPlain { static constexpr bool PERM = true;
    const float* P; bf16_t* O; int ldo; float scale;
    DI void operator()(AccRef acc, const pg8::Unit& u, int wr, int wc, int fr, int fq) const {
        const int row0 = u.pm * 256 + wr * 64 + fr, col0 = u.pn * 256 + wc * 32 + 8 * fq;
#pragma unroll
        for (int ai = 0; ai < 2; ++ai)
#pragma unroll
            for (int m = 0; m < 4; ++m) { const int row = row0 + ai * 128 + m * 16; const float rs = row_rstd16(P, row) * scale;
#pragma unroll
                for (int bj = 0; bj < 2; ++bj) { f32x4 v0 = acc[ai][bj][m][0] * rs, v1 = acc[ai][bj][m][1] * rs;
                    if (SIG) {
#pragma unroll
                        for (int e = 0; e < 4; ++e) { v0[e] = sigm(v0[e]); v1[e] = sigm(v1[e]); } }
                    *(u32x4*)(O + (size_t)row * ldo + col0 + bj * 128) = pk16(v0, v1); } }
    }
};
struct EpiQ { static constexpr bool PERM = false;
    const float* PA; const float* CS; bf16_t* Q;
    DI void operator()(AccRef acc, const pg8::Unit& u, int wr, int wc, int fr, int fq) const {
        const int row0 = u.pm * 256 + wr * 64 + fr;
#pragma unroll
        for (int ai = 0; ai < 2; ++ai)
#pragma unroll
            for (int m = 0; m < 4; ++m) { const int row = row0 + ai * 128 + m * 16;
                const f32x4* pp = (const f32x4*)(PA + (size_t)row * 32);
                const float ss = sum4(pp[0]) + sum4(pp[1]) + sum4(pp[2]);
                const float rs = rsqrtf(ss * (1.0f / 384.0f) + EPS);
                const f32x4 cs = *(const f32x4*)(CS + (size_t)row * 32 + 4 * fq), sn = *(const f32x4*)(CS + (size_t)row * 32 + 16 + 4 * fq);
#pragma unroll
                for (int bj = 0; bj < 2; ++bj) { const int g32 = u.pn * 8 + bj * 4 + wc;
                    f32x4 v0 = acc[ai][bj][m][0] * rs, v1 = acc[ai][bj][m][1] * rs;
                    if ((g32 % 3) == 2) { const f32x4 y0 = v0 * cs - v1 * sn, y1 = v0 * sn + v1 * cs; v0 = y0; v1 = y1; }
                    v0 = v0 * QSC; v1 = v1 * QSC;
                    bf16_t* o = Q + (size_t)row * 768 + u.pn * 256 + bj * 128 + wc * 32 + 4 * fq;
                    *(u32x2*)(o) = pk8(v0); *(u32x2*)(o + 16) = pk8(v1); } }
    }
};
struct EpiKV { static constexpr bool PERM = true;
    const float* PA; bf16_t* Kn; bf16_t* Vt;
    DI void operator()(AccRef acc, const pg8::Unit& u, int wr, int wc, int fr, int fq) const {
        const int row0 = u.pm * 256 + wr * 64 + fr;
#pragma unroll
        for (int ai = 0; ai < 2; ++ai)
#pragma unroll
            for (int m = 0; m < 4; ++m) { const int row = row0 + ai * 128 + m * 16;
                const f32x4* pp = (const f32x4*)(PA + (size_t)row * 32 + 12);
                const float ss = sum4(pp[0]) + sum4(pp[1]);
                const float rs = rsqrtf(ss * (1.0f / 256.0f) + EPS);
                const int b = row / SEQ, tok = row % SEQ;
#pragma unroll
                for (int bj = 0; bj < 2; ++bj) { const int h = 2 * u.pn + bj;
                    const f32x4 v0 = acc[ai][bj][m][0] * rs, v1 = acc[ai][bj][m][1] * rs;
                    if (wc < 2) { *(u32x4*)(Kn + (size_t)row * 512 + h * 64 + wc * 32 + 8 * fq) = pk16(v0, v1); }
                    else { bf16_t* vp = Vt + ((size_t)(b * 8 + h) * 64 + (wc - 2) * 32 + 8 * fq) * SEQ + tok;
#pragma unroll
                        for (int e = 0; e < 4; ++e) { vp[(size_t)e * SEQ] = f2bf(v0[e]); vp[(size_t)(4 + e) * SEQ] = f2bf(v1[e]); } } } }
    }
};
struct EpiBr { static constexpr bool PERM = true;
    const bf16_t* G; bf16_t* MX; int j;
    DI void operator()(AccRef acc, const pg8::Unit& u, int wr, int wc, int fr, int fq) const {
        const int row0 = u.pm * 256 + wr * 64 + fr, col0 = u.pn * 256 + wc * 32 + 8 * fq;
#pragma unroll
        for (int ai = 0; ai < 2; ++ai)
#pragma unroll
            for (int m = 0; m < 4; ++m) { const int row = row0 + ai * 128 + m * 16;
#pragma unroll
                for (int bj = 0; bj < 2; ++bj) { const int col = col0 + bj * 128;
                    const u32x4 gw = *(const u32x4*)(G + (size_t)row * 3072 + j * 1024 + col);
                    f32x4 v0 = acc[ai][bj][m][0], v1 = acc[ai][bj][m][1];
                    v0[0] *= bflo(gw.x); v0[1] *= bfhi(gw.x); v0[2] *= bflo(gw.y); v0[3] *= bfhi(gw.y);
                    v1[0] *= bflo(gw.z); v1[1] *= bfhi(gw.z); v1[2] *= bflo(gw.w); v1[3] *= bfhi(gw.w);
                    bf16_t* mp = MX + (size_t)row * 1024 + col;
                    if (j > 0) { const u32x4 ow = *(const u32x4*)mp;
                        v0[0] += bflo(ow.x); v0[1] += bfhi(ow.x); v0[2] += bflo(ow.y); v0[3] += bfhi(ow.y);
                        v1[0] += bflo(ow.z); v1[1] += bfhi(ow.z); v1[2] += bflo(ow.w); v1[3] += bfhi(ow.w); }
                    *(u32x4*)mp = pk16(v0, v1); } }
    }
};
struct EpiRes { static constexpr bool PERM = false;
    const float* xin; float* xout; bf16_t* xb; float* P;
    DI void operator()(AccRef acc, const pg8::Unit& u, int wr, int wc, int fr, int fq) const {
        const int row0 = u.pm * 256 + wr * 64 + fr, col0 = u.pn * 256 + wc * 32 + 4 * fq;
#pragma unroll
        for (int ai = 0; ai < 2; ++ai)
#pragma unroll
            for (int m = 0; m < 4; ++m) { const int row = row0 + ai * 128 + m * 16; float s = 0.f;
#pragma unroll
                for (int bj = 0; bj < 2; ++bj)
#pragma unroll
                    for (int n = 0; n < 2; ++n) { const size_t off = (size_t)row * 1024 + col0 + bj * 128 + n * 16;
                        const f32x4 xo = *(const f32x4*)(xin + off) + acc[ai][bj][m][n];
                        *(f32x4*)(xout + off) = xo; *(u32x2*)(xb + off) = pk8(xo); s += dot4(xo); }
                s += __shfl_xor(s, 16); s += __shfl_xor(s, 32);
                if (fq == 0) P[(size_t)row * 16 + u.pn * 4 + wc] = s; }
    }
};
struct EpiKVm { static constexpr bool PERM = true;
    const float* mrstd; bf16_t* Km; bf16_t* Vmt;
    DI void operator()(AccRef acc, const pg8::Unit& u, int wr, int wc, int fr, int fq) const {
        const int row0 = u.pm * 256 + wr * 64 + fr;
#pragma unroll
        for (int ai = 0; ai < 2; ++ai)
#pragma unroll
            for (int m = 0; m < 4; ++m) { const int row = row0 + ai * 128 + m * 16; const float rs = mrstd[row];
                const int b = row >> 8, key = row & 255;
#pragma unroll
                for (int bj = 0; bj < 2; ++bj) { const f32x4 v0 = acc[ai][bj][m][0] * rs, v1 = acc[ai][bj][m][1] * rs;
                    const int c = u.pn * 256 + bj * 128 + wc * 32 + 8 * fq;
                    if (u.pn < 4) { *(u32x4*)(Km + (size_t)row * 1024 + c) = pk16(v0, v1); }
                    else { const int c2 = c - 1024, h = c2 >> 8, dv = c2 & 255;
                        bf16_t* vp = Vmt + ((size_t)(b * 4 + h) * 256 + dv) * 256 + key;
#pragma unroll
                        for (int e = 0; e < 4; ++e) { vp[e * 256] = f2bf(v0[e]); vp[(4 + e) * 256] = f2bf(v1[e]); } } } }
    }
};
struct EpiFF { static constexpr bool PERM = false;
    const float* P; bf16_t* ACT;
    DI void operator()(AccRef acc, const pg8::Unit& u, int wr, int wc, int fr, int fq) const {
        const int row0 = u.pm * 256 + wr * 64 + fr;
#pragma unroll
        for (int ai = 0; ai < 2; ++ai)
#pragma unroll
            for (int m = 0; m < 4; ++m) { const int row = row0 + ai * 128 + m * 16; const float rs = row_rstd16(P, row);
#pragma unroll
                for (int bj = 0; bj < 2; ++bj) { const int G = u.pn * 8 + bj * 4 + wc;
                    const f32x4 gt = acc[ai][bj][m][0] * rs, up = acc[ai][bj][m][1] * rs; f32x4 a;
#pragma unroll
                    for (int e = 0; e < 4; ++e) a[e] = gt[e] * sigm(gt[e]) * up[e];
                    *(u32x2*)(ACT + (size_t)row * DFF + 16 * G + 4 * fq) = pk8(a); } }
    }
};

DI int srccol(int mode, int np) {
    if (mode == 1) return np < 672 ? np : (np < 768 ? -1 : np - 96);
    if (mode == 2) { const int G = np >> 5, s = (np >> 4) & 1, j = np & 15; return s * DFF + 16 * G + j; }
    return np;
}
DI void conv_item(const float* W, int K, int N, int Np, int mode, const float* gain, bf16_t* WT, LAS float* scr, int item, int lane) {
    const int nblk = Np / 64, kb = item / nblk, nb = item % nblk, k0 = 64 * kb, n0 = 64 * nb;
    const int r = lane >> 4, c4 = (lane & 15) * 4;
    const int sc = srccol(mode, n0 + c4);
    f32x4 v[16];
#pragma unroll
    for (int i = 0; i < 16; ++i) v[i] = (sc >= 0) ? *(const f32x4*)(W + (size_t)(k0 + 4 * i + r) * N + sc) : (f32x4){0.f, 0.f, 0.f, 0.f};
#pragma unroll
    for (int i = 0; i < 16; ++i) { const int row = 4 * i + r; const float gn = gain ? gain[k0 + row] : 1.0f; LAS float* d = scr + row * 65 + c4;
        d[0] = v[i][0] * gn; d[1] = v[i][1] * gn; d[2] = v[i][2] * gn; d[3] = v[i][3] * gn; }
    asm volatile("s_waitcnt lgkmcnt(0)" ::: "memory");
    const int c = lane & 7;
#pragma unroll
    for (int jj = 0; jj < 8; ++jj) { const int n = (lane >> 3) + 8 * jj; const LAS float* sp = scr + (8 * c) * 65 + n;
        u32x4 o; o.x = cvt_pk(sp[0 * 65], sp[1 * 65]); o.y = cvt_pk(sp[2 * 65], sp[3 * 65]); o.z = cvt_pk(sp[4 * 65], sp[5 * 65]); o.w = cvt_pk(sp[6 * 65], sp[7 * 65]);
        *(u32x4*)(WT + (size_t)(n0 + n) * K + k0 + 8 * c) = o; }
    asm volatile("s_waitcnt lgkmcnt(0)" ::: "memory");
}

DI void attn_unit(LAS unsigned char* lds, const bf16_t* Q, const bf16_t* Kn, const bf16_t* Kr, const bf16_t* Vt, bf16_t* Oa, int b, int h, int qb, int wv) {
    const int tid = otid(wv), lane = tid & 63, w = __builtin_amdgcn_readfirstlane(tid >> 6), l32 = lane & 31, hi = lane >> 5;
    constexpr int KST = 208, VST = 136, KBUF = 64 * KST, VBUF = 64 * VST, VOFF = 2 * KBUF;
    const size_t rowb = (size_t)b * SEQ;
    const int qrow = qb * 256 + 32 * w + l32;
    bf16x8 qf[6];
#pragma unroll
    for (int ks = 0; ks < 6; ++ks) qf[ks] = *(const bf16x8*)(Q + (rowb + qrow) * 768 + h * 96 + 16 * ks + 8 * hi);
    f32x16 o0, o1;
#pragma unroll
    for (int r = 0; r < 16; ++r) { o0[r] = 0.f; o1[r] = 0.f; }
    float mrun = -INFINITY, lrun = 0.f;
    const int NT = 4 * qb + 4, tlast = 4 * qb + (w >> 1);
    const int kkey = tid >> 3, kch = tid & 7, rkey = (tid & 255) >> 2, rch = tid & 3;
    const bf16_t* gK = Kn + (rowb + kkey) * 512 + h * 64 + kch * 8;
    const bf16_t* gR = Kr + (rowb + rkey) * 32 + rch * 8;
    const bf16_t* gV = Vt + ((size_t)(b * 8 + h) * 64 + kkey) * SEQ + kch * 8;
    u32x4 rk, rr, rv;
    rr = (u32x4){0u, 0u, 0u, 0u};
    rk = *(const u32x4*)gK; if (tid < 256) rr = *(const u32x4*)gR; rv = *(const u32x4*)gV;
    {
        *(LAS u32x4*)(lds + kkey * KST + kch * 16) = rk;
        if (tid < 256) *(LAS u32x4*)(lds + rkey * KST + 128 + rch * 16) = rr;
        *(LAS u32x2*)(lds + VOFF + kkey * VST + kch * 16) = (u32x2){rv.x, rv.y};
        *(LAS u32x2*)(lds + VOFF + kkey * VST + kch * 16 + 8) = (u32x2){rv.z, rv.w};
    }
    __syncthreads();
    for (int t = 0; t < NT; ++t) {
        const int cur = t & 1;
        if (t + 1 < NT) {
            rk = *(const u32x4*)(gK + (size_t)(t + 1) * 64 * 512);
            if (tid < 256) rr = *(const u32x4*)(gR + (size_t)(t + 1) * 64 * 32);
            rv = *(const u32x4*)(gV + (size_t)(t + 1) * 64);
        }
        if (t <= tlast) {
            const LAS unsigned char* kb_ = lds + cur * KBUF;
            const LAS unsigned char* vb_ = lds + VOFF + cur * VBUF;
            f32x16 s0, s1;
#pragma unroll
            for (int r = 0; r < 16; ++r) { s0[r] = 0.f; s1[r] = 0.f; }
#pragma unroll
            for (int ks = 0; ks < 6; ++ks) {
                const bf16x8 a0 = *(const LAS bf16x8*)(kb_ + l32 * KST + (16 * ks + 8 * hi) * 2);
                const bf16x8 a1 = *(const LAS bf16x8*)(kb_ + (32 + l32) * KST + (16 * ks + 8 * hi) * 2);
                s0 = MFMA32(a0, qf[ks], s0); s1 = MFMA32(a1, qf[ks], s1);
            }
            if (t == tlast) {
#pragma unroll
                for (int r = 0; r < 16; ++r) { const int key = 64 * t + crow(r, hi);
                    if (key > qrow) s0[r] = -INFINITY;
                    if (key + 32 > qrow) s1[r] = -INFINITY; }
            }
            float mx = fmaxf(s0[0], s1[0]);
#pragma unroll
            for (int r = 1; r < 16; ++r) mx = fmaxf(mx, fmaxf(s0[r], s1[r]));
            mx = fmaxf(mx, __shfl_xor(mx, 32));
            const float mnew = fmaxf(mrun, mx);
            const float alpha = __builtin_amdgcn_exp2f(mrun - mnew);
            mrun = mnew;
            float ps = 0.f;
#pragma unroll
            for (int r = 0; r < 16; ++r) { s0[r] = __builtin_amdgcn_exp2f(s0[r] - mnew); s1[r] = __builtin_amdgcn_exp2f(s1[r] - mnew); ps += s0[r] + s1[r]; }
            lrun = lrun * alpha + ps;
#pragma unroll
            for (int r = 0; r < 16; ++r) { o0[r] *= alpha; o1[r] *= alpha; }
#pragma unroll
            for (int s = 0; s < 4; ++s) {
                const int kb = s >> 1, sub = s & 1;
                bf16x8 P;
                if (kb == 0) P = pack8(s0[8 * sub + 0], s0[8 * sub + 1], s0[8 * sub + 2], s0[8 * sub + 3], s0[8 * sub + 4], s0[8 * sub + 5], s0[8 * sub + 6], s0[8 * sub + 7]);
                else         P = pack8(s1[8 * sub + 0], s1[8 * sub + 1], s1[8 * sub + 2], s1[8 * sub + 3], s1[8 * sub + 4], s1[8 * sub + 5], s1[8 * sub + 6], s1[8 * sub + 7]);
                const int koff = (32 * kb + 16 * sub + 4 * hi) * 2;
                const u32x2 a0l = *(const LAS u32x2*)(vb_ + l32 * VST + koff), a0h = *(const LAS u32x2*)(vb_ + l32 * VST + koff + 16);
                const u32x2 a1l = *(const LAS u32x2*)(vb_ + (32 + l32) * VST + koff), a1h = *(const LAS u32x2*)(vb_ + (32 + l32) * VST + koff + 16);
                o0 = MFMA32(mk8(a0l, a0h), P, o0); o1 = MFMA32(mk8(a1l, a1h), P, o1);
            }
        }
        if (t + 1 < NT) {
            LAS unsigned char* kd = lds + (cur ^ 1) * KBUF; LAS unsigned char* vd = lds + VOFF + (cur ^ 1) * VBUF;
            *(LAS u32x4*)(kd + kkey * KST + kch * 16) = rk;
            if (tid < 256) *(LAS u32x4*)(kd + rkey * KST + 128 + rch * 16) = rr;
            *(LAS u32x2*)(vd + kkey * VST + kch * 16) = (u32x2){rv.x, rv.y};
            *(LAS u32x2*)(vd + kkey * VST + kch * 16 + 8) = (u32x2){rv.z, rv.w};
        }
        __syncthreads();
    }
    const float lt = lrun + __shfl_xor(lrun, 32);
    const float inv = 1.0f / lt;
    bf16_t* op = Oa + (rowb + qrow) * 512 + h * 64;
#pragma unroll
    for (int g = 0; g < 4; ++g) {
        u32x2 w0, w1;
        w0.x = cvt_pk(o0[4 * g] * inv, o0[4 * g + 1] * inv); w0.y = cvt_pk(o0[4 * g + 2] * inv, o0[4 * g + 3] * inv);
        w1.x = cvt_pk(o1[4 * g] * inv, o1[4 * g + 1] * inv); w1.y = cvt_pk(o1[4 * g + 2] * inv, o1[4 * g + 3] * inv);
        *(u32x2*)(op + 8 * g + 4 * hi) = w0; *(u32x2*)(op + 32 + 8 * g + 4 * hi) = w1;
    }
}

DI void xattn_unit(LAS unsigned char* lds, bf16_t* QX, const bf16_t* Km, const bf16_t* Vmt, int b, int h, int qb, int wv) {
    const int tid = otid(wv), lane = tid & 63, w = __builtin_amdgcn_readfirstlane(tid >> 6), l32 = lane & 31, hi = lane >> 5;
    constexpr int KST = 272, VST = 520, BUF = 64 * VST;
    const size_t row = (size_t)b * SEQ + qb * 256 + 32 * w + l32;
    bf16_t* qp = QX + row * 1024 + h * 256;
    f32x16 sacc[8];
#pragma unroll
    for (int i = 0; i < 8; ++i)
#pragma unroll
        for (int r = 0; r < 16; ++r) sacc[i][r] = 0.f;
    unsigned pp[8][8];
    bf16x8 qf[8];
    u32x4 pf[4];
#define XLOAD(i) do { if ((i) < 8) { const int dh_ = (i) >> 2, kt_ = (i) & 3; \
        _Pragma("unroll") for (int j = 0; j < 2; ++j) { const int id = tid + 512 * j, key = id >> 4, ch = id & 15; \
            pf[j] = *(const u32x4*)(Km + ((size_t)(b * 256 + 64 * kt_ + key)) * 1024 + h * 256 + 128 * dh_ + 8 * ch); } } \
      else { const int c_ = (i) - 8; \
        _Pragma("unroll") for (int j = 0; j < 4; ++j) { const int id = tid + 512 * j, dv = id >> 5, ch = id & 31; \
            pf[j] = *(const u32x4*)(Vmt + ((size_t)((b * 4 + h) * 256 + 64 * c_ + dv)) * 256 + 8 * ch); } } } while (0)
#define XSTORE(i, bufp) do { if ((i) < 8) { \
        _Pragma("unroll") for (int j = 0; j < 2; ++j) { const int id = tid + 512 * j, key = id >> 4, ch = id & 15; *(LAS u32x4*)((bufp) + key * KST + ch * 16) = pf[j]; } } \
      else { \
        _Pragma("unroll") for (int j = 0; j < 4; ++j) { const int id = tid + 512 * j, dv = id >> 5, ch = id & 31; \
            *(LAS u32x2*)((bufp) + dv * VST + ch * 16) = (u32x2){pf[j].x, pf[j].y}; *(LAS u32x2*)((bufp) + dv * VST + ch * 16 + 8) = (u32x2){pf[j].z, pf[j].w}; } } } while (0)
    XLOAD(0); XSTORE(0, lds);
    __syncthreads();
#pragma unroll
    for (int i = 0; i < 12; ++i) {
        const LAS unsigned char* cb_ = lds + (i & 1) * BUF;
        if (i + 1 < 12) XLOAD(i + 1);
        if (i < 8) {
            const int dh = i >> 2, kt = i & 3;
            if (kt == 0) {
#pragma unroll
                for (int ks = 0; ks < 8; ++ks) qf[ks] = *(const bf16x8*)(qp + 128 * dh + 16 * ks + 8 * hi);
            }
#pragma unroll
            for (int ks = 0; ks < 8; ++ks) {
                const bf16x8 a0 = *(const LAS bf16x8*)(cb_ + l32 * KST + (16 * ks + 8 * hi) * 2);
                const bf16x8 a1 = *(const LAS bf16x8*)(cb_ + (32 + l32) * KST + (16 * ks + 8 * hi) * 2);
                sacc[2 * kt] = MFMA32(a0, qf[ks], sacc[2 * kt]); sacc[2 * kt + 1] = MFMA32(a1, qf[ks], sacc[2 * kt + 1]);
            }
            if (i == 7) {
                float mx = sacc[0][0];
#pragma unroll
                for (int j = 0; j < 8; ++j)
#pragma unroll
                    for (int r = 0; r < 16; ++r) mx = fmaxf(mx, sacc[j][r]);
                mx = fmaxf(mx, __shfl_xor(mx, 32));
                float ps = 0.f;
#pragma unroll
                for (int j = 0; j < 8; ++j)
#pragma unroll
                    for (int r = 0; r < 16; ++r) { sacc[j][r] = __builtin_amdgcn_exp2f(sacc[j][r] - mx); ps += sacc[j][r]; }
                ps += __shfl_xor(ps, 32);
                const float inv = 1.0f / ps;
#pragma unroll
                for (int j = 0; j < 8; ++j)
#pragma unroll
                    for (int r2 = 0; r2 < 8; ++r2) pp[j][r2] = cvt_pk(sacc[j][2 * r2] * inv, sacc[j][2 * r2 + 1] * inv);
            }
        } else {
            const int c = i - 8;
            f32x16 o0, o1;
#pragma unroll
            for (int r = 0; r < 16; ++r) { o0[r] = 0.f; o1[r] = 0.f; }
#pragma unroll
            for (int s = 0; s < 16; ++s) {
                const int kb = s >> 1, sub = s & 1;
                const u32x4 pw = {pp[kb][4 * sub], pp[kb][4 * sub + 1], pp[kb][4 * sub + 2], pp[kb][4 * sub + 3]};
                const bf16x8 P = __builtin_bit_cast(bf16x8, pw);
                const int koff = (32 * kb + 16 * sub + 4 * hi) * 2;
                const u32x2 a0l = *(const LAS u32x2*)(cb_ + l32 * VST + koff), a0h = *(const LAS u32x2*)(cb_ + l32 * VST + koff + 16);
                const u32x2 a1l = *(const LAS u32x2*)(cb_ + (32 + l32) * VST + koff), a1h = *(const LAS u32x2*)(cb_ + (32 + l32) * VST + koff + 16);
                o0 = MFMA32(mk8(a0l, a0h), P, o0); o1 = MFMA32(mk8(a1l, a1h), P, o1);
            }
#pragma unroll
            for (int g = 0; g < 4; ++g) {
                u32x2 w0, w1;
                w0.x = cvt_pk(o0[4 * g], o0[4 * g + 1]); w0.y = cvt_pk(o0[4 * g + 2], o0[4 * g + 3]);
                w1.x = cvt_pk(o1[4 * g], o1[4 * g + 1]); w1.y = cvt_pk(o1[4 * g + 2], o1[4 * g + 3]);
                *(u32x2*)(qp + 64 * c + 8 * g + 4 * hi) = w0; *(u32x2*)(qp + 64 * c + 32 + 8 * g + 4 * hi) = w1;
            }
        }
        if (i + 1 < 12) XSTORE(i + 1, lds + ((i + 1) & 1) * BUF);
        __syncthreads();
    }
#undef XLOAD
#undef XSTORE
}

DI void memkv_tile(LAS unsigned char* lds, const bf16_t* memb, const bf16_t* Wt, const float* mrstd, bf16_t* Km, bf16_t* Vmt, int tile, int wv) {
    const int tid = otid(wv), lane = tid & 63, w = wv, l32 = lane & 31, hi = lane >> 5;
    const int r0 = (tile >> 5) * 64, c0 = (tile & 31) * 64;
    f32x16 acc[2][2];
#pragma unroll
    for (int i = 0; i < 2; ++i)
#pragma unroll
        for (int j = 0; j < 2; ++j)
#pragma unroll
            for (int r = 0; r < 16; ++r) acc[i][j][r] = 0.f;
    const bf16_t* ap = memb + (size_t)(r0 + l32) * 1024 + 128 * w + 8 * hi;
    const bf16_t* bp = Wt + (size_t)(c0 + l32) * 1024 + 128 * w + 8 * hi;
#pragma unroll
    for (int ks = 0; ks < 8; ++ks) {
        const bf16x8 a0 = *(const bf16x8*)(ap + 16 * ks), a1 = *(const bf16x8*)(ap + 32 * 1024 + 16 * ks);
        const bf16x8 b0 = *(const bf16x8*)(bp + 16 * ks), b1 = *(const bf16x8*)(bp + 32 * 1024 + 16 * ks);
        acc[0][0] = MFMA32(b0, a0, acc[0][0]); acc[0][1] = MFMA32(b1, a0, acc[0][1]);
        acc[1][0] = MFMA32(b0, a1, acc[1][0]); acc[1][1] = MFMA32(b1, a1, acc[1][1]);
    }
    LAS float* red = (LAS float*)lds;
#pragma unroll
    for (int i = 0; i < 2; ++i)
#pragma unroll
        for (int j = 0; j < 2; ++j)
#pragma unroll
            for (int r = 0; r < 16; ++r) red[((w * 4 + i * 2 + j) * 16 + r) * 64 + lane] = acc[i][j][r];
    __syncthreads();
#pragma unroll
    for (int q = 0; q < 8; ++q) {
        const int idx = tid + 512 * q, ln = idx & 63, r = (idx >> 6) & 15, blk = idx >> 10;
        float s = 0.f;
#pragma unroll
        for (int ww = 0; ww < 8; ++ww) s += red[ww * 4096 + idx];
        const int i = blk >> 1, j = blk & 1;
        const int col = c0 + 32 * j + crow(r, ln >> 5), row = r0 + 32 * i + (ln & 31);
        const float val = s * mrstd[row];
        if (col < 1024) Km[(size_t)row * 1024 + col] = f2bf(val);
        else { const int c2 = col - 1024, h = c2 >> 8, dv = c2 & 255, b = row >> 8, key = row & 255; Vmt[((size_t)(b * 4 + h) * 256 + dv) * 256 + key] = f2bf(val); }
    }
    __syncthreads();
}

DI void gmlp_unit(LAS unsigned char* lds, bf16_t* zC, const float* ln_g, const float* ln_b, const float* w_s, const float* b_s, int chunk, int g, int wv) {
    const int tid = otid(wv), lane = tid & 63, w = __builtin_amdgcn_readfirstlane(tid >> 6), l32 = lane & 31, hi = lane >> 5;
    constexpr int VST = 272;
    const size_t row0 = (size_t)chunk * 128;
    LAS bf16_t* vnT = (LAS bf16_t*)lds;
    {
        f32x4 lg0, lg1, lb0, lb1;
        lg0 = *(const f32x4*)(ln_g + 8 * lane); lg1 = *(const f32x4*)(ln_g + 8 * lane + 4);
        lb0 = *(const f32x4*)(ln_b + 8 * lane); lb1 = *(const f32x4*)(ln_b + 8 * lane + 4);
        for (int tt = 0; tt < 16; ++tt) {
            const int t = 16 * w + tt;
            const u32x4 raw = *(const u32x4*)(zC + (row0 + t) * 1024 + 512 + 8 * lane);
            float x[8];
            x[0] = gelu_erf(bflo(raw.x)); x[1] = gelu_erf(bfhi(raw.x)); x[2] = gelu_erf(bflo(raw.y)); x[3] = gelu_erf(bfhi(raw.y));
            x[4] = gelu_erf(bflo(raw.z)); x[5] = gelu_erf(bfhi(raw.z)); x[6] = gelu_erf(bflo(raw.w)); x[7] = gelu_erf(bfhi(raw.w));
            float s = 0.f;
#pragma unroll
            for (int e = 0; e < 8; ++e) s += x[e];
            const float mean = wave_sum(s) * (1.0f / 512.0f);
            float q = 0.f;
#pragma unroll
            for (int e = 0; e < 8; ++e) { x[e] -= mean; q += x[e] * x[e]; }
            const float rstd = rsqrtf(wave_sum(q) * (1.0f / 512.0f) + EPS);
            if ((lane >> 4) == g) {
                const int cl = 8 * (lane & 15);
                vnT[(cl + 0) * (VST / 2) + t] = f2bf(x[0] * rstd * lg0[0] + lb0[0]); vnT[(cl + 1) * (VST / 2) + t] = f2bf(x[1] * rstd * lg0[1] + lb0[1]);
                vnT[(cl + 2) * (VST / 2) + t] = f2bf(x[2] * rstd * lg0[2] + lb0[2]); vnT[(cl + 3) * (VST / 2) + t] = f2bf(x[3] * rstd * lg0[3] + lb0[3]);
                vnT[(cl + 4) * (VST / 2) + t] = f2bf(x[4] * rstd * lg1[0] + lb1[0]); vnT[(cl + 5) * (VST / 2) + t] = f2bf(x[5] * rstd * lg1[1] + lb1[1]);
                vnT[(cl + 6) * (VST / 2) + t] = f2bf(x[6] * rstd * lg1[2] + lb1[2]); vnT[(cl + 7) * (VST / 2) + t] = f2bf(x[7] * rstd * lg1[3] + lb1[3]);
            }
        }
    }
    __syncthreads();
    {
        const int tb = w >> 1, cb0 = 2 * (w & 1);
        f32x16 a0, a1;
#pragma unroll
        for (int r = 0; r < 16; ++r) { a0[r] = 0.f; a1[r] = 0.f; }
        const int trow = 32 * tb + l32;
        const float* wrow = w_s + ((size_t)(g * 128 + trow)) * 128;
        for (int ks = 0; ks <= 2 * tb + 1; ++ks) {
            const int s0 = 16 * ks + 8 * hi;
            f32x4 w0 = *(const f32x4*)(wrow + s0), w1 = *(const f32x4*)(wrow + s0 + 4);
#pragma unroll
            for (int e = 0; e < 4; ++e) { if (s0 + e > trow) w0[e] = 0.f; if (s0 + 4 + e > trow) w1[e] = 0.f; }
            const bf16x8 A = pack8(w0[0], w0[1], w0[2], w0[3], w1[0], w1[1], w1[2], w1[3]);
            const bf16x8 B0 = *(const LAS bf16x8*)(lds + (32 * cb0 + l32) * VST + s0 * 2);
            const bf16x8 B1 = *(const LAS bf16x8*)(lds + (32 * (cb0 + 1) + l32) * VST + s0 * 2);
            a0 = MFMA32(A, B0, a0); a1 = MFMA32(A, B1, a1);
        }
#pragma unroll
        for (int r = 0; r < 16; ++r) {
            const int t = 32 * tb + crow(r, hi);
            const float bs = b_s[g * 128 + t];
            bf16_t* up0 = zC + (row0 + t) * 1024 + g * 128 + 32 * cb0 + l32;
            const float u0 = gelu_erf(bf2f(up0[0])), u1 = gelu_erf(bf2f(up0[32]));
            up0[0] = f2bf((a0[r] + bs) * u0); up0[32] = f2bf((a1[r] + bs) * u1);
        }
    }
    __syncthreads();
}

#define HG_PREP() \
    const int k = tid & 127, seg = tid >> 7; \
    const size_t row0 = (size_t)b * SEQ + (size_t)c * 64 + 16 * seg; \
    float cum[16], kv[16]; float bref, blast; \
    { const float lb = lbv[h * 128 + k]; float run = 0.f; \
      _Pragma("unroll") for (int i = 0; i < 16; ++i) { const float fr_ = bf2f(zB[(row0 + i) * 2048 + 512 + h * 128 + k]); \
          const float e_ = __expf(-fr_), sg_ = __builtin_amdgcn_rcpf(1.f + e_); const float f_ = lb + (1.f - lb) * sg_; \
          run += __logf(f_); cum[i] = run; kv[i] = (1.f - lb) * e_ * sg_; } \
      segs[seg * 128 + k] = run; __syncthreads(); \
      const float s0_ = segs[k], s1_ = segs[128 + k], s2_ = segs[256 + k], s3_ = segs[384 + k]; \
      const float off_ = (seg > 0 ? s0_ : 0.f) + (seg > 1 ? s1_ : 0.f) + (seg > 2 ? s2_ : 0.f); \
      bref = s0_ + s1_; blast = (s0_ + s1_) + (s2_ + s3_); \
      _Pragma("unroll") for (int i = 0; i < 16; ++i) cum[i] += off_; }

constexpr int HG_QR = 0, HG_KR = 17408, HG_QD = 34816, HG_VT = 52224, HG_KDT = 70656, HG_SEG = 89088, HG_SSL = 91136;

DI void hg_u_unit(LAS unsigned char* lds, const bf16_t* zB, const float* lbv, bf16_t* ST, float* dC, int b, int h, int c, int wv) {
    const int tid = otid(wv), lane = tid & 63, w = __builtin_amdgcn_readfirstlane(tid >> 6), l32 = lane & 31, hi = lane >> 5;
    LAS float* segs = (LAS float*)(lds + HG_SEG);
    HG_PREP();
    const int unit = (b * 4 + h) * 128 + c;
    {
        float kd[16]; unsigned vr[8];
#pragma unroll
        for (int i = 0; i < 16; ++i) kd[i] = kv[i] * __expf(blast - cum[i]);
#pragma unroll
        for (int i = 0; i < 8; ++i) { const unsigned lo = zB[(row0 + 2 * i) * 2048 + 1024 + h * 128 + k], hi2 = zB[(row0 + 2 * i + 1) * 2048 + 1024 + h * 128 + k]; vr[i] = lo | (hi2 << 16); }
        LAS unsigned char* kp = lds + HG_KDT + k * 144 + seg * 32;
        *(LAS u32x4*)kp = (u32x4){cvt_pk(kd[0], kd[1]), cvt_pk(kd[2], kd[3]), cvt_pk(kd[4], kd[5]), cvt_pk(kd[6], kd[7])};
        *(LAS u32x4*)(kp + 16) = (u32x4){cvt_pk(kd[8], kd[9]), cvt_pk(kd[10], kd[11]), cvt_pk(kd[12], kd[13]), cvt_pk(kd[14], kd[15])};
        LAS unsigned char* vp = lds + HG_VT + k * 144 + seg * 32;
        *(LAS u32x4*)vp = (u32x4){vr[0], vr[1], vr[2], vr[3]};
        *(LAS u32x4*)(vp + 16) = (u32x4){vr[4], vr[5], vr[6], vr[7]};
        if (seg == 0) dC[(size_t)unit * 128 + k] = __expf(blast);
    }
    __syncthreads();
    {
        const int vb = w & 3;
#pragma unroll
        for (int kbi = 0; kbi < 2; ++kbi) {
            const int kb = 2 * (w >> 2) + kbi;
            f32x16 acc;
#pragma unroll
            for (int r = 0; r < 16; ++r) acc[r] = 0.f;
#pragma unroll
            for (int ks = 0; ks < 4; ++ks) {
                const bf16x8 A = *(const LAS bf16x8*)(lds + HG_VT + (32 * vb + l32) * 144 + (16 * ks + 8 * hi) * 2);
                const bf16x8 B = *(const LAS bf16x8*)(lds + HG_KDT + (32 * kb + l32) * 144 + (16 * ks + 8 * hi) * 2);
                acc = MFMA32(A, B, acc);
            }
            bf16_t* sp = ST + (size_t)unit * 16384 + 32 * kb + l32;
#pragma unroll
            for (int r = 0; r < 16; ++r) sp[(32 * vb + crow(r, hi)) * 128] = f2bf(acc[r]);
        }
    }
    __syncthreads();
}

DI void hg_out_unit(LAS unsigned char* lds, const bf16_t* zB, const float* lbv, const bf16_t* ST, const float* hnorm, bf16_t* Ob, int b, int h, int c, int wv) {
    const int tid = otid(wv), lane = tid & 63, w = __builtin_amdgcn_readfirstlane(tid >> 6), l32 = lane & 31, hi = lane >> 5;
    LAS float* segs = (LAS float*)(lds + HG_SEG);
    LAS float* ssl = (LAS float*)(lds + HG_SSL);
    HG_PREP();
    const int unit = (b * 4 + h) * 128 + c;
    {
        LAS bf16_t* Qr = (LAS bf16_t*)(lds + HG_QR); LAS bf16_t* Kr = (LAS bf16_t*)(lds + HG_KR); LAS bf16_t* Qd = (LAS bf16_t*)(lds + HG_QD);
        unsigned vr[8];
#pragma unroll
        for (int i = 0; i < 16; ++i) { const int t = 16 * seg + i;
            const float qraw = bf2f(zB[(row0 + i) * 2048 + h * 128 + k]); const float q = qraw * sigm(qraw);
            Qr[t * 136 + k] = f2bf(q * __expf(cum[i] - bref)); Kr[t * 136 + k] = f2bf(kv[i] * __expf(bref - cum[i])); Qd[t * 136 + k] = f2bf(q * __expf(cum[i])); }
#pragma unroll
        for (int i = 0; i < 8; ++i) { const unsigned lo = zB[(row0 + 2 * i) * 2048 + 1024 + h * 128 + k], hi2 = zB[(row0 + 2 * i + 1) * 2048 + 1024 + h * 128 + k]; vr[i] = lo | (hi2 << 16); }
        LAS unsigned char* vp = lds + HG_VT + k * 144 + seg * 32;
        *(LAS u32x4*)vp = (u32x4){vr[0], vr[1], vr[2], vr[3]};
        *(LAS u32x4*)(vp + 16) = (u32x4){vr[4], vr[5], vr[6], vr[7]};
    }
    __syncthreads();
    const int vb = w & 3, tb = w >> 2;
    f32x16 o;
#pragma unroll
    for (int r = 0; r < 16; ++r) o[r] = 0.f;
    {
        const bf16_t* sp = ST + (size_t)unit * 16384 + (size_t)(32 * vb + l32) * 128 + 8 * hi;
#pragma unroll
        for (int ks = 0; ks < 8; ++ks) {
            const bf16x8 A = *(const bf16x8*)(sp + 16 * ks);
            const bf16x8 B = *(const LAS bf16x8*)(lds + HG_QD + (32 * tb + l32) * 272 + (16 * ks + 8 * hi) * 2);
            o = MFMA32(A, B, o);
        }
    }
#pragma unroll
    for (int sb = 0; sb < 2; ++sb) {
        if (sb <= tb) {
            f32x16 at;
#pragma unroll
            for (int r = 0; r < 16; ++r) at[r] = 0.f;
#pragma unroll
            for (int ks = 0; ks < 8; ++ks) {
                const bf16x8 A = *(const LAS bf16x8*)(lds + HG_KR + (32 * sb + l32) * 272 + (16 * ks + 8 * hi) * 2);
                const bf16x8 B = *(const LAS bf16x8*)(lds + HG_QR + (32 * tb + l32) * 272 + (16 * ks + 8 * hi) * 2);
                at = MFMA32(A, B, at);
            }
            if (sb == tb) {
#pragma unroll
                for (int r = 0; r < 16; ++r) if (crow(r, hi) > l32) at[r] = 0.f;
            }
#pragma unroll
            for (int sub = 0; sub < 2; ++sub) {
                const bf16x8 P = pack8(at[8 * sub + 0], at[8 * sub + 1], at[8 * sub + 2], at[8 * sub + 3], at[8 * sub + 4], at[8 * sub + 5], at[8 * sub + 6], at[8 * sub + 7]);
                const int koff = (32 * sb + 16 * sub + 4 * hi) * 2;
                const u32x2 al = *(const LAS u32x2*)(lds + HG_VT + (32 * vb + l32) * 144 + koff), ah = *(const LAS u32x2*)(lds + HG_VT + (32 * vb + l32) * 144 + koff + 16);
                o = MFMA32(mk8(al, ah), P, o);
            }
        }
    }
    float ss = 0.f;
#pragma unroll
    for (int r = 0; r < 16; ++r) ss += o[r] * o[r];
    ss += __shfl_xor(ss, 32);
    if (hi == 0) ssl[vb * 64 + 32 * tb + l32] = ss;
    __syncthreads();
    {
        const int t = 32 * tb + l32;
        const float tot = (ssl[t] + ssl[64 + t]) + (ssl[128 + t] + ssl[192 + t]);
        const float rstd = rsqrtf(tot * (1.0f / 128.0f) + EPS);
        const size_t row = (size_t)b * SEQ + (size_t)c * 64 + t;
#pragma unroll
        for (int g = 0; g < 4; ++g) {
            const int v0 = 32 * vb + 8 * g + 4 * hi;
            const u32x2 gr = *(const u32x2*)(zB + row * 2048 + 1536 + h * 128 + v0);
            const f32x4 hn = *(const f32x4*)(hnorm + v0);
            const float g0 = bflo(gr.x), g1 = bfhi(gr.x), g2 = bflo(gr.y), g3 = bfhi(gr.y);
            u32x2 ow;
            ow.x = cvt_pk(o[4 * g] * rstd * hn[0] * (g0 * sigm(g0)), o[4 * g + 1] * rstd * hn[1] * (g1 * sigm(g1)));
            ow.y = cvt_pk(o[4 * g + 2] * rstd * hn[2] * (g2 * sigm(g2)), o[4 * g + 3] * rstd * hn[3] * (g3 * sigm(g3)));
            *(u32x2*)(Ob + row * 512 + h * 128 + v0) = ow;
        }
    }
    __syncthreads();
}


#define XB_TMO      128
#define XB_XCNT(j)  (256  + 64 * (j))
#define XB_XSUB(j)  (1280 + 64 * (j))
#define XB_XGEN(j)  (2304 + 64 * (j))
#define XB_TOP      3328
#define XB_TOPGEN   3392
#define XCD_BAR_WORDS 3456
#define XB_SPIN_CAP (1u << 18)
DI unsigned xb_ld(unsigned* p)              { return __hip_atomic_load(p, __ATOMIC_RELAXED, __HIP_MEMORY_SCOPE_AGENT); }
DI unsigned xb_add(unsigned* p, unsigned v) { return __hip_atomic_fetch_add(p, v, __ATOMIC_RELAXED, __HIP_MEMORY_SCOPE_AGENT); }
DI unsigned xb_xcc_id() { return (unsigned)__builtin_amdgcn_s_getreg((3 << 11) | 20) & 0xFu; }
#define XB_SPIN(cond, bar) do { unsigned _sp = 0; while (cond) { __builtin_amdgcn_s_sleep(1); \
    if ((++_sp & 255u) == 0u) { if (xb_ld(&(bar)[XB_TMO])) break; if (_sp > XB_SPIN_CAP) { atomicAdd(&(bar)[XB_TMO], 1u); break; } } } } while (0)
DI void xcd_barrier_complete(unsigned* bar, unsigned x, unsigned& nloc, unsigned& nx) {
    const unsigned G = gridDim.x * gridDim.y * gridDim.z;
    unsigned sum, cnt, mine, sp = 0u;
    for (;;) {
        sum = 0u; cnt = 0u; mine = 0u;
#pragma unroll
        for (unsigned j = 0; j < 16; ++j) { const unsigned c = xb_ld(&bar[XB_XCNT(j)]); sum += c; cnt += (c > 0u) ? 1u : 0u; mine = (j == x) ? c : mine; }
        if (sum == G) break;
        __builtin_amdgcn_s_sleep(1);
        if ((++sp & 255u) == 0u) { if (xb_ld(&bar[XB_TMO])) break; if (sp > XB_SPIN_CAP) { atomicAdd(&bar[XB_TMO], 1u); break; } }
    }
    nloc = mine > 0u ? mine : 1u; nx = cnt > 0u ? cnt : 1u;
}
DI void xcd_barrier(unsigned* bar, volatile LAS unsigned* st) {
    asm volatile("s_waitcnt vmcnt(0)" ::: "memory");
    __syncthreads();
    if (threadIdx.x == 0) {
        const unsigned x = xb_xcc_id();
        __builtin_amdgcn_s_waitcnt(0);
        unsigned nloc = st[0], nx = st[1];
        if (nloc == 0u) { xcd_barrier_complete(bar, x, nloc, nx); st[0] = nloc; st[1] = nx; }
        const unsigned old = xb_add(&bar[XB_XSUB(x)], 1u);
        const unsigned gen = old / nloc;
        if (old + 1u == (gen + 1u) * nloc) {
            __builtin_amdgcn_fence(__ATOMIC_RELEASE, "agent");
            asm volatile("s_waitcnt vmcnt(0)" ::: "memory");
            const unsigned og = xb_add(&bar[XB_TOP], 1u);
            const unsigned tg = og / nx;
            if (og + 1u == (tg + 1u) * nx) xb_add(&bar[XB_TOPGEN], 1u);
            else XB_SPIN(xb_ld(&bar[XB_TOPGEN]) == tg, bar);
            __builtin_amdgcn_fence(__ATOMIC_ACQUIRE, "agent");
            xb_add(&bar[XB_XGEN(x)], 1u);
            asm volatile("s_waitcnt vmcnt(0)" ::: "memory");
        } else {
            XB_SPIN(xb_ld(&bar[XB_XGEN(x)]) == gen, bar);
            __builtin_amdgcn_fence(__ATOMIC_ACQUIRE, "agent");
            asm volatile("s_waitcnt vmcnt(0)" ::: "memory");
        }
    }
    __syncthreads();
}

constexpr size_t MiB = 1u << 20;
constexpr size_t WS_X0 = 0, WS_R2 = 32 * MiB, WS_R3 = 96 * MiB, WS_X1 = 128 * MiB, WS_R1 = 160 * MiB, WS_R4 = 184 * MiB, WS_RW = 216 * MiB;
constexpr size_t WS_CTL = 250 * MiB + 512 * 1024, CTL_BYTES = 16384;
constexpr size_t WS_P = 241 * MiB, WS_PA = 242 * MiB, WS_CS = 244 * MiB, WS_DC = 246 * MiB, WS_MEMB = 247 * MiB, WS_KM = 248 * MiB, WS_VMT = 249 * MiB, WS_MISC = 250 * MiB, WS_END = 251 * MiB;
constexpr size_t W1_IN = 0, W1_UQ = W1_IN + (size_t)6912 * 1024, W1_UKV = W1_UQ + (size_t)768 * 384, W1_BA = W1_UKV + (size_t)1024 * 256, W1_BB = W1_BA + (size_t)1024 * 512,
                 W1_BC = W1_BB + (size_t)1024 * 512, W1_MIX = W1_BC + (size_t)1024 * 512, W1_END = W1_MIX + (size_t)1024 * 1024;
constexpr size_t W2_XQ = 0, W2_XKV = W2_XQ + (size_t)1024 * 1024, W2_XO = W2_XKV + (size_t)2048 * 1024, W2_FI = W2_XO + (size_t)1024 * 1024, W2_FO = W2_FI + (size_t)5632 * 1024, W2_END = W2_FO + (size_t)1024 * 2816;
static_assert(W1_END * 2 <= 25 * MiB && W2_END * 2 <= 25 * MiB, "weight region");

constexpr int LDS_BYTES = 147456;

struct Args { const float* in[28]; float* out; unsigned char* ws; };

constexpr int PTAB_OFF = 135168;
DI void* ldptr(LAS unsigned char* lds, int i) {
    unsigned off_ = PTAB_OFF + 8 * i; asm volatile("" : "+v"(off_));
    const LAS unsigned* t = (const LAS unsigned*)(lds + off_);
    const unsigned lo = __builtin_amdgcn_readfirstlane(t[0]), hi = __builtin_amdgcn_readfirstlane(t[1]);
    return (void*)(((unsigned long long)hi << 32) | (unsigned long long)lo);
}
#define INP(i) ((const float*)ldptr(lds, (i)))
#define PH_HEAD() \
    int G = G0_, bid = bid0_; asm volatile("" : "+s"(G), "+s"(bid)); \
    int wv = wv0_; asm volatile("" : "+s"(wv)); const int tid = otid(wv), lane = tid & 63, wave = wv; \
    const int gw = bid * 8 + wave, NGW = G * 8; (void)lane; (void)gw; (void)NGW; \
    unsigned char* ws = (unsigned char*)ldptr(lds, 29); \
    bf16_t* const X0 = (bf16_t*)(ws + WS_X0); bf16_t* const X1 = (bf16_t*)(ws + WS_X1); \
    bf16_t* const R1 = (bf16_t*)(ws + WS_R1); bf16_t* const R2 = (bf16_t*)(ws + WS_R2); bf16_t* const R3 = (bf16_t*)(ws + WS_R3); bf16_t* const R4 = (bf16_t*)(ws + WS_R4); \
    bf16_t* const RW = (bf16_t*)(ws + WS_RW); \
    float* const P = (float*)(ws + WS_P); float* const PA = (float*)(ws + WS_PA); float* const CS = (float*)(ws + WS_CS); float* const dC = (float*)(ws + WS_DC); \
    bf16_t* const memb = (bf16_t*)(ws + WS_MEMB); bf16_t* const Km = (bf16_t*)(ws + WS_KM); bf16_t* const Vmt = (bf16_t*)(ws + WS_VMT); \
    float* const mrstd = (float*)(ws + WS_MISC); float* const lbv = mrstd + 512; \
    bf16_t* const xcur = par ? X1 : X0; bf16_t* const xfree = par ? X0 : X1; \
    bf16_t* const zA = R1; bf16_t* const zB = R2; bf16_t* const zC = R4; \
    bf16_t* const Qb = R3; bf16_t* const Krb = R3 + (size_t)MTOK * 768; \
    bf16_t* const Knb = xfree; bf16_t* const Vtb = xfree + (size_t)MTOK * 512; \
    bf16_t* const Oa = R1; bf16_t* const Ob = xfree; bf16_t* const STb = R3; bf16_t* const Gt = R2; bf16_t* const MX = xcur; \
    bf16_t* const QX = R2; bf16_t* const ACT = R2; float* const xres = (float*)ldptr(lds, 28); \
    (void)X0; (void)X1; (void)R1; (void)R2; (void)R3; (void)R4; (void)RW; (void)P; (void)PA; (void)CS; (void)dC; (void)memb; (void)Km; (void)Vmt; (void)mrstd; (void)lbv; \
    (void)xcur; (void)xfree; (void)zA; (void)zB; (void)zC; (void)Qb; (void)Krb; (void)Knb; (void)Vtb; (void)Oa; (void)Ob; (void)STb; (void)Gt; (void)MX; (void)QX; (void)ACT; (void)xres;

#ifdef TPROBE
#define TSTAMP(cls) do { if (blockIdx.x == 0 && threadIdx.x == 0) { LAS unsigned long long* tp_ = (LAS unsigned long long*)(lds + PTAB_OFF + 512); \
    const unsigned long long now_ = __builtin_amdgcn_s_memrealtime(); tp_[1 + (cls)] += now_ - tp_[0]; tp_[0] = now_; } } while (0)
#else
#define TSTAMP(cls) do { } while (0)
#endif
#define GSYNC() xcd_barrier((unsigned*)((unsigned char*)ldptr(lds, 29) + WS_CTL), (volatile LAS unsigned*)(lds + PTAB_OFF + 256))
__global__ void __launch_bounds__(512, 2) mega_fwd(Args args) {
    extern __shared__ __attribute__((aligned(16))) unsigned char lds_raw[];
    LAS unsigned char* lds = (LAS unsigned char*)lds_raw;
    cg::grid_group grid = cg::this_grid();
    const int G0_ = gridDim.x, bid0_ = blockIdx.x, wv0_ = __builtin_amdgcn_readfirstlane(threadIdx.x >> 6);
    int par = 0;
    if (threadIdx.x == 0) {
        LAS unsigned long long* pt = (LAS unsigned long long*)(lds + PTAB_OFF);
#pragma unroll
        for (int i = 0; i < 28; ++i) pt[i] = (unsigned long long)args.in[i];
        pt[28] = (unsigned long long)args.out; pt[29] = (unsigned long long)args.ws;
        pt[32] = 0ull;
#ifdef TPROBE
        for (int i = 0; i < 8; ++i) pt[64 + i] = 0ull; pt[64] = __builtin_amdgcn_s_memrealtime();
#endif
        (void)xb_add((unsigned*)(args.ws + WS_CTL) + XB_XCNT(xb_xcc_id()), 1u);
    }
    __syncthreads();

    for (int l = 0; l < 2; ++l) {
        {
            PH_HEAD();
            LAS float* scr = (LAS float*)(lds + wave * 16640);
            const float* w_in = INP(4) + (size_t)l * 1024 * INW; const float* mixn = INP(3) + l * 1024;
            const float* wuq = INP(6) + (size_t)l * 384 * 768; const float* qn = INP(5) + l * 384;
            const float* wukv = INP(8) + (size_t)l * 256 * 1024; const float* kvn = INP(7) + l * 256;
            const float* wba = INP(15) + (size_t)l * 512 * 1024; const float* wbb = INP(16) + (size_t)l * 512 * 1024; const float* wbc = INP(17) + (size_t)l * 512 * 1024;
            const float* wmx = INP(18) + (size_t)l * 1024 * 1024;
            constexpr int I_IN = 16 * 108, I_UQ = 6 * 12, I_UKV = 4 * 16, I_B = 8 * 16, I_MX = 16 * 16;
            constexpr int NIT = I_IN + I_UQ + I_UKV + 3 * I_B + I_MX;
            for (int it = gw; it < NIT; it += NGW) {
                int r = it;
                if (r < I_IN) { conv_item(w_in, 1024, INW, 6912, 1, mixn, RW + W1_IN, scr, r, lane); continue; } r -= I_IN;
                if (r < I_UQ) { conv_item(wuq, 384, 768, 768, 0, qn, RW + W1_UQ, scr, r, lane); continue; } r -= I_UQ;
                if (r < I_UKV) { conv_item(wukv, 256, 1024, 1024, 0, kvn, RW + W1_UKV, scr, r, lane); continue; } r -= I_UKV;
                if (r < I_B) { conv_item(wba, 512, 1024, 1024, 0, nullptr, RW + W1_BA, scr, r, lane); continue; } r -= I_B;
                if (r < I_B) { conv_item(wbb, 512, 1024, 1024, 0, nullptr, RW + W1_BB, scr, r, lane); continue; } r -= I_B;
                if (r < I_B) { conv_item(wbc, 512, 1024, 1024, 0, nullptr, RW + W1_BC, scr, r, lane); continue; } r -= I_B;
                conv_item(wmx, 1024, 1024, 1024, 0, nullptr, RW + W1_MIX, scr, r, lane);
            }
            if (l == 0) {
                const float* xin0 = INP(0);
                for (int m = gw; m < MTOK; m += NGW) {
                    const f32x4* xr = (const f32x4*)(xin0 + (size_t)m * 1024) + lane; float s = 0.f;
                    unsigned long long* o8 = (unsigned long long*)(xcur + (size_t)m * 1024) + lane;
#pragma unroll
                    for (int j = 0; j < 4; ++j) { const f32x4 v = xr[64 * j]; s += dot4(v); o8[64 * j] = (unsigned long long)cvt_pk(v.x, v.y) | ((unsigned long long)cvt_pk(v.z, v.w) << 32); }
                    s = wave_sum(s);
                    if (lane < 16) P[(size_t)m * 16 + lane] = (lane == 0) ? s : 0.f;
                }
                for (int m = gw; m < NB * NMEM; m += NGW) {
                    const f32x4* xr = (const f32x4*)(INP(1) + (size_t)m * 1024) + lane; float s = 0.f;
                    unsigned long long* o8 = (unsigned long long*)(memb + (size_t)m * 1024) + lane;
#pragma unroll
                    for (int j = 0; j < 4; ++j) { const f32x4 v = xr[64 * j]; s += dot4(v); o8[64 * j] = (unsigned long long)cvt_pk(v.x, v.y) | ((unsigned long long)cvt_pk(v.z, v.w) << 32); }
                    s = wave_sum(s);
                    if (lane == 0) mrstd[m] = rsqrtf(s * (1.0f / 1024.0f) + EPS);
                }
                const int* pos = (const int*)INP(2);
                for (int idx = bid * 512 + tid; idx < MTOK * 16; idx += G * 512) {
                    const int row = idx >> 4, j = idx & 15;
                    const float invf = powf(10000.0f, -(float)(2 * j) / 32.0f);
                    const float ang = (float)pos[row] * invf;
                    double tt = (double)ang * 0.15915494309189535; tt -= rint(tt);
                    const float rv = (float)tt;
                    CS[(size_t)row * 32 + j] = __builtin_amdgcn_cosf(rv); CS[(size_t)row * 32 + 16 + j] = __builtin_amdgcn_sinf(rv);
                }
                for (int idx = bid * 512 + tid; idx < 512; idx += G * 512) {
                    const float p0 = INP(9)[idx], p1 = INP(9)[512 + idx];
                    lbv[idx] = 0.f; lbv[512 + idx] = 1.0f / (1.0f + expf(p0 - p1));
                }
            }
        }
        __syncthreads();
        if (l == 0) grid.sync(); else GSYNC();
        TSTAMP(0);
        {
            PH_HEAD();
            pg8::Gemm g{xcur, RW + W1_IN, MTOK, 3840, 1024, 1024, 1024}; pg8::StaticOrder S; S.init(MTOK, 3840, G, bid);
            EpiA E{P, zA, zB, zC, PA};
            pg8::gemm_phase<EpiA>(lds, g, S, E, wv);
        }
        GSYNC();
        TSTAMP(1);
        {
            PH_HEAD();
            for (int idx = bid * 512 + tid; idx < MTOK * 16; idx += G * 512) {
                const int row = idx >> 4, j = idx & 15;
                const float x1 = bf2f(zA[(size_t)row * 768 + 640 + j]), x2 = bf2f(zA[(size_t)row * 768 + 656 + j]);
                const float cs = CS[(size_t)row * 32 + j], sn = CS[(size_t)row * 32 + 16 + j];
                Krb[(size_t)row * 32 + j] = f2bf(x1 * cs - x2 * sn); Krb[(size_t)row * 32 + 16 + j] = f2bf(x1 * sn + x2 * cs);
            }
            { pg8::Gemm g{zA, RW + W1_UQ, MTOK, 768, 384, 768, 384}; pg8::StaticOrder S; S.init(MTOK, 768, G, bid);
              EpiQ E{PA, CS, Qb}; pg8::gemm_phase<EpiQ>(lds, g, S, E, wv); }
            { pg8::Gemm g{zA + 384, RW + W1_UKV, MTOK, 1024, 256, 768, 256}; pg8::StaticOrder S; S.init(MTOK, 1024, G, bid);
              EpiKV E{PA, Knb, Vtb}; pg8::gemm_phase<EpiKV>(lds, g, S, E, wv); }
        }
        __syncthreads();
        GSYNC();
        TSTAMP(1);
        {
            PH_HEAD();
            for (int item = bid; item < 256; item += G) {
                const int b = item >> 7, h = (item >> 4) & 7, s = item & 15;
                attn_unit(lds, Qb, Knb, Krb, Vtb, Oa, b, h, 31 - s, wv);
                attn_unit(lds, Qb, Knb, Krb, Vtb, Oa, b, h, s, wv);
            }
#ifdef TPROBE
            GSYNC(); TSTAMP(2);
#endif
            const float* lng = INP(11) + l * 512; const float* lnb = INP(12) + l * 512;
            const float* wsp = INP(13) + (size_t)l * 4 * 128 * 128; const float* bsp = INP(14) + l * 512;
            for (int u = bid; u < 512; u += G) gmlp_unit(lds, zC, lng, lnb, wsp, bsp, u >> 2, u & 3, wv);
        }
        GSYNC();
#ifdef TPROBE
        TSTAMP(5);
#else
        TSTAMP(2);
#endif
        {
            PH_HEAD();
            for (int u = bid; u < 1024; u += G) hg_u_unit(lds, zB, lbv + l * 512, STb, dC, u >> 9, (u >> 7) & 3, u & 127, wv);
        }
        GSYNC();
        TSTAMP(3);
        {
            PH_HEAD();
            if (tid < 256) {
                for (int p = bid * 256 + tid; p < 65536; p += G * 256) {
                    const int bh = p >> 13, e2 = p & 8191;
                    unsigned* sp = (unsigned*)STb + (size_t)bh * 128 * 8192 + e2;
                    const float* dp = dC + (size_t)bh * 128 * 128 + ((2 * e2) & 127);
                    float S0 = 0.f, S1 = 0.f;
                    for (int c0 = 0; c0 < 128; c0 += 16) {
                        unsigned uu[16]; f32x2 dd[16];
#pragma unroll
                        for (int i = 0; i < 16; ++i) { uu[i] = sp[(size_t)(c0 + i) * 8192]; dd[i] = *(const f32x2*)(dp + (size_t)(c0 + i) * 128); }
#pragma unroll
                        for (int i = 0; i < 16; ++i) { sp[(size_t)(c0 + i) * 8192] = cvt_pk(S0, S1); S0 = dd[i].x * S0 + bflo(uu[i]); S1 = dd[i].y * S1 + bfhi(uu[i]); }
                    }
                }
            }
        }
        GSYNC();
        TSTAMP(3);
        {
            PH_HEAD();
            for (int u = bid; u < 1024; u += G) hg_out_unit(lds, zB, lbv + l * 512, STb, INP(10) + l * 128, Ob, u >> 9, (u >> 7) & 3, u & 127, wv);
        }
        GSYNC();
        TSTAMP(3);
        {
            PH_HEAD();
            pg8::Gemm g{xcur, RW + W1_IN + (size_t)3840 * 1024, MTOK, 3072, 1024, 1024, 1024}; pg8::StaticOrder S; S.init(MTOK, 3072, G, bid);
            EpiPlain<true> E{P, Gt, 3072, 1.0f};
            pg8::gemm_phase<EpiPlain<true>>(lds, g, S, E, wv);
        }
        GSYNC();
        TSTAMP(1);
        {
            PH_HEAD();
            pg8::StaticOrder S; S.init(MTOK, 1024, G, bid);
            { pg8::Gemm g{Oa, RW + W1_BA, MTOK, 1024, 512, 512, 512}; EpiBr E{Gt, MX, 0}; pg8::gemm_phase<EpiBr>(lds, g, S, E, wv); }
            { pg8::Gemm g{Ob, RW + W1_BB, MTOK, 1024, 512, 512, 512}; EpiBr E{Gt, MX, 1}; pg8::gemm_phase<EpiBr>(lds, g, S, E, wv); }
            { pg8::Gemm g{zC, RW + W1_BC, MTOK, 1024, 512, 1024, 512}; EpiBr E{Gt, MX, 2}; pg8::gemm_phase<EpiBr>(lds, g, S, E, wv); }
        }
        GSYNC();
        TSTAMP(1);
        {
            PH_HEAD();
            pg8::Gemm g{MX, RW + W1_MIX, MTOK, 1024, 1024, 1024, 1024}; pg8::StaticOrder S; S.init(MTOK, 1024, G, bid);
            EpiRes E{l == 0 ? INP(0) : (const float*)xres, xres, xfree, P};
            pg8::gemm_phase<EpiRes>(lds, g, S, E, wv);
        }
        par ^= 1;
        GSYNC();
        TSTAMP(1);
        {
            PH_HEAD();
            LAS float* scr = (LAS float*)(lds + wave * 16640);
            const float* wxq = INP(21) + (size_t)l * 1024 * 1024; const float* xan = INP(19) + l * 1024;
            const float* wxkv = INP(22) + (size_t)l * 1024 * 2048; const float* memn = INP(20) + l * 1024;
            const float* wxo = INP(23) + (size_t)l * 1024 * 1024;
            const float* wfi = INP(25) + (size_t)l * 1024 * 2 * DFF; const float* ffn = INP(24) + l * 1024;
            const float* wfo = INP(26) + (size_t)l * DFF * 1024;
            constexpr int I_XQ = 16 * 16, I_XKV = 16 * 32, I_FI = 16 * 88, I_FO = 44 * 16;
            constexpr int NIT = 2 * I_XQ + I_XKV + I_FI + I_FO;
            for (int it = gw; it < NIT; it += NGW) {
                int r = it;
                if (r < I_XQ) { conv_item(wxq, 1024, 1024, 1024, 0, xan, RW + W2_XQ, scr, r, lane); continue; } r -= I_XQ;
                if (r < I_XKV) { conv_item(wxkv, 1024, 2048, 2048, 0, memn, RW + W2_XKV, scr, r, lane); continue; } r -= I_XKV;
                if (r < I_XQ) { conv_item(wxo, 1024, 1024, 1024, 0, nullptr, RW + W2_XO, scr, r, lane); continue; } r -= I_XQ;
                if (r < I_FI) { conv_item(wfi, 1024, 2 * DFF, 2 * DFF, 2, ffn, RW + W2_FI, scr, r, lane); continue; } r -= I_FI;
                conv_item(wfo, DFF, 1024, 1024, 0, nullptr, RW + W2_FO, scr, r, lane);
            }
        }
        __syncthreads();
        GSYNC();
        TSTAMP(0);
        {
            PH_HEAD();
            { pg8::Gemm g{xcur, RW + W2_XQ, MTOK, 1024, 1024, 1024, 1024}; pg8::StaticOrder S; S.init(MTOK, 1024, G, bid);
              EpiPlain<false> E{P, QX, 1024, XSC}; pg8::gemm_phase<EpiPlain<false>>(lds, g, S, E, wv); }
            for (int t = bid; t < 256; t += G) memkv_tile(lds, memb, RW + W2_XKV, mrstd, Km, Vmt, t, wv);
        }
        GSYNC();
        TSTAMP(1);
        {
            PH_HEAD();
            for (int u = bid; u < 256; u += G) xattn_unit(lds, QX, Km, Vmt, u >> 7, (u >> 5) & 3, u & 31, wv);
        }
        GSYNC();
        TSTAMP(4);
        {
            PH_HEAD();
            pg8::Gemm g{QX, RW + W2_XO, MTOK, 1024, 1024, 1024, 1024}; pg8::StaticOrder S; S.init(MTOK, 1024, G, bid);
            EpiRes E{xres, xres, xcur, P};
            pg8::gemm_phase<EpiRes>(lds, g, S, E, wv);
        }
        GSYNC();
        TSTAMP(1);
        {
            PH_HEAD();
            pg8::Gemm g{xcur, RW + W2_FI, MTOK, 2 * DFF, 1024, 1024, 1024}; pg8::StaticOrder S; S.init(MTOK, 2 * DFF, G, bid);
            EpiFF E{P, ACT};
            pg8::gemm_phase<EpiFF>(lds, g, S, E, wv);
        }
        GSYNC();
        TSTAMP(1);
        {
            PH_HEAD();
            pg8::Gemm g{ACT, RW + W2_FO, MTOK, 1024, DFF, DFF, DFF}; pg8::StaticOrder S; S.init(MTOK, 1024, G, bid);
            EpiRes E{xres, xres, xcur, P};
            pg8::gemm_phase<EpiRes>(lds, g, S, E, wv);
        }
        GSYNC();
        TSTAMP(1);
    }
    {
        PH_HEAD();
        const float* fn = INP(27);
        for (int m = gw; m < MTOK; m += NGW) {
            const float rs = row_rstd16(P, m);
            f32x4* xr = (f32x4*)(xres + (size_t)m * 1024) + lane; const f32x4* gp = (const f32x4*)fn + lane;
#pragma unroll
            for (int j = 0; j < 4; ++j) { const f32x4 v = xr[64 * j], gg = gp[64 * j]; xr[64 * j] = v * rs * gg; }
        }
#ifdef TPROBE
        GSYNC(); TSTAMP(6);
        if (blockIdx.x == 0) {
            __syncthreads();
            LAS unsigned long long* tp_ = (LAS unsigned long long*)(lds + PTAB_OFF + 512);
            const float ta = (float)tp_[1 + TPA] * 0.01f, tb = (float)tp_[1 + TPB] * 0.01f;
            if (tid == 0) xres[0] = 10.0f * ta;
            for (int i = tid; i < 10000; i += 512) xres[16 + i] = tb;
        }
#endif
    }
}

extern "C" void kernel_launch(void* const* d_in, const int* in_sizes, int n_in, void* d_out, int out_size, void* d_ws, size_t ws_size, hipStream_t stream) {
    static int grid = 0;
    if (grid == 0) {
        if (n_in != 28 || out_size != MTOK * DM || ws_size < WS_END) { fprintf(stderr, "kernel_launch: unexpected problem (n_in %d out %d ws %zu)\n", n_in, out_size, ws_size); grid = -1; return; }
        int dev = 0, cus = 0, per_cu = 0;
        (void)hipGetDevice(&dev);
        (void)hipDeviceGetAttribute(&cus, hipDeviceAttributeMultiprocessorCount, dev);
        (void)hipFuncSetAttribute((const void*)mega_fwd, hipFuncAttributeMaxDynamicSharedMemorySize, LDS_BYTES);
        (void)hipOccupancyMaxActiveBlocksPerMultiprocessor(&per_cu, (const void*)mega_fwd, 512, LDS_BYTES);
        if (per_cu < 1 || cus < 1) { fprintf(stderr, "kernel_launch: occupancy query gave %d blocks/CU on %d CUs\n", per_cu, cus); grid = -1; return; }
        grid = cus;
    }
    if (grid < 0) return;
    (void)hipMemsetAsync((char*)d_ws + WS_CTL, 0, CTL_BYTES, stream);
    Args a{};
    for (int i = 0; i < 28; ++i) a.in[i] = (const float*)d_in[i];
    a.out = (float*)d_out; a.ws = (unsigned char*)d_ws;
    void* kargs[] = {&a};
    hipError_t e = hipLaunchCooperativeKernel((const void*)mega_fwd, dim3(grid), dim3(512), kargs, LDS_BYTES, stream);
    if (e != hipSuccess) fprintf(stderr, "cooperative launch failed: %s (grid %d)\n", hipGetErrorString(e), grid);
}
```

```cpp
#include <hip/hip_runtime.h>
#include <hip/hip_cooperative_groups.h>
#include <cstdio>
#include <cstdint>
namespace cg = cooperative_groups;

#define LAS __attribute__((address_space(3)))
#define DI __device__ __forceinline__
typedef unsigned short bf16_t;
typedef short bf16x8 __attribute__((ext_vector_type(8)));
typedef float f32x2 __attribute__((ext_vector_type(2)));
typedef float f32x4 __attribute__((ext_vector_type(4)));
typedef float f32x16 __attribute__((ext_vector_type(16)));
typedef unsigned u32x2 __attribute__((ext_vector_type(2)));
typedef unsigned u32x4 __attribute__((ext_vector_type(4)));

constexpr int SEQ = 8192, NB = 2, MTOK = NB * SEQ, DM = 1024, NMEM = 256;
constexpr int INW = 6816, DFF = 2816;
constexpr float EPS = 1e-6f;
constexpr float QSC = 0.10206207261596575f * 1.4426950408889634f;
constexpr float XSC = 0.0625f * 1.4426950408889634f;

DI unsigned cvt_pk(float lo, float hi) {
    typedef __bf16 b2 __attribute__((ext_vector_type(2)));
    f32x2 v = {lo, hi}; b2 b = __builtin_convertvector(v, b2); return __builtin_bit_cast(unsigned, b);
}
DI bf16_t f2bf(float f) { return (bf16_t)(cvt_pk(f, 0.f) & 0xffffu); }
DI float bf2f(bf16_t h) { return __uint_as_float((unsigned)h << 16); }
DI float bflo(unsigned w) { return __uint_as_float(w << 16); }
DI float bfhi(unsigned w) { return __uint_as_float(w & 0xffff0000u); }
DI int olane() { int t = __builtin_amdgcn_mbcnt_hi(~0u, __builtin_amdgcn_mbcnt_lo(~0u, 0u)); asm volatile("" : "+v"(t)); return t; }
DI int otid(int wv) { return wv * 64 + olane(); }
DI float wave_sum(float v) {
#pragma unroll
    for (int o = 1; o < 64; o <<= 1) v += __shfl_xor(v, o);
    return v;
}
DI float sigm(float x) { return __builtin_amdgcn_rcpf(1.f + __expf(-x)); }
DI float gelu_erf(float v) {
    const float av = fabsf(v), t = __builtin_amdgcn_rcpf(av * 0.2316418882f + 1.0f);
    float q = t * 0.5307027145f + (-0.7265760135f); q = q * t + 0.7107068705f; q = q * t + (-0.142248368f); q = q * t + 0.127414796f; q = q * t;
    const float e = __builtin_amdgcn_exp2f((v * v) * (-0.72134752044f));
    const float m = v * (q * e);
    return v < 0.f ? m : v - m;
}
DI int crow(int r, int h) { return (r & 3) + 8 * (r >> 2) + 4 * h; }
DI float dot4(f32x4 a) { return (a.x * a.x + a.y * a.y) + (a.z * a.z + a.w * a.w); }
DI float sum4(f32x4 a) { return (a.x + a.y) + (a.z + a.w); }
#define MFMA32(a, b, c) __builtin_amdgcn_mfma_f32_32x32x16_bf16((a), (b), (c), 0, 0, 0)
DI bf16x8 mk8(u32x2 lo, u32x2 hi) { u32x4 v = {lo.x, lo.y, hi.x, hi.y}; return __builtin_bit_cast(bf16x8, v); }
DI bf16x8 pack8(float a0, float a1, float a2, float a3, float a4, float a5, float a6, float a7) {
    u32x4 v = {cvt_pk(a0, a1), cvt_pk(a2, a3), cvt_pk(a4, a5), cvt_pk(a6, a7)}; return __builtin_bit_cast(bf16x8, v);
}

namespace pg8 {
constexpr int BM = 256, BK = 64, HALF = 128, HTB = HALF * BK * 2, STAGE_BYTES = 8 * HTB, NXCD = 8, WGM = 8;
DI int lds_byte(int r, int c) { const int st = (r >> 4) * 2 + (c >> 5), rr = r & 15, cc = c & 31, ob = rr * 64 + cc * 2; return st * 1024 + (ob ^ (((ob >> 9) & 1) << 5)); }
DI void stage_rc(int b, int& R, int& C) { const int st = b / 1024, sb = b % 1024, swz = sb ^ (((sb >> 9) & 1) << 5); R = (st >> 1) * 16 + swz / 64; C = (st & 1) * 32 + (swz % 64) / 2; }
DI int perm32(int rho) { const int n = rho >> 4, i = rho & 15; return 8 * (i >> 2) + 4 * n + (i & 3); }
struct Unit { int pm, pn; };
struct Gemm { const bf16_t* A; const bf16_t* Bt; int M, N, K, lda, ldb; };
struct StaticOrder {
    int nM, nN, nwg, G, c;
    DI void init(int M, int N, int G_, int c_) { nM = M / BM; nN = N / BM; nwg = nM * nN; G = G_; c = c_; }
    DI bool next(int i, Unit& u) const {
        const long L = (long)i * G + c; if (L >= nwg) return false;
        int wgid = (int)L; { const int q = nwg / NXCD, r = nwg % NXCD, xcd = wgid % NXCD, off = wgid / NXCD; wgid = (xcd < r ? xcd * (q + 1) : r * (q + 1) + (xcd - r) * q) + off; }
        const int nig = WGM * nN, gid = wgid / nig, fm = gid * WGM, gsz = (nM - fm) < WGM ? (nM - fm) : WGM;
        u.pm = fm + ((wgid % nig) % gsz); u.pn = (wgid % nig) / gsz; return true;
    }
};
template <class Epi>
DI void gemm_phase(LAS unsigned char* lds, const Gemm g, const StaticOrder& S, const Epi& E, int wv) {
    const int tid = otid(wv), wid = __builtin_amdgcn_readfirstlane(tid >> 6), lane = tid & 63, wr = wid >> 2, wc = wid & 3, fr = lane & 15, fq = lane >> 4;
    const int K = g.K, nt = K / BK;
    unsigned voffA[2], voffB[2];
#pragma unroll
    for (int i = 0; i < 2; ++i) { int R, C; stage_rc(tid * 16 + i * 8192, R, C); const int Rb = Epi::PERM ? ((R & ~31) + perm32(R & 31)) : R;
        voffA[i] = (unsigned)(R * g.lda + C) * 2u; voffB[i] = (unsigned)(Rb * g.ldb + C) * 2u; }
    const size_t kstep = (size_t)(BK * 2);
    const size_t hsA = (size_t)HALF * g.lda * 2, hsB = (size_t)HALF * g.ldb * 2;
    const size_t tsA = 2 * hsA, tsB = 2 * hsB;
    const unsigned ldsw = (unsigned)wid * 1024u;
    const int aoff = lds_byte(wr * 64 + fr, fq * 8), boff = lds_byte(wc * 32 + fr, fq * 8);
#define PG8_SA(b, h) (((b) * 2 + (h)) * HTB)
#define PG8_SB(b, h) ((4 + (b) * 2 + (h)) * HTB)
#define PG8_STAGE(bufoff, gbase, voff) do { const char* gb_ = (const char*)(gbase); asm volatile("" : "+s"(gb_)); _Pragma("unroll") for (int _i = 0; _i < 2; ++_i) { unsigned vo_ = (voff)[_i]; asm volatile("" : "+v"(vo_)); \
        __builtin_amdgcn_global_load_lds((const unsigned*)(gb_ + vo_), (LAS unsigned*)(lds + (bufoff) + ldsw + _i * 8192), 16, 0, 0); } } while (0)
#define PG8_LDA(dst, b, h) do { _Pragma("unroll") for (int m = 0; m < 4; ++m) _Pragma("unroll") for (int k = 0; k < 2; ++k) dst[m][k] = *(const LAS bf16x8*)(lds + PG8_SA(b, h) + aoff + m * 2048 + k * 1024); } while (0)
#define PG8_LDB(dst, b, h) do { _Pragma("unroll") for (int n = 0; n < 2; ++n) _Pragma("unroll") for (int k = 0; k < 2; ++k) dst[n][k] = *(const LAS bf16x8*)(lds + PG8_SB(b, h) + boff + n * 2048 + k * 1024); } while (0)
#define PG8_MMA(ai, bj, At, Bt) do { __builtin_amdgcn_s_setprio(1); _Pragma("unroll") for (int m = 0; m < 4; ++m) _Pragma("unroll") for (int n = 0; n < 2; ++n) _Pragma("unroll") for (int k = 0; k < 2; ++k) \
        acc[ai][bj][m][n] = __builtin_amdgcn_mfma_f32_16x16x32_bf16(Bt[n][k], At[m][k], acc[ai][bj][m][n], 0, 0, 0); __builtin_amdgcn_s_setprio(0); } while (0)
#define PG8_WAIT_V(n) asm volatile("s_waitcnt vmcnt(" #n ")" ::: "memory")
#define PG8_WAIT_L(n) asm volatile("s_waitcnt lgkmcnt(" #n ")" ::: "memory")
#define PG8_BAR __builtin_amdgcn_s_barrier()
#define PG8_SCHED __builtin_amdgcn_sched_barrier(0)
    Unit cur, nxt; int ui = 0;
    if (!S.next(0, cur)) return;
    f32x4 acc[2][2][4][2];
#pragma unroll
    for (int a = 0; a < 2; ++a)
#pragma unroll
        for (int b = 0; b < 2; ++b)
#pragma unroll
            for (int m = 0; m < 4; ++m)
#pragma unroll
                for (int n = 0; n < 2; ++n) acc[a][b][m][n] = (f32x4){0.f, 0.f, 0.f, 0.f};
    bf16x8 At[4][2], B0[2][2], B1[2][2];
    const char* cA = (const char*)g.A + (size_t)cur.pm * tsA; const char* cB = (const char*)g.Bt + (size_t)cur.pn * tsB;
    PG8_STAGE(PG8_SB(0, 0), cB, voffB); PG8_STAGE(PG8_SB(0, 1), cB + hsB, voffB); PG8_STAGE(PG8_SA(0, 0), cA, voffA); PG8_STAGE(PG8_SA(0, 1), cA + hsA, voffA);
    if (wr == 1) PG8_BAR;
    PG8_WAIT_V(2); PG8_BAR;
    PG8_STAGE(PG8_SB(1, 0), cB + kstep, voffB); PG8_STAGE(PG8_SA(1, 0), cA + kstep, voffA); PG8_STAGE(PG8_SB(1, 1), cB + hsB + kstep, voffB);
    PG8_WAIT_V(6); PG8_BAR;
    for (;;) {
        const bool has_next = S.next(ui + 1, nxt);
        const char* nA = has_next ? (const char*)g.A + (size_t)nxt.pm * tsA : cA; const char* nB = has_next ? (const char*)g.Bt + (size_t)nxt.pn * tsB : cB;
        for (int t = 0; t < nt; t += 2) {
            const bool last = (t == nt - 2);
            const char* a1 = cA + (size_t)(t + 1) * kstep;
            const char* a2 = last ? nA : cA + (size_t)(t + 2) * kstep; const char* b2 = last ? nB : cB + (size_t)(t + 2) * kstep;
            const char* a3 = a2 + kstep; const char* b3 = b2 + kstep;
            PG8_LDB(B0, 0, 0); PG8_LDB(B1, 0, 1); PG8_SCHED; PG8_LDA(At, 0, 0); PG8_STAGE(PG8_SA(1, 1), a1 + hsA, voffA);
            PG8_WAIT_V(8); PG8_WAIT_L(0); PG8_BAR; PG8_MMA(0, 0, At, B0); PG8_MMA(0, 1, At, B1); PG8_BAR; PG8_SCHED;
            PG8_LDA(At, 0, 1); PG8_STAGE(PG8_SB(0, 0), b2, voffB); PG8_STAGE(PG8_SB(0, 1), b2 + hsB, voffB); PG8_STAGE(PG8_SA(0, 0), a2, voffA);
            PG8_WAIT_V(8); PG8_WAIT_L(0); PG8_BAR; PG8_MMA(1, 0, At, B0); PG8_MMA(1, 1, At, B1); PG8_BAR; PG8_SCHED;
            PG8_LDB(B0, 1, 0); PG8_LDB(B1, 1, 1); PG8_SCHED; PG8_LDA(At, 1, 0); PG8_STAGE(PG8_SA(0, 1), a2 + hsA, voffA);
            PG8_WAIT_V(8); PG8_WAIT_L(0); PG8_BAR; PG8_MMA(0, 0, At, B0); PG8_MMA(0, 1, At, B1); PG8_BAR; PG8_SCHED;
            PG8_LDA(At, 1, 1); PG8_STAGE(PG8_SB(1, 0), b3, voffB); PG8_STAGE(PG8_SB(1, 1), b3 + hsB, voffB); PG8_STAGE(PG8_SA(1, 0), a3, voffA);
            PG8_WAIT_V(8); PG8_WAIT_L(0); PG8_BAR; PG8_MMA(1, 0, At, B0); PG8_MMA(1, 1, At, B1); PG8_BAR; PG8_SCHED;
        }
        if (wr == 0) PG8_BAR;
        { const int ln_ = olane(); E(acc, cur, wr, wc, ln_ & 15, ln_ >> 4); }
        if (!has_next) break;
#pragma unroll
        for (int a = 0; a < 2; ++a)
#pragma unroll
            for (int b = 0; b < 2; ++b)
#pragma unroll
                for (int m = 0; m < 4; ++m)
#pragma unroll
                    for (int n = 0; n < 2; ++n) acc[a][b][m][n] = (f32x4){0.f, 0.f, 0.f, 0.f};
        cur = nxt; cA = nA; cB = nB; ++ui;
        if (wr == 1) PG8_BAR;
    }
    PG8_WAIT_V(0);
    PG8_BAR;
#undef PG8_SA
#undef PG8_SB
#undef PG8_STAGE
#undef PG8_LDA
#undef PG8_LDB
#undef PG8_MMA
#undef PG8_WAIT_V
#undef PG8_WAIT_L
#undef PG8_BAR
#undef PG8_SCHED
}
}
typedef const f32x4 (&AccRef)[2][2][4][2];

DI float row_rstd16(const float* P, int row) {
    const f32x4* p = (const f32x4*)(P + (size_t)row * 16);
    const float s = (sum4(p[0]) + sum4(p[1])) + (sum4(p[2]) + sum4(p[3]));
    return rsqrtf(s * (1.0f / 1024.0f) + EPS);
}
DI u32x4 pk16(f32x4 v0, f32x4 v1) { u32x4 w; w.x = cvt_pk(v0[0], v0[1]); w.y = cvt_pk(v0[2], v0[3]); w.z = cvt_pk(v1[0], v1[1]); w.w = cvt_pk(v1[2], v1[3]); return w; }
DI u32x2 pk8(f32x4 v) { u32x2 w; w.x = cvt_pk(v[0], v[1]); w.y = cvt_pk(v[2], v[3]); return w; }

struct EpiA { static constexpr bool PERM = true;
    const float* P; bf16_t* zA; bf16_t* zB; bf16_t* zC; float* PA;
    DI void operator()(AccRef acc, const pg8::Unit& u, int wr, int wc, int fr, int fq) const {
        const int pn = u.pn; bf16_t* base; int ld, colt;
        if (pn < 3) { base = zA; ld = 768; colt = pn * 256; } else if (pn < 11) { base = zB; ld = 2048; colt = (pn - 3) * 256; } else { base = zC; ld = 1024; colt = (pn - 11) * 256; }
        const int row0 = u.pm * 256 + wr * 64 + fr, col0 = colt + wc * 32 + 8 * fq;
#pragma unroll
        for (int ai = 0; ai < 2; ++ai)
#pragma unroll
            for (int m = 0; m < 4; ++m) { const int row = row0 + ai * 128 + m * 16; const float rs = row_rstd16(P, row);
#pragma unroll
                for (int bj = 0; bj < 2; ++bj) { const f32x4 v0 = acc[ai][bj][m][0] * rs, v1 = acc[ai][bj][m][1] * rs;
                    if (pn < 3) { float s = dot4(v0) + dot4(v1); s += __shfl_xor(s, 16); s += __shfl_xor(s, 32); if (fq == 0) PA[(size_t)row * 32 + pn * 8 + bj * 4 + wc] = s; }
                    *(u32x4*)(base + (size_t)row * ld + col0 + bj * 128) = pk16(v0, v1); } }
    }
};
template <bool SIG> struct EpiPlain { static constexpr bool PERM = true;
    const float* P; bf16_t* O; int ldo; float scale;
    DI void operator()(AccRef acc, const pg8::Unit& u, int wr, int wc, int fr, int fq) const {
        const int row0 = u.pm * 256 + wr * 64 + fr, col0 = u.pn * 256 + wc * 32 + 8 * fq;
#pragma unroll
        for (int ai = 0; ai < 2; ++ai)
#pragma unroll
            for (int m = 0; m < 4; ++m) { const int row = row0 + ai * 128 + m * 16; const float rs = row_rstd16(P, row) * scale;
#pragma unroll
                for (int bj = 0; bj < 2; ++bj) { f32x4 v0 = acc[ai][bj][m][0] * rs, v1 = acc[ai][bj][m][1] * rs;
                    if (SIG) {
#pragma unroll
                        for (int e = 0; e < 4; ++e) { v0[e] = sigm(v0[e]); v1[e] = sigm(v1[e]); } }
                    *(u32x4*)(O + (size_t)row * ldo + col0 + bj * 128) = pk16(v0, v1); } }
    }
};
struct EpiQ { static constexpr bool PERM = false;
    const float* PA; const float* CS; bf16_t* Q;
    DI void operator()(AccRef acc, const pg8::Unit& u, int wr, int wc, int fr, int fq) const {
        const int row0 = u.pm * 256 + wr * 64 + fr;
#pragma unroll
        for (int ai = 0; ai < 2; ++ai)
#pragma unroll
            for (int m = 0; m < 4; ++m) { const int row = row0 + ai * 128 + m * 16;
                const f32x4* pp = (const f32x4*)(PA + (size_t)row * 32);
                const float ss = sum4(pp[0]) + sum4(pp[1]) + sum4(pp[2]);
                const float rs = rsqrtf(ss * (1.0f / 384.0f) + EPS);
                const f32x4 cs = *(const f32x4*)(CS + (size_t)row * 32 + 4 * fq), sn = *(const f32x4*)(CS + (size_t)row * 32 + 16 + 4 * fq);
#pragma unroll
                for (int bj = 0; bj < 2; ++bj) { const int g32 = u.pn * 8 + bj * 4 + wc;
                    f32x4 v0 = acc[ai][bj][m][0] * rs, v1 = acc[ai][bj][m][1] * rs;
                    if ((g32 % 3) == 2) { const f32x4 y0 = v0 * cs - v1 * sn, y1 = v0 * sn + v1 * cs; v0 = y0; v1 = y1; }
                    v0 = v0 * QSC; v1 = v1 * QSC;
                    bf16_t* o = Q + (size_t)row * 768 + u.pn * 256 + bj * 128 + wc * 32 + 4 * fq;
                    *(u32x2*)(o) = pk8(v0); *(u32x2*)(o + 16) = pk8(v1); } }
    }
};
struct EpiKV { static constexpr bool PERM = true;
    const float* PA; bf16_t* Kn; bf16_t* Vt;
    DI void operator()(AccRef acc, const pg8::Unit& u, int wr, int wc, int fr, int fq) const {
        const int row0 = u.pm * 256 + wr * 64 + fr;
#pragma unroll
        for (int ai = 0; ai < 2; ++ai)
#pragma unroll
            for (int m = 0; m < 4; ++m) { const int row = row0 + ai * 128 + m * 16;
                const f32x4* pp = (const f32x4*)(PA + (size_t)row * 32 + 12);
                const float ss = sum4(pp[0]) + sum4(pp[1]);
                const float rs = rsqrtf(ss * (1.0f / 256.0f) + EPS);
                const int b = row / SEQ, tok = row % SEQ;
#pragma unroll
                for (int bj = 0; bj < 2; ++bj) { const int h = 2 * u.pn + bj;
                    const f32x4 v0 = acc[ai][bj][m][0] * rs, v1 = acc[ai][bj][m][1] * rs;
                    if (wc < 2) { *(u32x4*)(Kn + (size_t)row * 512 + h * 64 + wc * 32 + 8 * fq) = pk16(v0, v1); }
                    else { bf16_t* vp = Vt + ((size_t)(b * 8 + h) * 64 + (wc - 2) * 32 + 8 * fq) * SEQ + tok;
#pragma unroll
                        for (int e = 0; e < 4; ++e) { vp[(size_t)e * SEQ] = f2bf(v0[e]); vp[(size_t)(4 + e) * SEQ] = f2bf(v1[e]); } } } }
    }
};
struct EpiBr { static constexpr bool PERM = true;
    const bf16_t* G; bf16_t* MX; int j;
    DI void operator()(AccRef acc, const pg8::Unit& u, int wr, int wc, int fr, int fq) const {
        const int row0 = u.pm * 256 + wr * 64 + fr, col0 = u.pn * 256 + wc * 32 + 8 * fq;
#pragma unroll
        for (int ai = 0; ai < 2; ++ai)
#pragma unroll
            for (int m = 0; m < 4; ++m) { const int row = row0 + ai * 128 + m * 16;
#pragma unroll
                for (int bj = 0; bj < 2; ++bj) { const int col = col0 + bj * 128;
                    const u32x4 gw = *(const u32x4*)(G + (size_t)row * 3072 + j * 1024 + col);
                    f32x4 v0 = acc[ai][bj][m][0], v1 = acc[ai][bj][m][1];
                    v0[0] *= bflo(gw.x); v0[1] *= bfhi(gw.x); v0[2] *= bflo(gw.y); v0[3] *= bfhi(gw.y);
                    v1[0] *= bflo(gw.z); v1[1] *= bfhi(gw.z); v1[2] *= bflo(gw.w); v1[3] *= bfhi(gw.w);
                    bf16_t* mp = MX + (size_t)row * 1024 + col;
                    if (j > 0) { const u32x4 ow = *(const u32x4*)mp;
                        v0[0] += bflo(ow.x); v0[1] += bfhi(ow.x); v0[2] += bflo(ow.y); v0[3] += bfhi(ow.y);
                        v1[0] += bflo(ow.z); v1[1] += bfhi(ow.z); v1[2] += bflo(ow.w); v1[3] += bfhi(ow.w); }
                    *(u32x4*)mp = pk16(v0, v1); } }
    }
};
struct EpiRes { static constexpr bool PERM = false;
    const float* xin; float* xout; bf16_t* xb; float* P;
    DI void operator()(AccRef acc, const pg8::Unit& u, int wr, int wc, int fr, int fq) const {
        const int row0 = u.pm * 256 + wr * 64 + fr, col0 = u.pn * 256 + wc * 32 + 4 * fq;
#pragma unroll
        for (int ai = 0; ai < 2; ++ai)
#pragma unroll
            for (int m = 0; m < 4; ++m) { const int row = row0 + ai * 128 + m * 16; float s = 0.f;
#pragma unroll
                for (int bj = 0; bj < 2; ++bj)
#pragma unroll
                    for (int n = 0; n < 2; ++n) { const size_t off = (size_t)row * 1024 + col0 + bj * 128 + n * 16;
                        const f32x4 xo = *(const f32x4*)(xin + off) + acc[ai][bj][m][n];
                        *(f32x4*)(xout + off) = xo; *(u32x2*)(xb + off) = pk8(xo); s += dot4(xo); }
                s += __shfl_xor(s, 16); s += __shfl_xor(s, 32);
                if (fq == 0) P[(size_t)row * 16 + u.pn * 4 + wc] = s; }
    }
};
struct EpiKVm { static constexpr bool PERM = true;
    const float* mrstd; bf16_t* Km; bf16_t* Vmt;
    DI void operator()(AccRef acc, const pg8::Unit& u, int wr, int wc, int fr, int fq) const {
        const int row0 = u.pm * 256 + wr * 64 + fr;
#pragma unroll
        for (int ai = 0; ai < 2; ++ai)
#pragma unroll
            for (int m = 0; m < 4; ++m) { const int row = row0 + ai * 128 + m * 16; const float rs = mrstd[row];
                const int b = row >> 8, key = row & 255;
#pragma unroll
                for (int bj = 0; bj < 2; ++bj) { const f32x4 v0 = acc[ai][bj][m][0] * rs, v1 = acc[ai][bj][m][1] * rs;
                    const int c = u.pn * 256 + bj * 128 + wc * 32 + 8 * fq;
                    if (u.pn < 4) { *(u32x4*)(Km + (size_t)row * 1024 + c) = pk16(v0, v1); }
                    else { const int c2 = c - 1024, h = c2 >> 8, dv = c2 & 255;
                        bf16_t* vp = Vmt + ((size_t)(b * 4 + h) * 256 + dv) * 256 + key;
#pragma unroll
                        for (int e = 0; e < 4; ++e) { vp[e * 256] = f2bf(v0[e]); vp[(4 + e) * 256] = f2bf(v1[e]); } } } }
    }
};
struct EpiFF { static constexpr bool PERM = false;
    const float* P; bf16_t* ACT;
    DI void operator()(AccRef acc, const pg8::Unit& u, int wr, int wc, int fr, int fq) const {
        const int row0 = u.pm * 256 + wr * 64 + fr;
#pragma unroll
        for (int ai = 0; ai < 2; ++ai)
#pragma unroll
            for (int m = 0; m < 4; ++m) { const int row = row0 + ai * 128 + m * 16; const float rs = row_rstd16(P, row);
#pragma unroll
                for (int bj = 0; bj < 2; ++bj) { const int G = u.pn * 8 + bj * 4 + wc;
                    const f32x4 gt = acc[ai][bj][m][0] * rs, up = acc[ai][bj][m][1] * rs; f32x4 a;
#pragma unroll
                    for (int e = 0; e < 4; ++e) a[e] = gt[e] * sigm(gt[e]) * up[e];
                    *(u32x2*)(ACT + (size_t)row * DFF + 16 * G + 4 * fq) = pk8(a); } }
    }
};

DI int srccol(int mode, int np) {
    if (mode == 1) return np < 672 ? np : (np < 768 ? -1 : np - 96);
    if (mode == 2) { const int G = np >> 5, s = (np >> 4) & 1, j = np & 15; return s * DFF + 16 * G + j; }
    return np;
}
DI void conv_item(const float* W, int K, int N, int Np, int mode, const float* gain, bf16_t* WT, LAS float* scr, int item, int lane) {
    const int nblk = Np / 64, kb = item / nblk, nb = item % nblk, k0 = 64 * kb, n0 = 64 * nb;
    const int r = lane >> 4, c4 = (lane & 15) * 4;
    const int sc = srccol(mode, n0 + c4);
    f32x4 v[16];
#pragma unroll
    for (int i = 0; i < 16; ++i) v[i] = (sc >= 0) ? *(const f32x4*)(W + (size_t)(k0 + 4 * i + r) * N + sc) : (f32x4){0.f, 0.f, 0.f, 0.f};
#pragma unroll
    for (int i = 0; i < 16; ++i) { const int row = 4 * i + r; const float gn = gain ? gain[k0 + row] : 1.0f; LAS float* d = scr + row * 65 + c4;
        d[0] = v[i][0] * gn; d[1] = v[i][1] * gn; d[2] = v[i][2] * gn; d[3] = v[i][3] * gn; }
    asm volatile("s_waitcnt lgkmcnt(0)" ::: "memory");
    const int c = lane & 7;
#pragma unroll
    for (int jj = 0; jj < 8; ++jj) { const int n = (lane >> 3) + 8 * jj; const LAS float* sp = scr + (8 * c) * 65 + n;
        u32x4 o; o.x = cvt_pk(sp[0 * 65], sp[1 * 65]); o.y = cvt_pk(sp[2 * 65], sp[3 * 65]); o.z = cvt_pk(sp[4 * 65], sp[5 * 65]); o.w = cvt_pk(sp[6 * 65], sp[7 * 65]);
        *(u32x4*)(WT + (size_t)(n0 + n) * K + k0 + 8 * c) = o; }
    asm volatile("s_waitcnt lgkmcnt(0)" ::: "memory");
}

DI void attn_unit(LAS unsigned char* lds, const bf16_t* Q, const bf16_t* Kn, const bf16_t* Kr, const bf16_t* Vt, bf16_t* Oa, int b, int h, int qb, int wv) {
    const int tid = otid(wv), lane = tid & 63, w = wv, l32 = lane & 31, hi = lane >> 5;
    constexpr int KST = 208, VST = 264, KBUF = 128 * KST, VBUF = 64 * VST, VOFF = 2 * KBUF;
    const size_t rowb = (size_t)b * SEQ;
    const int qrow = qb * 256 + 32 * w + l32;
    bf16x8 qf[6];
#pragma unroll
    for (int ks = 0; ks < 6; ++ks) qf[ks] = *(const bf16x8*)(Q + (rowb + qrow) * 768 + h * 96 + 16 * ks + 8 * hi);
    f32x16 o0, o1;
#pragma unroll
    for (int r = 0; r < 16; ++r) { o0[r] = 0.f; o1[r] = 0.f; }
    float mrun = -INFINITY, lrun = 0.f;
    const int NT = 2 * qb + 2, tlast = 2 * qb + (w >> 2);
    const int kkey = tid >> 3, kch = tid & 7, rkey = tid >> 2, rch = tid & 3, vdv = tid >> 4, vch = tid & 15;
    const bf16_t* gK = Kn + (rowb + kkey) * 512 + h * 64 + kch * 8;
    const bf16_t* gR = Kr + (rowb + rkey) * 32 + rch * 8;
    const bf16_t* gV = Vt + ((size_t)(b * 8 + h) * 64 + vdv) * SEQ + vch * 8;
    u32x4 rk0, rk1, rr, rv0, rv1;
#define ATT_LOAD(t) do { rk0 = *(const u32x4*)(gK + (size_t)(t) * 128 * 512); rk1 = *(const u32x4*)(gK + (size_t)(t) * 128 * 512 + 64 * 512); \
        rr = *(const u32x4*)(gR + (size_t)(t) * 128 * 32); rv0 = *(const u32x4*)(gV + (size_t)(t) * 128); rv1 = *(const u32x4*)(gV + (size_t)(t) * 128 + (size_t)32 * SEQ); } while (0)
#define ATT_STORE(kd, vd) do { *(LAS u32x4*)((kd) + kkey * KST + kch * 16) = rk0; *(LAS u32x4*)((kd) + (64 + kkey) * KST + kch * 16) = rk1; \
        *(LAS u32x4*)((kd) + rkey * KST + 128 + rch * 16) = rr; \
        *(LAS u32x2*)((vd) + vdv * VST + vch * 16) = (u32x2){rv0.x, rv0.y}; *(LAS u32x2*)((vd) + vdv * VST + vch * 16 + 8) = (u32x2){rv0.z, rv0.w}; \
        *(LAS u32x2*)((vd) + (32 + vdv) * VST + vch * 16) = (u32x2){rv1.x, rv1.y}; *(LAS u32x2*)((vd) + (32 + vdv) * VST + vch * 16 + 8) = (u32x2){rv1.z, rv1.w}; } while (0)
    ATT_LOAD(0);
    ATT_STORE(lds, lds + VOFF);
    __syncthreads();
    for (int t = 0; t < NT; ++t) {
        const int cur = t & 1;
        if (t + 1 < NT) ATT_LOAD(t + 1);
        if (t <= tlast) {
            const LAS unsigned char* kb_ = lds + cur * KBUF;
            const LAS unsigned char* vb_ = lds + VOFF + cur * VBUF;
            f32x16 s[4];
#pragma unroll
            for (int kb = 0; kb < 4; ++kb)
#pragma unroll
                for (int r = 0; r < 16; ++r) s[kb][r] = 0.f;
#pragma unroll
            for (int ks = 0; ks < 6; ++ks)
#pragma unroll
                for (int kb = 0; kb < 4; ++kb) {
                    const bf16x8 a = *(const LAS bf16x8*)(kb_ + (32 * kb + l32) * KST + (16 * ks + 8 * hi) * 2);
                    s[kb] = MFMA32(a, qf[ks], s[kb]);
                }
            if (t == tlast) {
#pragma unroll
                for (int kb = 0; kb < 4; ++kb)
#pragma unroll
                    for (int r = 0; r < 16; ++r) { const int key = 128 * t + 32 * kb + crow(r, hi); if (key > qrow) s[kb][r] = -INFINITY; }
            }
            float mx = fmaxf(fmaxf(s[0][0], s[1][0]), fmaxf(s[2][0], s[3][0]));
#pragma unroll
            for (int r = 1; r < 16; ++r) mx = fmaxf(mx, fmaxf(fmaxf(s[0][r], s[1][r]), fmaxf(s[2][r], s[3][r])));
            mx = fmaxf(mx, __shfl_xor(mx, 32));
            const float mnew = fmaxf(mrun, mx);
            if (__builtin_amdgcn_ballot_w64(mnew > mrun) != 0ull) {
                const float alpha = __builtin_amdgcn_exp2f(mrun - mnew);
                mrun = mnew; lrun *= alpha;
#pragma unroll
                for (int r = 0; r < 16; ++r) { o0[r] *= alpha; o1[r] *= alpha; }
            }
            float ps = 0.f;
#pragma unroll
            for (int kb = 0; kb < 4; ++kb)
#pragma unroll
                for (int r = 0; r < 16; ++r) { s[kb][r] = __builtin_amdgcn_exp2f(s[kb][r] - mrun); ps += s[kb][r]; }
            lrun += ps;
#pragma unroll
            for (int kb = 0; kb < 4; ++kb)
#pragma unroll
                for (int sub = 0; sub < 2; ++sub) {
                    const bf16x8 P = pack8(s[kb][8 * sub + 0], s[kb][8 * sub + 1], s[kb][8 * sub + 2], s[kb][8 * sub + 3], s[kb][8 * sub + 4], s[kb][8 * sub + 5], s[kb][8 * sub + 6], s[kb][8 * sub + 7]);
                    const int koff = (32 * kb + 16 * sub + 4 * hi) * 2;
                    const u32x2 a0l = *(const LAS u32x2*)(vb_ + l32 * VST + koff), a0h = *(const LAS u32x2*)(vb_ + l32 * VST + koff + 16);
                    const u32x2 a1l = *(const LAS u32x2*)(vb_ + (32 + l32) * VST + koff), a1h = *(const LAS u32x2*)(vb_ + (32 + l32) * VST + koff + 16);
                    o0 = MFMA32(mk8(a0l, a0h), P, o0); o1 = MFMA32(mk8(a1l, a1h), P, o1);
                }
        }
        if (t + 1 < NT) ATT_STORE(lds + (cur ^ 1) * KBUF, lds + VOFF + (cur ^ 1) * VBUF);
        __syncthreads();
    }
#undef ATT_LOAD
#undef ATT_STORE
    const float lt = lrun + __shfl_xor(lrun, 32);
    const float inv = 1.0f / lt;
    bf16_t* op = Oa + (rowb + qrow) * 512 + h * 64;
#pragma unroll
    for (int g = 0; g < 4; ++g) {
        u32x2 w0, w1;
        w0.x = cvt_pk(o0[4 * g] * inv, o0[4 * g + 1] * inv); w0.y = cvt_pk(o0[4 * g + 2] * inv, o0[4 * g + 3] * inv);
        w1.x = cvt_pk(o1[4 * g] * inv, o1[4 * g + 1] * inv); w1.y = cvt_pk(o1[4 * g + 2] * inv, o1[4 * g + 3] * inv);
        *(u32x2*)(op + 8 * g + 4 * hi) = w0; *(u32x2*)(op + 32 + 8 * g + 4 * hi) = w1;
    }
}

DI void xattn_unit(LAS unsigned char* lds, bf16_t* QX, const bf16_t* Km, const bf16_t* Vmt, int b, int h, int qb, int wv) {
    const int tid = otid(wv), lane = tid & 63, w = __builtin_amdgcn_readfirstlane(tid >> 6), l32 = lane & 31, hi = lane >> 5;
    constexpr int KST = 272, VST = 520, BUF = 64 * VST;
    const size_t row = (size_t)b * SEQ + qb * 256 + 32 * w + l32;
    bf16_t* qp = QX + row * 1024 + h * 256;
    f32x16 sacc[8];
#pragma unroll
    for (int i = 0; i < 8; ++i)
#pragma unroll
        for (int r = 0; r < 16; ++r) sacc[i][r] = 0.f;
    unsigned pp[8][8];
    bf16x8 qf[8];
    u32x4 pf[4];
#define XLOAD(i) do { if ((i) < 8) { const int dh_ = (i) >> 2, kt_ = (i) & 3; \
        _Pragma("unroll") for (int j = 0; j < 2; ++j) { const int id = tid + 512 * j, key = id >> 4, ch = id & 15; \
            pf[j] = *(const u32x4*)(Km + ((size_t)(b * 256 + 64 * kt_ + key)) * 1024 + h * 256 + 128 * dh_ + 8 * ch); } } \
      else { const int c_ = (i) - 8; \
        _Pragma("unroll") for (int j = 0; j < 4; ++j) { const int id = tid + 512 * j, dv = id >> 5, ch = id & 31; \
            pf[j] = *(const u32x4*)(Vmt + ((size_t)((b * 4 + h) * 256 + 64 * c_ + dv)) * 256 + 8 * ch); } } } while (0)
#define XSTORE(i, bufp) do { if ((i) < 8) { \
        _Pragma("unroll") for (int j = 0; j < 2; ++j) { const int id = tid + 512 * j, key = id >> 4, ch = id & 15; *(LAS u32x4*)((bufp) + key * KST + ch * 16) = pf[j]; } } \
      else { \
        _Pragma("unroll") for (int j = 0; j < 4; ++j) { const int id = tid + 512 * j, dv = id >> 5, ch = id & 31; \
            *(LAS u32x2*)((bufp) + dv * VST + ch * 16) = (u32x2){pf[j].x, pf[j].y}; *(LAS u32x2*)((bufp) + dv * VST + ch * 16 + 8) = (u32x2){pf[j].z, pf[j].w}; } } } while (0)
    XLOAD(0); XSTORE(0, lds);
    __syncthreads();
#pragma unroll
    for (int i = 0; i < 12; ++i) {
        const LAS unsigned char* cb_ = lds + (i & 1) * BUF;
        if (i + 1 < 12) XLOAD(i + 1);
        if (i < 8) {
            const int dh = i >> 2, kt = i & 3;
            if (kt == 0) {
#pragma unroll
                for (int ks = 0; ks < 8; ++ks) qf[ks] = *(const bf16x8*)(qp + 128 * dh + 16 * ks + 8 * hi);
            }
#pragma unroll
            for (int ks = 0; ks < 8; ++ks) {
                const bf16x8 a0 = *(const LAS bf16x8*)(cb_ + l32 * KST + (16 * ks + 8 * hi) * 2);
                const bf16x8 a1 = *(const LAS bf16x8*)(cb_ + (32 + l32) * KST + (16 * ks + 8 * hi) * 2);
                sacc[2 * kt] = MFMA32(a0, qf[ks], sacc[2 * kt]); sacc[2 * kt + 1] = MFMA32(a1, qf[ks], sacc[2 * kt + 1]);
            }
            if (i == 7) {
                float mx = sacc[0][0];
#pragma unroll
                for (int j = 0; j < 8; ++j)
#pragma unroll
                    for (int r = 0; r < 16; ++r) mx = fmaxf(mx, sacc[j][r]);
                mx = fmaxf(mx, __shfl_xor(mx, 32));
                float ps = 0.f;
#pragma unroll
                for (int j = 0; j < 8; ++j)
#pragma unroll
                    for (int r = 0; r < 16; ++r) { sacc[j][r] = __builtin_amdgcn_exp2f(sacc[j][r] - mx); ps += sacc[j][r]; }
                ps += __shfl_xor(ps, 32);
                const float inv = 1.0f / ps;
#pragma unroll
                for (int j = 0; j < 8; ++j)
#pragma unroll
                    for (int r2 = 0; r2 < 8; ++r2) pp[j][r2] = cvt_pk(sacc[j][2 * r2] * inv, sacc[j][2 * r2 + 1] * inv);
            }
        } else {
            const int c = i - 8;
            f32x16 o0, o1;
#pragma unroll
            for (int r = 0; r < 16; ++r) { o0[r] = 0.f; o1[r] = 0.f; }
#pragma unroll
            for (int s = 0; s < 16; ++s) {
                const int kb = s >> 1, sub = s & 1;
                const u32x4 pw = {pp[kb][4 * sub], pp[kb][4 * sub + 1], pp[kb][4 * sub + 2], pp[kb][4 * sub + 3]};
                const bf16x8 P = __builtin_bit_cast(bf16x8, pw);
                const int koff = (32 * kb + 16 * sub + 4 * hi) * 2;
                const u32x2 a0l = *(const LAS u32x2*)(cb_ + l32 * VST + koff), a0h = *(const LAS u32x2*)(cb_ + l32 * VST + koff + 16);
                const u32x2 a1l = *(const LAS u32x2*)(cb_ + (32 + l32) * VST + koff), a1h = *(const LAS u32x2*)(cb_ + (32 + l32) * VST + koff + 16);
                o0 = MFMA32(mk8(a0l, a0h), P, o0); o1 = MFMA32(mk8(a1l, a1h), P, o1);
            }
#pragma unroll
            for (int g = 0; g < 4; ++g) {
                u32x2 w0, w1;
                w0.x = cvt_pk(o0[4 * g], o0[4 * g + 1]); w0.y = cvt_pk(o0[4 * g + 2], o0[4 * g + 3]);
                w1.x = cvt_pk(o1[4 * g], o1[4 * g + 1]); w1.y = cvt_pk(o1[4 * g + 2], o1[4 * g + 3]);
                *(u32x2*)(qp + 64 * c + 8 * g + 4 * hi) = w0; *(u32x2*)(qp + 64 * c + 32 + 8 * g + 4 * hi) = w1;
            }
        }
        if (i + 1 < 12) XSTORE(i + 1, lds + ((i + 1) & 1) * BUF);
        __syncthreads();
    }
#undef XLOAD
#undef XSTORE
}

DI void memkv_tile(LAS unsigned char* lds, const bf16_t* memb, const bf16_t* Wt, const float* mrstd, bf16_t* Km, bf16_t* Vmt, int tile, int wv) {
    const int tid = otid(wv), lane = tid & 63, w = wv, l32 = lane & 31, hi = lane >> 5;
    const int r0 = (tile >> 5) * 64, c0 = (tile & 31) * 64;
    f32x16 acc[2][2];
#pragma unroll
    for (int i = 0; i < 2; ++i)
#pragma unroll
        for (int j = 0; j < 2; ++j)
#pragma unroll
            for (int r = 0; r < 16; ++r) acc[i][j][r] = 0.f;
    const bf16_t* ap = memb + (size_t)(r0 + l32) * 1024 + 128 * w + 8 * hi;
    const bf16_t* bp = Wt + (size_t)(c0 + l32) * 1024 + 128 * w + 8 * hi;
#pragma unroll
    for (int ks = 0; ks < 8; ++ks) {
        const bf16x8 a0 = *(const bf16x8*)(ap + 16 * ks), a1 = *(const bf16x8*)(ap + 32 * 1024 + 16 * ks);
        const bf16x8 b0 = *(const bf16x8*)(bp + 16 * ks), b1 = *(const bf16x8*)(bp + 32 * 1024 + 16 * ks);
        acc[0][0] = MFMA32(b0, a0, acc[0][0]); acc[0][1] = MFMA32(b1, a0, acc[0][1]);
        acc[1][0] = MFMA32(b0, a1, acc[1][0]); acc[1][1] = MFMA32(b1, a1, acc[1][1]);
    }
    LAS float* red = (LAS float*)lds;
#pragma unroll
    for (int i = 0; i < 2; ++i)
#pragma unroll
        for (int j = 0; j < 2; ++j)
#pragma unroll
            for (int r = 0; r < 16; ++r) red[((w * 4 + i * 2 + j) * 16 + r) * 64 + lane] = acc[i][j][r];
    __syncthreads();
#pragma unroll
    for (int q = 0; q < 8; ++q) {
        const int idx = tid + 512 * q, ln = idx & 63, r = (idx >> 6) & 15, blk = idx >> 10;
        float s = 0.f;
#pragma unroll
        for (int ww = 0; ww < 8; ++ww) s += red[ww * 4096 + idx];
        const int i = blk >> 1, j = blk & 1;
        const int col = c0 + 32 * j + crow(r, ln >> 5), row = r0 + 32 * i + (ln & 31);
        const float val = s * mrstd[row];
        if (col < 1024) Km[(size_t)row * 1024 + col] = f2bf(val);
        else { const int c2 = col - 1024, h = c2 >> 8, dv = c2 & 255, b = row >> 8, key = row & 255; Vmt[((size_t)(b * 4 + h) * 256 + dv) * 256 + key] = f2bf(val); }
    }
    __syncthreads();
}

DI void gmlp_unit(LAS unsigned char* lds, bf16_t* zC, const float* ln_g, const float* ln_b, const float* w_s, const float* b_s, int chunk, int g, int wv) {
    const int tid = otid(wv), lane = tid & 63, w = __builtin_amdgcn_readfirstlane(tid >> 6), l32 = lane & 31, hi = lane >> 5;
    constexpr int VST = 272;
    const size_t row0 = (size_t)chunk * 128;
    LAS bf16_t* vnT = (LAS bf16_t*)lds;
    {
        f32x4 lg0, lg1, lb0, lb1;
        lg0 = *(const f32x4*)(ln_g + 8 * lane); lg1 = *(const f32x4*)(ln_g + 8 * lane + 4);
        lb0 = *(const f32x4*)(ln_b + 8 * lane); lb1 = *(const f32x4*)(ln_b + 8 * lane + 4);
        u32x4 rawv[16];
#pragma unroll
        for (int tt = 0; tt < 16; ++tt) rawv[tt] = *(const u32x4*)(zC + (row0 + 16 * w + tt) * 1024 + 512 + 8 * lane);
#pragma unroll
        for (int tt = 0; tt < 16; ++tt) {
            const int t = 16 * w + tt;
            const u32x4 raw = rawv[tt];
            float x[8];
            x[0] = gelu_erf(bflo(raw.x)); x[1] = gelu_erf(bfhi(raw.x)); x[2] = gelu_erf(bflo(raw.y)); x[3] = gelu_erf(bfhi(raw.y));
            x[4] = gelu_erf(bflo(raw.z)); x[5] = gelu_erf(bfhi(raw.z)); x[6] = gelu_erf(bflo(raw.w)); x[7] = gelu_erf(bfhi(raw.w));
            float s = 0.f;
#pragma unroll
            for (int e = 0; e < 8; ++e) s += x[e];
            const float mean = wave_sum(s) * (1.0f / 512.0f);
            float q = 0.f;
#pragma unroll
            for (int e = 0; e < 8; ++e) { x[e] -= mean; q += x[e] * x[e]; }
            const float rstd = rsqrtf(wave_sum(q) * (1.0f / 512.0f) + EPS);
            if ((lane >> 4) == g) {
                const int cl = 8 * (lane & 15);
                vnT[(cl + 0) * (VST / 2) + t] = f2bf(x[0] * rstd * lg0[0] + lb0[0]); vnT[(cl + 1) * (VST / 2) + t] = f2bf(x[1] * rstd * lg0[1] + lb0[1]);
                vnT[(cl + 2) * (VST / 2) + t] = f2bf(x[2] * rstd * lg0[2] + lb0[2]); vnT[(cl + 3) * (VST / 2) + t] = f2bf(x[3] * rstd * lg0[3] + lb0[3]);
                vnT[(cl + 4) * (VST / 2) + t] = f2bf(x[4] * rstd * lg1[0] + lb1[0]); vnT[(cl + 5) * (VST / 2) + t] = f2bf(x[5] * rstd * lg1[1] + lb1[1]);
                vnT[(cl + 6) * (VST / 2) + t] = f2bf(x[6] * rstd * lg1[2] + lb1[2]); vnT[(cl + 7) * (VST / 2) + t] = f2bf(x[7] * rstd * lg1[3] + lb1[3]);
            }
        }
    }
    __syncthreads();
    {
        const int tb = w >> 1, cb0 = 2 * (w & 1);
        f32x16 a0, a1;
#pragma unroll
        for (int r = 0; r < 16; ++r) { a0[r] = 0.f; a1[r] = 0.f; }
        const int trow = 32 * tb + l32;
        const float* wrow = w_s + ((size_t)(g * 128 + trow)) * 128;
        f32x4 wq0[8], wq1[8];
#pragma unroll
        for (int ks = 0; ks < 8; ++ks) { wq0[ks] = (f32x4){0.f, 0.f, 0.f, 0.f}; wq1[ks] = wq0[ks];
            if (ks <= 2 * tb + 1) { wq0[ks] = *(const f32x4*)(wrow + 16 * ks + 8 * hi); wq1[ks] = *(const f32x4*)(wrow + 16 * ks + 8 * hi + 4); } }
#pragma unroll
        for (int ks = 0; ks < 8; ++ks) {
            if (ks > 2 * tb + 1) break;
            const int s0 = 16 * ks + 8 * hi;
            f32x4 w0 = wq0[ks], w1 = wq1[ks];
#pragma unroll
            for (int e = 0; e < 4; ++e) { if (s0 + e > trow) w0[e] = 0.f; if (s0 + 4 + e > trow) w1[e] = 0.f; }
            const bf16x8 A = pack8(w0[0], w0[1], w0[2], w0[3], w1[0], w1[1], w1[2], w1[3]);
            const bf16x8 B0 = *(const LAS bf16x8*)(lds + (32 * cb0 + l32) * VST + s0 * 2);
            const bf16x8 B1 = *(const LAS bf16x8*)(lds + (32 * (cb0 + 1) + l32) * VST + s0 * 2);
            a0 = MFMA32(A, B0, a0); a1 = MFMA32(A, B1, a1);
        }
#pragma unroll
        for (int r = 0; r < 16; ++r) {
            const int t = 32 * tb + crow(r, hi);
            const float bs = b_s[g * 128 + t];
            bf16_t* up0 = zC + (row0 + t) * 1024 + g * 128 + 32 * cb0 + l32;
            const float u0 = gelu_erf(bf2f(up0[0])), u1 = gelu_erf(bf2f(up0[32]));
            up0[0] = f2bf((a0[r] + bs) * u0); up0[32] = f2bf((a1[r] + bs) * u1);
        }
    }
    __syncthreads();
}

#define HG_IDS() \
    const int k = tid & 127, seg = tid >> 7; \
    const size_t row0 = (size_t)b * SEQ + (size_t)c * 64 + 16 * seg; \
    bf16_t hfr[16], vrw[16]; \
    _Pragma("unroll") for (int i = 0; i < 16; ++i) { hfr[i] = zB[(row0 + i) * 2048 + 512 + h * 128 + k]; vrw[i] = zB[(row0 + i) * 2048 + 1024 + h * 128 + k]; }
#define HG_PREP() \
    float cum[16], kv[16]; float bref, blast; \
    { const float lb = lbv[h * 128 + k]; float run = 0.f; \
      _Pragma("unroll") for (int i = 0; i < 16; ++i) { const float fr_ = bf2f(hfr[i]); \
          const float e_ = __expf(-fr_), sg_ = __builtin_amdgcn_rcpf(1.f + e_); const float f_ = lb + (1.f - lb) * sg_; \
          run += __logf(f_); cum[i] = run; kv[i] = (1.f - lb) * e_ * sg_; } \
      segs[seg * 128 + k] = run; __syncthreads(); \
      const float s0_ = segs[k], s1_ = segs[128 + k], s2_ = segs[256 + k], s3_ = segs[384 + k]; \
      const float off_ = (seg > 0 ? s0_ : 0.f) + (seg > 1 ? s1_ : 0.f) + (seg > 2 ? s2_ : 0.f); \
      bref = s0_ + s1_; blast = (s0_ + s1_) + (s2_ + s3_); \
      _Pragma("unroll") for (int i = 0; i < 16; ++i) cum[i] += off_; }

constexpr int HG_QR = 0, HG_KR = 17408, HG_QD = 34816, HG_VT = 52224, HG_KDT = 70656, HG_SEG = 89088, HG_SSL = 91136;

DI void hg_u_unit(LAS unsigned char* lds, const bf16_t* zB, const float* lbv, bf16_t* ST, float* dC, int b, int h, int c, int wv) {
    const int tid = otid(wv), lane = tid & 63, w = __builtin_amdgcn_readfirstlane(tid >> 6), l32 = lane & 31, hi = lane >> 5;
    LAS float* segs = (LAS float*)(lds + HG_SEG);
    HG_IDS();
    HG_PREP();
    const int unit = (b * 4 + h) * 128 + c;
    {
        float kd[16]; unsigned vr[8];
#pragma unroll
        for (int i = 0; i < 16; ++i) kd[i] = kv[i] * __expf(blast - cum[i]);
#pragma unroll
        for (int i = 0; i < 8; ++i) { const unsigned lo = vrw[2 * i], hi2 = vrw[2 * i + 1]; vr[i] = lo | (hi2 << 16); }
        LAS unsigned char* kp = lds + HG_KDT + k * 144 + seg * 32;
        *(LAS u32x4*)kp = (u32x4){cvt_pk(kd[0], kd[1]), cvt_pk(kd[2], kd[3]), cvt_pk(kd[4], kd[5]), cvt_pk(kd[6], kd[7])};
        *(LAS u32x4*)(kp + 16) = (u32x4){cvt_pk(kd[8], kd[9]), cvt_pk(kd[10], kd[11]), cvt_pk(kd[12], kd[13]), cvt_pk(kd[14], kd[15])};
        LAS unsigned char* vp = lds + HG_VT + k * 144 + seg * 32;
        *(LAS u32x4*)vp = (u32x4){vr[0], vr[1], vr[2], vr[3]};
        *(LAS u32x4*)(vp + 16) = (u32x4){vr[4], vr[5], vr[6], vr[7]};
        if (seg == 0) dC[(size_t)unit * 128 + k] = __expf(blast);
    }
    __syncthreads();
    {
        const int vb = w & 3;
#pragma unroll
        for (int kbi = 0; kbi < 2; ++kbi) {
            const int kb = 2 * (w >> 2) + kbi;
            f32x16 acc;
#pragma unroll
            for (int r = 0; r < 16; ++r) acc[r] = 0.f;
#pragma unroll
            for (int ks = 0; ks < 4; ++ks) {
                const bf16x8 A = *(const LAS bf16x8*)(lds + HG_VT + (32 * vb + l32) * 144 + (16 * ks + 8 * hi) * 2);
                const bf16x8 B = *(const LAS bf16x8*)(lds + HG_KDT + (32 * kb + l32) * 144 + (16 * ks + 8 * hi) * 2);
                acc = MFMA32(A, B, acc);
            }
            bf16_t* sp = ST + (size_t)unit * 16384 + 32 * kb + l32;
#pragma unroll
            for (int r = 0; r < 16; ++r) sp[(32 * vb + crow(r, hi)) * 128] = f2bf(acc[r]);
        }
    }
    __syncthreads();
}

DI void hg_out_unit(LAS unsigned char* lds, const bf16_t* zB, const float* lbv, const bf16_t* ST, const float* hnorm, bf16_t* Ob, int b, int h, int c, int wv) {
    const int tid = otid(wv), lane = tid & 63, w = __builtin_amdgcn_readfirstlane(tid >> 6), l32 = lane & 31, hi = lane >> 5;
    LAS float* segs = (LAS float*)(lds + HG_SEG);
    LAS float* ssl = (LAS float*)(lds + HG_SSL);
    HG_IDS();
    const int unit = (b * 4 + h) * 128 + c;
    const int vb = w & 3, tb = w >> 2;
    bf16_t hqr[16];
#pragma unroll
    for (int i = 0; i < 16; ++i) hqr[i] = zB[(row0 + i) * 2048 + h * 128 + k];
    bf16x8 stf[8];
    {
        const bf16_t* sp = ST + (size_t)unit * 16384 + (size_t)(32 * vb + l32) * 128 + 8 * hi;
#pragma unroll
        for (int ks = 0; ks < 8; ++ks) stf[ks] = *(const bf16x8*)(sp + 16 * ks);
    }
    u32x2 grw[4];
    {
        const size_t rowg = (size_t)b * SEQ + (size_t)c * 64 + 32 * tb + l32;
#pragma unroll
        for (int g = 0; g < 4; ++g) grw[g] = *(const u32x2*)(zB + rowg * 2048 + 1536 + h * 128 + 32 * vb + 8 * g + 4 * hi);
    }
    HG_PREP();
    {
        LAS bf16_t* Qr = (LAS bf16_t*)(lds + HG_QR); LAS bf16_t* Kr = (LAS bf16_t*)(lds + HG_KR); LAS bf16_t* Qd = (LAS bf16_t*)(lds + HG_QD);
        unsigned vr[8];
#pragma unroll
        for (int i = 0; i < 16; ++i) { const int t = 16 * seg + i;
            const float qraw = bf2f(hqr[i]); const float q = qraw * sigm(qraw);
            Qr[t * 136 + k] = f2bf(q * __expf(cum[i] - bref)); Kr[t * 136 + k] = f2bf(kv[i] * __expf(bref - cum[i])); Qd[t * 136 + k] = f2bf(q * __expf(cum[i])); }
#pragma unroll
        for (int i = 0; i < 8; ++i) { const unsigned lo = vrw[2 * i], hi2 = vrw[2 * i + 1]; vr[i] = lo | (hi2 << 16); }
        LAS unsigned char* vp = lds + HG_VT + k * 144 + seg * 32;
        *(LAS u32x4*)vp = (u32x4){vr[0], vr[1], vr[2], vr[3]};
        *(LAS u32x4*)(vp + 16) = (u32x4){vr[4], vr[5], vr[6], vr[7]};
    }
    __syncthreads();
    f32x16 o;
#pragma unroll
    for (int r = 0; r < 16; ++r) o[r] = 0.f;
    {
#pragma unroll
        for (int ks = 0; ks < 8; ++ks) {
            const bf16x8 A = stf[ks];
            const bf16x8 B = *(const LAS bf16x8*)(lds + HG_QD + (32 * tb + l32) * 272 + (16 * ks + 8 * hi) * 2);
            o = MFMA32(A, B, o);
        }
    }
#pragma unroll
    for (int sb = 0; sb < 2; ++sb) {
        if (sb <= tb) {
            f32x16 at;
#pragma unroll
            for (int r = 0; r < 16; ++r) at[r] = 0.f;
#pragma unroll
            for (int ks = 0; ks < 8; ++ks) {
                const bf16x8 A = *(const LAS bf16x8*)(lds + HG_KR + (32 * sb + l32) * 272 + (16 * ks + 8 * hi) * 2);
                const bf16x8 B = *(const LAS bf16x8*)(lds + HG_QR + (32 * tb + l32) * 272 + (16 * ks + 8 * hi) * 2);
                at = MFMA32(A, B, at);
            }
            if (sb == tb) {
#pragma unroll
                for (int r = 0; r < 16; ++r) if (crow(r, hi) > l32) at[r] = 0.f;
            }
#pragma unroll
            for (int sub = 0; sub < 2; ++sub) {
                const bf16x8 P = pack8(at[8 * sub + 0], at[8 * sub + 1], at[8 * sub + 2], at[8 * sub + 3], at[8 * sub + 4], at[8 * sub + 5], at[8 * sub + 6], at[8 * sub + 7]);
                const int koff = (32 * sb + 16 * sub + 4 * hi) * 2;
                const u32x2 al = *(const LAS u32x2*)(lds + HG_VT + (32 * vb + l32) * 144 + koff), ah = *(const LAS u32x2*)(lds + HG_VT + (32 * vb + l32) * 144 + koff + 16);
                o = MFMA32(mk8(al, ah), P, o);
            }
        }
    }
    float ss = 0.f;
#pragma unroll
    for (int r = 0; r < 16; ++r) ss += o[r] * o[r];
    ss += __shfl_xor(ss, 32);
    if (hi == 0) ssl[vb * 64 + 32 * tb + l32] = ss;
    __syncthreads();
    {
        const int t = 32 * tb + l32;
        const float tot = (ssl[t] + ssl[64 + t]) + (ssl[128 + t] + ssl[192 + t]);
        const float rstd = rsqrtf(tot * (1.0f / 128.0f) + EPS);
        const size_t row = (size_t)b * SEQ + (size_t)c * 64 + t;
#pragma unroll
        for (int g = 0; g < 4; ++g) {
            const int v0 = 32 * vb + 8 * g + 4 * hi;
            const u32x2 gr = grw[g];
            const f32x4 hn = *(const f32x4*)(hnorm + v0);
            const float g0 = bflo(gr.x), g1 = bfhi(gr.x), g2 = bflo(gr.y), g3 = bfhi(gr.y);
            u32x2 ow;
            ow.x = cvt_pk(o[4 * g] * rstd * hn[0] * (g0 * sigm(g0)), o[4 * g + 1] * rstd * hn[1] * (g1 * sigm(g1)));
            ow.y = cvt_pk(o[4 * g + 2] * rstd * hn[2] * (g2 * sigm(g2)), o[4 * g + 3] * rstd * hn[3] * (g3 * sigm(g3)));
            *(u32x2*)(Ob + row * 512 + h * 128 + v0) = ow;
        }
    }
    __syncthreads();
}


#define XB_TMO      128
#define XB_XCNT(j)  (256  + 64 * (j))
#define XB_XSUB(j)  (1280 + 64 * (j))
#define XB_XGEN(j)  (2304 + 64 * (j))
#define XB_TOP      3328
#define XB_TOPGEN   3392
#define XCD_BAR_WORDS 3456
#define XB_SPIN_CAP (1u << 18)
DI unsigned xb_ld(unsigned* p)              { return __hip_atomic_load(p, __ATOMIC_RELAXED, __HIP_MEMORY_SCOPE_AGENT); }
DI unsigned xb_add(unsigned* p, unsigned v) { return __hip_atomic_fetch_add(p, v, __ATOMIC_RELAXED, __HIP_MEMORY_SCOPE_AGENT); }
DI unsigned xb_xcc_id() { return (unsigned)__builtin_amdgcn_s_getreg((3 << 11) | 20) & 0xFu; }
#define XB_SPIN(cond, bar) do { unsigned _sp = 0; while (cond) { __builtin_amdgcn_s_sleep(1); \
    if ((++_sp & 255u) == 0u) { if (xb_ld(&(bar)[XB_TMO])) break; if (_sp > XB_SPIN_CAP) { atomicAdd(&(bar)[XB_TMO], 1u); break; } } } } while (0)
DI void xcd_barrier_complete(unsigned* bar, unsigned x, unsigned& nloc, unsigned& nx) {
    const unsigned G = gridDim.x * gridDim.y * gridDim.z;
    unsigned sum, cnt, mine, sp = 0u;
    for (;;) {
        sum = 0u; cnt = 0u; mine = 0u;
#pragma unroll
        for (unsigned j = 0; j < 16; ++j) { const unsigned c = xb_ld(&bar[XB_XCNT(j)]); sum += c; cnt += (c > 0u) ? 1u : 0u; mine = (j == x) ? c : mine; }
        if (sum == G) break;
        __builtin_amdgcn_s_sleep(1);
        if ((++sp & 255u) == 0u) { if (xb_ld(&bar[XB_TMO])) break; if (sp > XB_SPIN_CAP) { atomicAdd(&bar[XB_TMO], 1u); break; } }
    }
    nloc = mine > 0u ? mine : 1u; nx = cnt > 0u ? cnt : 1u;
}
DI void xcd_barrier(unsigned* bar, volatile LAS unsigned* st) {
    asm volatile("s_waitcnt vmcnt(0)" ::: "memory");
    __syncthreads();
    if (threadIdx.x == 0) {
        const unsigned x = xb_xcc_id();
        __builtin_amdgcn_s_waitcnt(0);
        unsigned nloc = st[0], nx = st[1];
        if (nloc == 0u) { xcd_barrier_complete(bar, x, nloc, nx); st[0] = nloc; st[1] = nx; }
        const unsigned old = xb_add(&bar[XB_XSUB(x)], 1u);
        const unsigned gen = old / nloc;
        if (old + 1u == (gen + 1u) * nloc) {
            __builtin_amdgcn_fence(__ATOMIC_RELEASE, "agent");
            asm volatile("s_waitcnt vmcnt(0)" ::: "memory");
            const unsigned og = xb_add(&bar[XB_TOP], 1u);
            const unsigned tg = og / nx;
            if (og + 1u == (tg + 1u) * nx) xb_add(&bar[XB_TOPGEN], 1u);
            else XB_SPIN(xb_ld(&bar[XB_TOPGEN]) == tg, bar);
            __builtin_amdgcn_fence(__ATOMIC_ACQUIRE, "agent");
            xb_add(&bar[XB_XGEN(x)], 1u);
            asm volatile("s_waitcnt vmcnt(0)" ::: "memory");
        } else {
            XB_SPIN(xb_ld(&bar[XB_XGEN(x)]) == gen, bar);
            __builtin_amdgcn_fence(__ATOMIC_ACQUIRE, "agent");
            asm volatile("s_waitcnt vmcnt(0)" ::: "memory");
        }
    }
    __syncthreads();
}

constexpr size_t MiB = 1u << 20;
constexpr size_t WS_X0 = 0, WS_R2 = 32 * MiB, WS_R3 = 96 * MiB, WS_X1 = 128 * MiB, WS_R1 = 160 * MiB, WS_R4 = 184 * MiB, WS_RW = 216 * MiB;
constexpr size_t WS_CTL = 250 * MiB + 512 * 1024, CTL_BYTES = 16384;
constexpr size_t WS_P = 241 * MiB, WS_PA = 242 * MiB, WS_CS = 244 * MiB, WS_DC = 246 * MiB, WS_MEMB = 247 * MiB, WS_KM = 248 * MiB, WS_VMT = 249 * MiB, WS_MISC = 250 * MiB, WS_END = 251 * MiB;
constexpr size_t W1_IN = 0, W1_UQ = W1_IN + (size_t)6912 * 1024, W1_UKV = W1_UQ + (size_t)768 * 384, W1_BA = W1_UKV + (size_t)1024 * 256, W1_BB = W1_BA + (size_t)1024 * 512,
                 W1_BC = W1_BB + (size_t)1024 * 512, W1_MIX = W1_BC + (size_t)1024 * 512, W1_END = W1_MIX + (size_t)1024 * 1024;
constexpr size_t W2_XQ = 0, W2_XKV = W2_XQ + (size_t)1024 * 1024, W2_XO = W2_XKV + (size_t)2048 * 1024, W2_FI = W2_XO + (size_t)1024 * 1024, W2_FO = W2_FI + (size_t)5632 * 1024, W2_END = W2_FO + (size_t)1024 * 2816;
static_assert(W1_END * 2 <= 25 * MiB && W2_END * 2 <= 25 * MiB, "weight region");

constexpr int LDS_BYTES = 147456;

struct Args { const float* in[28]; float* out; unsigned char* ws; };

constexpr int PTAB_OFF = 135168;
DI void* ldptr(LAS unsigned char* lds, int i) {
    unsigned off_ = PTAB_OFF + 8 * i; asm volatile("" : "+v"(off_));
    const LAS unsigned* t = (const LAS unsigned*)(lds + off_);
    const unsigned lo = __builtin_amdgcn_readfirstlane(t[0]), hi = __builtin_amdgcn_readfirstlane(t[1]);
    return (void*)(((unsigned long long)hi << 32) | (unsigned long long)lo);
}
#define INP(i) ((const float*)ldptr(lds, (i)))
#define PH_HEAD() \
    int G = G0_, bid = bid0_; asm volatile("" : "+s"(G), "+s"(bid)); \
    int wv = wv0_; asm volatile("" : "+s"(wv)); const int tid = otid(wv), lane = tid & 63, wave = wv; \
    const int gw = bid * 8 + wave, NGW = G * 8; (void)lane; (void)gw; (void)NGW; \
    unsigned char* ws = (unsigned char*)ldptr(lds, 29); \
    bf16_t* const X0 = (bf16_t*)(ws + WS_X0); bf16_t* const X1 = (bf16_t*)(ws + WS_X1); \
    bf16_t* const R1 = (bf16_t*)(ws + WS_R1); bf16_t* const R2 = (bf16_t*)(ws + WS_R2); bf16_t* const R3 = (bf16_t*)(ws + WS_R3); bf16_t* const R4 = (bf16_t*)(ws + WS_R4); \
    bf16_t* const RW = (bf16_t*)(ws + WS_RW); \
    float* const P = (float*)(ws + WS_P); float* const PA = (float*)(ws + WS_PA); float* const CS = (float*)(ws + WS_CS); float* const dC = (float*)(ws + WS_DC); \
    bf16_t* const memb = (bf16_t*)(ws + WS_MEMB); bf16_t* const Km = (bf16_t*)(ws + WS_KM); bf16_t* const Vmt = (bf16_t*)(ws + WS_VMT); \
    float* const mrstd = (float*)(ws + WS_MISC); float* const lbv = mrstd + 512; \
    bf16_t* const xcur = par ? X1 : X0; bf16_t* const xfree = par ? X0 : X1; \
    bf16_t* const zA = R1; bf16_t* const zB = R2; bf16_t* const zC = R4; \
    bf16_t* const Qb = R3; bf16_t* const Krb = R3 + (size_t)MTOK * 768; \
    bf16_t* const Knb = xfree; bf16_t* const Vtb = xfree + (size_t)MTOK * 512; \
    bf16_t* const Oa = R1; bf16_t* const Ob = xfree; bf16_t* const STb = R3; bf16_t* const Gt = R2; bf16_t* const MX = xcur; \
    bf16_t* const QX = R2; bf16_t* const ACT = R2; float* const xres = (float*)ldptr(lds, 28); \
    (void)X0; (void)X1; (void)R1; (void)R2; (void)R3; (void)R4; (void)RW; (void)P; (void)PA; (void)CS; (void)dC; (void)memb; (void)Km; (void)Vmt; (void)mrstd; (void)lbv; \
    (void)xcur; (void)xfree; (void)zA; (void)zB; (void)zC; (void)Qb; (void)Krb; (void)Knb; (void)Vtb; (void)Oa; (void)Ob; (void)STb; (void)Gt; (void)MX; (void)QX; (void)ACT; (void)xres;

#ifdef TPROBE
#define TSTAMP(cls) do { if (blockIdx.x == 0 && threadIdx.x == 0) { LAS unsigned long long* tp_ = (LAS unsigned long long*)(lds + PTAB_OFF + 512); \
    const unsigned long long now_ = __builtin_amdgcn_s_memrealtime(); tp_[1 + (cls)] += now_ - tp_[0]; tp_[0] = now_; } } while (0)
#else
#define TSTAMP(cls) do { } while (0)
#endif
#define GSYNC() xcd_barrier((unsigned*)((unsigned char*)ldptr(lds, 29) + WS_CTL), (volatile LAS unsigned*)(lds + PTAB_OFF + 256))
__global__ void __launch_bounds__(512, 2) mega_fwd(Args args) {
    extern __shared__ __attribute__((aligned(16))) unsigned char lds_raw[];
    LAS unsigned char* lds = (LAS unsigned char*)lds_raw;
    cg::grid_group grid = cg::this_grid();
    const int G0_ = gridDim.x, bid0_ = blockIdx.x, wv0_ = __builtin_amdgcn_readfirstlane(threadIdx.x >> 6);
    int par = 0;
    if (threadIdx.x == 0) {
        LAS unsigned long long* pt = (LAS unsigned long long*)(lds + PTAB_OFF);
#pragma unroll
        for (int i = 0; i < 28; ++i) pt[i] = (unsigned long long)args.in[i];
        pt[28] = (unsigned long long)args.out; pt[29] = (unsigned long long)args.ws;
        pt[32] = 0ull;
#ifdef TPROBE
        for (int i = 0; i < 8; ++i) pt[64 + i] = 0ull; pt[64] = __builtin_amdgcn_s_memrealtime();
#endif
        (void)xb_add((unsigned*)(args.ws + WS_CTL) + XB_XCNT(xb_xcc_id()), 1u);
    }
    __syncthreads();

    for (int l = 0; l < 2; ++l) {
        {
            PH_HEAD();
            LAS float* scr = (LAS float*)(lds + wave * 16640);
            const float* w_in = INP(4) + (size_t)l * 1024 * INW; const float* mixn = INP(3) + l * 1024;
            const float* wuq = INP(6) + (size_t)l * 384 * 768; const float* qn = INP(5) + l * 384;
            const float* wukv = INP(8) + (size_t)l * 256 * 1024; const float* kvn = INP(7) + l * 256;
            const float* wba = INP(15) + (size_t)l * 512 * 1024; const float* wbb = INP(16) + (size_t)l * 512 * 1024; const float* wbc = INP(17) + (size_t)l * 512 * 1024;
            const float* wmx = INP(18) + (size_t)l * 1024 * 1024;
            constexpr int I_IN = 16 * 108, I_UQ = 6 * 12, I_UKV = 4 * 16, I_B = 8 * 16, I_MX = 16 * 16;
            constexpr int NIT = I_IN + I_UQ + I_UKV + 3 * I_B + I_MX;
            for (int it = gw; it < NIT; it += NGW) {
                int r = it;
                if (r < I_IN) { conv_item(w_in, 1024, INW, 6912, 1, mixn, RW + W1_IN, scr, r, lane); continue; } r -= I_IN;
                if (r < I_UQ) { conv_item(wuq, 384, 768, 768, 0, qn, RW + W1_UQ, scr, r, lane); continue; } r -= I_UQ;
                if (r < I_UKV) { conv_item(wukv, 256, 1024, 1024, 0, kvn, RW + W1_UKV, scr, r, lane); continue; } r -= I_UKV;
                if (r < I_B) { conv_item(wba, 512, 1024, 1024, 0, nullptr, RW + W1_BA, scr, r, lane); continue; } r -= I_B;
                if (r < I_B) { conv_item(wbb, 512, 1024, 1024, 0, nullptr, RW + W1_BB, scr, r, lane); continue; } r -= I_B;
                if (r < I_B) { conv_item(wbc, 512, 1024, 1024, 0, nullptr, RW + W1_BC, scr, r, lane); continue; } r -= I_B;
                conv_item(wmx, 1024, 1024, 1024, 0, nullptr, RW + W1_MIX, scr, r, lane);
            }
            if (l == 0) {
                const float* xin0 = INP(0);
                for (int m0 = 4 * gw; m0 < MTOK; m0 += 4 * NGW) {
                    f32x4 vv[4][4];
#pragma unroll
                    for (int q = 0; q < 4; ++q)
#pragma unroll
                        for (int j = 0; j < 4; ++j) vv[q][j] = ((const f32x4*)(xin0 + (size_t)(m0 + q) * 1024) + lane)[64 * j];
#pragma unroll
                    for (int q = 0; q < 4; ++q) { const int m = m0 + q; float s = 0.f;
                        unsigned long long* o8 = (unsigned long long*)(xcur + (size_t)m * 1024) + lane;
#pragma unroll
                        for (int j = 0; j < 4; ++j) { const f32x4 v = vv[q][j]; s += dot4(v); o8[64 * j] = (unsigned long long)cvt_pk(v.x, v.y) | ((unsigned long long)cvt_pk(v.z, v.w) << 32); }
                        s = wave_sum(s);
                        if (lane < 16) P[(size_t)m * 16 + lane] = (lane == 0) ? s : 0.f; }
                }
                for (int m = gw; m < NB * NMEM; m += NGW) {
                    const f32x4* xr = (const f32x4*)(INP(1) + (size_t)m * 1024) + lane; float s = 0.f;
                    unsigned long long* o8 = (unsigned long long*)(memb + (size_t)m * 1024) + lane;
#pragma unroll
                    for (int j = 0; j < 4; ++j) { const f32x4 v = xr[64 * j]; s += dot4(v); o8[64 * j] = (unsigned long long)cvt_pk(v.x, v.y) | ((unsigned long long)cvt_pk(v.z, v.w) << 32); }
                    s = wave_sum(s);
                    if (lane == 0) mrstd[m] = rsqrtf(s * (1.0f / 1024.0f) + EPS);
                }
                const int* pos = (const int*)INP(2);
                for (int idx = bid * 512 + tid; idx < MTOK * 16; idx += G * 512) {
                    const int row = idx >> 4, j = idx & 15;
                    const float invf = powf(10000.0f, -(float)(2 * j) / 32.0f);
                    const float ang = (float)pos[row] * invf;
                    double tt = (double)ang * 0.15915494309189535; tt -= rint(tt);
                    const float rv = (float)tt;
                    CS[(size_t)row * 32 + j] = __builtin_amdgcn_cosf(rv); CS[(size_t)row * 32 + 16 + j] = __builtin_amdgcn_sinf(rv);
                }
                for (int idx = bid * 512 + tid; idx < 512; idx += G * 512) {
                    const float p0 = INP(9)[idx], p1 = INP(9)[512 + idx];
                    lbv[idx] = 0.f; lbv[512 + idx] = 1.0f / (1.0f + expf(p0 - p1));
                }
            }
        }
        __syncthreads();
        if (l == 0) grid.sync(); else GSYNC();
        TSTAMP(0);
        {
            PH_HEAD();
            pg8::Gemm g{xcur, RW + W1_IN, MTOK, 3840, 1024, 1024, 1024}; pg8::StaticOrder S; S.init(MTOK, 3840, G, bid);
            EpiA E{P, zA, zB, zC, PA};
            pg8::gemm_phase<EpiA>(lds, g, S, E, wv);
        }
        GSYNC();
        TSTAMP(1);
        {
            PH_HEAD();
            for (int idx = bid * 512 + tid; idx < MTOK * 16; idx += G * 512) {
                const int row = idx >> 4, j = idx & 15;
                const float x1 = bf2f(zA[(size_t)row * 768 + 640 + j]), x2 = bf2f(zA[(size_t)row * 768 + 656 + j]);
                const float cs = CS[(size_t)row * 32 + j], sn = CS[(size_t)row * 32 + 16 + j];
                Krb[(size_t)row * 32 + j] = f2bf(x1 * cs - x2 * sn); Krb[(size_t)row * 32 + 16 + j] = f2bf(x1 * sn + x2 * cs);
            }
            { pg8::Gemm g{zA, RW + W1_UQ, MTOK, 768, 384, 768, 384}; pg8::StaticOrder S; S.init(MTOK, 768, G, bid);
              EpiQ E{PA, CS, Qb}; pg8::gemm_phase<EpiQ>(lds, g, S, E, wv); }
            { pg8::Gemm g{zA + 384, RW + W1_UKV, MTOK, 1024, 256, 768, 256}; pg8::StaticOrder S; S.init(MTOK, 1024, G, bid);
              EpiKV E{PA, Knb, Vtb}; pg8::gemm_phase<EpiKV>(lds, g, S, E, wv); }
        }
        __syncthreads();
        GSYNC();
        TSTAMP(1);
        {
            PH_HEAD();
            for (int item = bid; item < 256; item += G) {
                const int b = item >> 7, h = (item >> 4) & 7, s = item & 15;
                attn_unit(lds, Qb, Knb, Krb, Vtb, Oa, b, h, 31 - s, wv);
                attn_unit(lds, Qb, Knb, Krb, Vtb, Oa, b, h, s, wv);
            }
#ifdef TPROBE
            GSYNC(); TSTAMP(2);
#endif
            const float* lng = INP(11) + l * 512; const float* lnb = INP(12) + l * 512;
            const float* wsp = INP(13) + (size_t)l * 4 * 128 * 128; const float* bsp = INP(14) + l * 512;
            for (int u = bid; u < 512; u += G) gmlp_unit(lds, zC, lng, lnb, wsp, bsp, u >> 2, u & 3, wv);
        }
        GSYNC();
#ifdef TPROBE
        TSTAMP(5);
#else
        TSTAMP(2);
#endif
        {
            PH_HEAD();
            for (int u = bid; u < 1024; u += G) hg_u_unit(lds, zB, lbv + l * 512, STb, dC, u >> 9, (u >> 7) & 3, u & 127, wv);
        }
        GSYNC();
        TSTAMP(3);
        {
            PH_HEAD();
            if (tid < 256) {
                for (int p = bid * 256 + tid; p < 65536; p += G * 256) {
                    const int bh = p >> 13, e2 = p & 8191;
                    unsigned* sp = (unsigned*)STb + (size_t)bh * 128 * 8192 + e2;
                    const float* dp = dC + (size_t)bh * 128 * 128 + ((2 * e2) & 127);
                    float S0 = 0.f, S1 = 0.f;
                    for (int c0 = 0; c0 < 128; c0 += 16) {
                        unsigned uu[16]; f32x2 dd[16];
#pragma unroll
                        for (int i = 0; i < 16; ++i) { uu[i] = sp[(size_t)(c0 + i) * 8192]; dd[i] = *(const f32x2*)(dp + (size_t)(c0 + i) * 128); }
#pragma unroll
                        for (int i = 0; i < 16; ++i) { sp[(size_t)(c0 + i) * 8192] = cvt_pk(S0, S1); S0 = dd[i].x * S0 + bflo(uu[i]); S1 = dd[i].y * S1 + bfhi(uu[i]); }
                    }
                }
            }
        }
        GSYNC();
        TSTAMP(3);
        {
            PH_HEAD();
            for (int u = bid; u < 1024; u += G) hg_out_unit(lds, zB, lbv + l * 512, STb, INP(10) + l * 128, Ob, u >> 9, (u >> 7) & 3, u & 127, wv);
        }
        GSYNC();
        TSTAMP(3);
        {
            PH_HEAD();
            pg8::Gemm g{xcur, RW + W1_IN + (size_t)3840 * 1024, MTOK, 3072, 1024, 1024, 1024}; pg8::StaticOrder S; S.init(MTOK, 3072, G, bid);
            EpiPlain<true> E{P, Gt, 3072, 1.0f};
            pg8::gemm_phase<EpiPlain<true>>(lds, g, S, E, wv);
        }
        GSYNC();
        TSTAMP(1);
        {
            PH_HEAD();
            pg8::StaticOrder S; S.init(MTOK, 1024, G, bid);
            { pg8::Gemm g{Oa, RW + W1_BA, MTOK, 1024, 512, 512, 512}; EpiBr E{Gt, MX, 0}; pg8::gemm_phase<EpiBr>(lds, g, S, E, wv); }
            { pg8::Gemm g{Ob, RW + W1_BB, MTOK, 1024, 512, 512, 512}; EpiBr E{Gt, MX, 1}; pg8::gemm_phase<EpiBr>(lds, g, S, E, wv); }
            { pg8::Gemm g{zC, RW + W1_BC, MTOK, 1024, 512, 1024, 512}; EpiBr E{Gt, MX, 2}; pg8::gemm_phase<EpiBr>(lds, g, S, E, wv); }
        }
        GSYNC();
        TSTAMP(1);
        {
            PH_HEAD();
            pg8::Gemm g{MX, RW + W1_MIX, MTOK, 1024, 1024, 1024, 1024}; pg8::StaticOrder S; S.init(MTOK, 1024, G, bid);
            EpiRes E{l == 0 ? INP(0) : (const float*)xres, xres, xfree, P};
            pg8::gemm_phase<EpiRes>(lds, g, S, E, wv);
        }
        par ^= 1;
        GSYNC();
        TSTAMP(1);
        {
            PH_HEAD();
            LAS float* scr = (LAS float*)(lds + wave * 16640);
            const float* wxq = INP(21) + (size_t)l * 1024 * 1024; const float* xan = INP(19) + l * 1024;
            const float* wxkv = INP(22) + (size_t)l * 1024 * 2048; const float* memn = INP(20) + l * 1024;
            const float* wxo = INP(23) + (size_t)l * 1024 * 1024;
            const float* wfi = INP(25) + (size_t)l * 1024 * 2 * DFF; const float* ffn = INP(24) + l * 1024;
            const float* wfo = INP(26) + (size_t)l * DFF * 1024;
            constexpr int I_XQ = 16 * 16, I_XKV = 16 * 32, I_FI = 16 * 88, I_FO = 44 * 16;
            constexpr int NIT = 2 * I_XQ + I_XKV + I_FI + I_FO;
            for (int it = gw; it < NIT; it += NGW) {
                int r = it;
                if (r < I_XQ) { conv_item(wxq, 1024, 1024, 1024, 0, xan, RW + W2_XQ, scr, r, lane); continue; } r -= I_XQ;
                if (r < I_XKV) { conv_item(wxkv, 1024, 2048, 2048, 0, memn, RW + W2_XKV, scr, r, lane); continue; } r -= I_XKV;
                if (r < I_XQ) { conv_item(wxo, 1024, 1024, 1024, 0, nullptr, RW + W2_XO, scr, r, lane); continue; } r -= I_XQ;
                if (r < I_FI) { conv_item(wfi, 1024, 2 * DFF, 2 * DFF, 2, ffn, RW + W2_FI, scr, r, lane); continue; } r -= I_FI;
                conv_item(wfo, DFF, 1024, 1024, 0, nullptr, RW + W2_FO, scr, r, lane);
            }
        }
        __syncthreads();
        GSYNC();
        TSTAMP(0);
        {
            PH_HEAD();
            { pg8::Gemm g{xcur, RW + W2_XQ, MTOK, 1024, 1024, 1024, 1024}; pg8::StaticOrder S; S.init(MTOK, 1024, G, bid);
              EpiPlain<false> E{P, QX, 1024, XSC}; pg8::gemm_phase<EpiPlain<false>>(lds, g, S, E, wv); }
            for (int t = bid; t < 256; t += G) memkv_tile(lds, memb, RW + W2_XKV, mrstd, Km, Vmt, t, wv);
        }
        GSYNC();
        TSTAMP(1);
        {
            PH_HEAD();
            for (int u = bid; u < 256; u += G) xattn_unit(lds, QX, Km, Vmt, u >> 7, (u >> 5) & 3, u & 31, wv);
        }
        GSYNC();
        TSTAMP(4);
        {
            PH_HEAD();
            pg8::Gemm g{QX, RW + W2_XO, MTOK, 1024, 1024, 1024, 1024}; pg8::StaticOrder S; S.init(MTOK, 1024, G, bid);
            EpiRes E{xres, xres, xcur, P};
            pg8::gemm_phase<EpiRes>(lds, g, S, E, wv);
        }
        GSYNC();
        TSTAMP(1);
        {
            PH_HEAD();
            pg8::Gemm g{xcur, RW + W2_FI, MTOK, 2 * DFF, 1024, 1024, 1024}; pg8::StaticOrder S; S.init(MTOK, 2 * DFF, G, bid);
            EpiFF E{P, ACT};
            pg8::gemm_phase<EpiFF>(lds, g, S, E, wv);
        }
        GSYNC();
        TSTAMP(1);
        {
            PH_HEAD();
            pg8::Gemm g{ACT, RW + W2_FO, MTOK, 1024, DFF, DFF, DFF}; pg8::StaticOrder S; S.init(MTOK, 1024, G, bid);
            EpiRes E{xres, xres, xcur, P};
            pg8::gemm_phase<EpiRes>(lds, g, S, E, wv);
        }
        GSYNC();
        TSTAMP(1);
    }
    {
        PH_HEAD();
        const float* fn = INP(27);
        const f32x4* gp = (const f32x4*)fn + lane;
        f32x4 gg[4];
#pragma unroll
        for (int j = 0; j < 4; ++j) gg[j] = gp[64 * j];
        for (int m0 = 4 * gw; m0 < MTOK; m0 += 4 * NGW) {
            f32x4 vv[4][4]; float rs[4];
#pragma unroll
            for (int q = 0; q < 4; ++q) { rs[q] = row_rstd16(P, m0 + q);
#pragma unroll
                for (int j = 0; j < 4; ++j) vv[q][j] = ((const f32x4*)(xres + (size_t)(m0 + q) * 1024) + lane)[64 * j]; }
#pragma unroll
            for (int q = 0; q < 4; ++q)
#pragma unroll
                for (int j = 0; j < 4; ++j) ((f32x4*)(xres + (size_t)(m0 + q) * 1024) + lane)[64 * j] = vv[q][j] * rs[q] * gg[j];
        }
#ifdef TPROBE
        GSYNC(); TSTAMP(6);
        if (blockIdx.x == 0) {
            __syncthreads();
            LAS unsigned long long* tp_ = (LAS unsigned long long*)(lds + PTAB_OFF + 512);
            const float ta = (float)tp_[1 + TPA] * 0.01f, tb = (float)tp_[1 + TPB] * 0.01f;
            if (tid == 0) xres[0] = 10.0f * ta;
            for (int i = tid; i < 10000; i += 512) xres[16 + i] = tb;
        }
#endif
    }
}

extern "C" void kernel_launch(void* const* d_in, const int* in_sizes, int n_in, void* d_out, int out_size, void* d_ws, size_t ws_size, hipStream_t stream) {
    static int grid = 0;
    if (grid == 0) {
        if (n_in != 28 || out_size != MTOK * DM || ws_size < WS_END) { fprintf(stderr, "kernel_launch: unexpected problem (n_in %d out %d ws %zu)\n", n_in, out_size, ws_size); grid = -1; return; }
        int dev = 0, cus = 0, per_cu = 0;
        (void)hipGetDevice(&dev);
        (void)hipDeviceGetAttribute(&cus, hipDeviceAttributeMultiprocessorCount, dev);
        (void)hipFuncSetAttribute((const void*)mega_fwd, hipFuncAttributeMaxDynamicSharedMemorySize, LDS_BYTES);
        (void)hipOccupancyMaxActiveBlocksPerMultiprocessor(&per_cu, (const void*)mega_fwd, 512, LDS_BYTES);
        if (per_cu < 1 || cus < 1) { fprintf(stderr, "kernel_launch: occupancy query gave %d blocks/CU on %d CUs\n", per_cu, cus); grid = -1; return; }
        grid = cus;
    }
    if (grid < 0) return;
    (void)hipMemsetAsync((char*)d_ws + WS_CTL, 0, CTL_BYTES, stream);
    Args a{};
    for (int i = 0; i < 28; ++i) a.in[i] = (const float*)d_in[i];
    a.out = (float*)d_out; a.ws = (unsigned char*)d_ws;
    void* kargs[] = {&a};
    hipError_t e = hipLaunchCooperativeKernel((const void*)mega_fwd, dim3(grid), dim3(512), kargs, LDS_BYTES, stream);
    if (e != hipSuccess) fprintf(stderr, "cooperative launch failed: %s (grid %d)\n", hipGetErrorString(e), grid);
}
```

```cpp
#include <hip/hip_runtime.h>
#include <hip/hip_cooperative_groups.h>
#include <cstdio>
#include <cstdint>
namespace cg = cooperative_groups;

#define LAS __attribute__((address_space(3)))
#define DI __device__ __forceinline__
typedef unsigned short bf16_t;
typedef short bf16x8 __attribute__((ext_vector_type(8)));
typedef float f32x2 __attribute__((ext_vector_type(2)));
typedef float f32x4 __attribute__((ext_vector_type(4)));
typedef float f32x16 __attribute__((ext_vector_type(16)));
typedef unsigned u32x2 __attribute__((ext_vector_type(2)));
typedef unsigned u32x4 __attribute__((ext_vector_type(4)));

constexpr int SEQ = 8192, NB = 2, MTOK = NB * SEQ, DM = 1024, NMEM = 256;
constexpr int INW = 6816, DFF = 2816;
constexpr float EPS = 1e-6f;
constexpr float QSC = 0.10206207261596575f * 1.4426950408889634f;
constexpr float XSC = 0.0625f * 1.4426950408889634f;

DI unsigned cvt_pk(float lo, float hi) {
    typedef __bf16 b2 __attribute__((ext_vector_type(2)));
    f32x2 v = {lo, hi}; b2 b = __builtin_convertvector(v, b2); return __builtin_bit_cast(unsigned, b);
}
DI bf16_t f2bf(float f) { return (bf16_t)(cvt_pk(f, 0.f) & 0xffffu); }
DI float bf2f(bf16_t h) { return __uint_as_float((unsigned)h << 16); }
DI float bflo(unsigned w) { return __uint_as_float(w << 16); }
DI float bfhi(unsigned w) { return __uint_as_float(w & 0xffff0000u); }
DI int olane() { int t = __builtin_amdgcn_mbcnt_hi(~0u, __builtin_amdgcn_mbcnt_lo(~0u, 0u)); asm volatile("" : "+v"(t)); return t; }
DI int otid(int wv) { return wv * 64 + olane(); }
DI float wave_sum(float v) {
#pragma unroll
    for (int o = 1; o < 64; o <<= 1) v += __shfl_xor(v, o);
    return v;
}
DI float sigm(float x) { return __builtin_amdgcn_rcpf(1.f + __expf(-x)); }
DI float gelu_erf(float v) {
    const float av = fabsf(v), t = __builtin_amdgcn_rcpf(av * 0.2316418882f + 1.0f);
    float q = t * 0.5307027145f + (-0.7265760135f); q = q * t + 0.7107068705f; q = q * t + (-0.142248368f); q = q * t + 0.127414796f; q = q * t;
    const float e = __builtin_amdgcn_exp2f((v * v) * (-0.72134752044f));
    const float m = v * (q * e);
    return v < 0.f ? m : v - m;
}
DI int crow(int r, int h) { return (r & 3) + 8 * (r >> 2) + 4 * h; }
DI float dot4(f32x4 a) { return (a.x * a.x + a.y * a.y) + (a.z * a.z + a.w * a.w); }
DI float sum4(f32x4 a) { return (a.x + a.y) + (a.z + a.w); }
#define LBAR() do { asm volatile("s_waitcnt lgkmcnt(0)" ::: "memory"); __builtin_amdgcn_s_barrier(); asm volatile("" ::: "memory"); } while (0)
#define MFMA32(a, b, c) __builtin_amdgcn_mfma_f32_32x32x16_bf16((a), (b), (c), 0, 0, 0)
DI bf16x8 mk8(u32x2 lo, u32x2 hi) { u32x4 v = {lo.x, lo.y, hi.x, hi.y}; return __builtin_bit_cast(bf16x8, v); }
DI bf16x8 pack8(float a0, float a1, float a2, float a3, float a4, float a5, float a6, float a7) {
    u32x4 v = {cvt_pk(a0, a1), cvt_pk(a2, a3), cvt_pk(a4, a5), cvt_pk(a6, a7)}; return __builtin_bit_cast(bf16x8, v);
}

namespace pg8 {
constexpr int BM = 256, BK = 64, HALF = 128, HTB = HALF * BK * 2, STAGE_BYTES = 8 * HTB, NXCD = 8, WGM = 8;
DI int lds_byte(int r, int c) { const int st = (r >> 4) * 2 + (c >> 5), rr = r & 15, cc = c & 31, ob = rr * 64 + cc * 2; return st * 1024 + (ob ^ (((ob >> 9) & 1) << 5)); }
DI void stage_rc(int b, int& R, int& C) { const int st = b / 1024, sb = b % 1024, swz = sb ^ (((sb >> 9) & 1) << 5); R = (st >> 1) * 16 + swz / 64; C = (st & 1) * 32 + (swz % 64) / 2; }
DI int perm32(int rho) { const int n = rho >> 4, i = rho & 15; return 8 * (i >> 2) + 4 * n + (i & 3); }
struct Unit { int pm, pn; };
struct Gemm { const bf16_t* A; const bf16_t* Bt; int M, N, K, lda, ldb; };
struct StaticOrder {
    int nM, nN, nwg, G, c;
    DI void init(int M, int N, int G_, int c_) { nM = M / BM; nN = N / BM; nwg = nM * nN; G = G_; c = c_; }
    DI bool next(int i, Unit& u) const {
        const long L = (long)i * G + c; if (L >= nwg) return false;
        int wgid = (int)L; { const int q = nwg / NXCD, r = nwg % NXCD, xcd = wgid % NXCD, off = wgid / NXCD; wgid = (xcd < r ? xcd * (q + 1) : r * (q + 1) + (xcd - r) * q) + off; }
        const int nig = WGM * nN, gid = wgid / nig, fm = gid * WGM, gsz = (nM - fm) < WGM ? (nM - fm) : WGM;
        u.pm = fm + ((wgid % nig) % gsz); u.pn = (wgid % nig) / gsz; return true;
    }
};
template <class Epi>
DI void gemm_phase(LAS unsigned char* lds, const Gemm g, const StaticOrder& S, const Epi& E, int wv) {
    const int tid = otid(wv), wid = __builtin_amdgcn_readfirstlane(tid >> 6), lane = tid & 63, wr = wid >> 2, wc = wid & 3, fr = lane & 15, fq = lane >> 4;
    const int K = g.K, nt = K / BK;
    unsigned voffA[2], voffB[2];
#pragma unroll
    for (int i = 0; i < 2; ++i) { int R, C; stage_rc(tid * 16 + i * 8192, R, C); const int Rb = Epi::PERM ? ((R & ~31) + perm32(R & 31)) : R;
        voffA[i] = (unsigned)(R * g.lda + C) * 2u; voffB[i] = (unsigned)(Rb * g.ldb + C) * 2u; }
    const size_t kstep = (size_t)(BK * 2);
    const size_t hsA = (size_t)HALF * g.lda * 2, hsB = (size_t)HALF * g.ldb * 2;
    const size_t tsA = 2 * hsA, tsB = 2 * hsB;
    const unsigned ldsw = (unsigned)wid * 1024u;
    const int aoff = lds_byte(wr * 64 + fr, fq * 8), boff = lds_byte(wc * 32 + fr, fq * 8);
#define PG8_SA(b, h) (((b) * 2 + (h)) * HTB)
#define PG8_SB(b, h) ((4 + (b) * 2 + (h)) * HTB)
#define PG8_STAGE(bufoff, gbase, voff) do { const char* gb_ = (const char*)(gbase); asm volatile("" : "+s"(gb_)); _Pragma("unroll") for (int _i = 0; _i < 2; ++_i) { unsigned vo_ = (voff)[_i]; asm volatile("" : "+v"(vo_)); \
        __builtin_amdgcn_global_load_lds((const unsigned*)(gb_ + vo_), (LAS unsigned*)(lds + (bufoff) + ldsw + _i * 8192), 16, 0, 0); } } while (0)
#define PG8_LDA(dst, b, h) do { _Pragma("unroll") for (int m = 0; m < 4; ++m) _Pragma("unroll") for (int k = 0; k < 2; ++k) dst[m][k] = *(const LAS bf16x8*)(lds + PG8_SA(b, h) + aoff + m * 2048 + k * 1024); } while (0)
#define PG8_LDB(dst, b, h) do { _Pragma("unroll") for (int n = 0; n < 2; ++n) _Pragma("unroll") for (int k = 0; k < 2; ++k) dst[n][k] = *(const LAS bf16x8*)(lds + PG8_SB(b, h) + boff + n * 2048 + k * 1024); } while (0)
#define PG8_MMA(ai, bj, At, Bt) do { __builtin_amdgcn_s_setprio(1); _Pragma("unroll") for (int m = 0; m < 4; ++m) _Pragma("unroll") for (int n = 0; n < 2; ++n) _Pragma("unroll") for (int k = 0; k < 2; ++k) \
        acc[ai][bj][m][n] = __builtin_amdgcn_mfma_f32_16x16x32_bf16(Bt[n][k], At[m][k], acc[ai][bj][m][n], 0, 0, 0); __builtin_amdgcn_s_setprio(0); } while (0)
#define PG8_WAIT_V(n) asm volatile("s_waitcnt vmcnt(" #n ")" ::: "memory")
#define PG8_WAIT_L(n) asm volatile("s_waitcnt lgkmcnt(" #n ")" ::: "memory")
#define PG8_BAR __builtin_amdgcn_s_barrier()
#define PG8_SCHED __builtin_amdgcn_sched_barrier(0)
    Unit cur, nxt; int ui = 0;
    if (!S.next(0, cur)) return;
    f32x4 acc[2][2][4][2];
#pragma unroll
    for (int a = 0; a < 2; ++a)
#pragma unroll
        for (int b = 0; b < 2; ++b)
#pragma unroll
            for (int m = 0; m < 4; ++m)
#pragma unroll
                for (int n = 0; n < 2; ++n) acc[a][b][m][n] = (f32x4){0.f, 0.f, 0.f, 0.f};
    bf16x8 At[4][2], B0[2][2], B1[2][2];
    const char* cA = (const char*)g.A + (size_t)cur.pm * tsA; const char* cB = (const char*)g.Bt + (size_t)cur.pn * tsB;
    PG8_STAGE(PG8_SB(0, 0), cB, voffB); PG8_STAGE(PG8_SB(0, 1), cB + hsB, voffB); PG8_STAGE(PG8_SA(0, 0), cA, voffA); PG8_STAGE(PG8_SA(0, 1), cA + hsA, voffA);
    if (wr == 1) PG8_BAR;
    PG8_WAIT_V(2); PG8_BAR;
    PG8_STAGE(PG8_SB(1, 0), cB + kstep, voffB); PG8_STAGE(PG8_SA(1, 0), cA + kstep, voffA); PG8_STAGE(PG8_SB(1, 1), cB + hsB + kstep, voffB);
    PG8_WAIT_V(6); PG8_BAR;
    for (;;) {
        const bool has_next = S.next(ui + 1, nxt);
        const char* nA = has_next ? (const char*)g.A + (size_t)nxt.pm * tsA : cA; const char* nB = has_next ? (const char*)g.Bt + (size_t)nxt.pn * tsB : cB;
        for (int t = 0; t < nt; t += 2) {
            const bool last = (t == nt - 2);
            const char* a1 = cA + (size_t)(t + 1) * kstep;
            const char* a2 = last ? nA : cA + (size_t)(t + 2) * kstep; const char* b2 = last ? nB : cB + (size_t)(t + 2) * kstep;
            const char* a3 = a2 + kstep; const char* b3 = b2 + kstep;
            PG8_LDB(B0, 0, 0); PG8_LDB(B1, 0, 1); PG8_SCHED; PG8_LDA(At, 0, 0); PG8_STAGE(PG8_SA(1, 1), a1 + hsA, voffA);
            PG8_WAIT_V(8); PG8_WAIT_L(0); PG8_BAR; PG8_MMA(0, 0, At, B0); PG8_MMA(0, 1, At, B1); PG8_BAR; PG8_SCHED;
            PG8_LDA(At, 0, 1); PG8_STAGE(PG8_SB(0, 0), b2, voffB); PG8_STAGE(PG8_SB(0, 1), b2 + hsB, voffB); PG8_STAGE(PG8_SA(0, 0), a2, voffA);
            PG8_WAIT_V(8); PG8_WAIT_L(0); PG8_BAR; PG8_MMA(1, 0, At, B0); PG8_MMA(1, 1, At, B1); PG8_BAR; PG8_SCHED;
            PG8_LDB(B0, 1, 0); PG8_LDB(B1, 1, 1); PG8_SCHED; PG8_LDA(At, 1, 0); PG8_STAGE(PG8_SA(0, 1), a2 + hsA, voffA);
            PG8_WAIT_V(8); PG8_WAIT_L(0); PG8_BAR; PG8_MMA(0, 0, At, B0); PG8_MMA(0, 1, At, B1); PG8_BAR; PG8_SCHED;
            PG8_LDA(At, 1, 1); PG8_STAGE(PG8_SB(1, 0), b3, voffB); PG8_STAGE(PG8_SB(1, 1), b3 + hsB, voffB); PG8_STAGE(PG8_SA(1, 0), a3, voffA);
            PG8_WAIT_V(8); PG8_WAIT_L(0); PG8_BAR; PG8_MMA(1, 0, At, B0); PG8_MMA(1, 1, At, B1); PG8_BAR; PG8_SCHED;
        }
        if (wr == 0) PG8_BAR;
        { const int ln_ = olane(); E(acc, cur, wr, wc, ln_ & 15, ln_ >> 4); }
        if (!has_next) break;
#pragma unroll
        for (int a = 0; a < 2; ++a)
#pragma unroll
            for (int b = 0; b < 2; ++b)
#pragma unroll
                for (int m = 0; m < 4; ++m)
#pragma unroll
                    for (int n = 0; n < 2; ++n) acc[a][b][m][n] = (f32x4){0.f, 0.f, 0.f, 0.f};
        cur = nxt; cA = nA; cB = nB; ++ui;
        if (wr == 1) PG8_BAR;
    }
    PG8_WAIT_V(0);
    PG8_BAR;
#undef PG8_SA
#undef PG8_SB
#undef PG8_STAGE
#undef PG8_LDA
#undef PG8_LDB
#undef PG8_MMA
#undef PG8_WAIT_V
#undef PG8_WAIT_L
#undef PG8_BAR
#undef PG8_SCHED
}
}
typedef const f32x4 (&AccRef)[2][2][4][2];

DI float row_rstd16(const float* P, int row) {
    const f32x4* p = (const f32x4*)(P + (size_t)row * 16);
    const float s = (sum4(p[0]) + sum4(p[1])) + (sum4(p[2]) + sum4(p[3]));
    return rsqrtf(s * (1.0f / 1024.0f) + EPS);
}
DI float row_ssq_q(const float* Pq, int stride, int nq, int row, int fq) {
    float s = 0.f;
    if (fq < nq) s = sum4(*(const f32x4*)(Pq + (size_t)row * stride + 4 * fq));
    s += __shfl_xor(s, 16); s += __shfl_xor(s, 32);
    return s;
}
DI u32x4 pk16(f32x4 v0, f32x4 v1) { u32x4 w; w.x = cvt_pk(v0[0], v0[1]); w.y = cvt_pk(v0[2], v0[3]); w.z = cvt_pk(v1[0], v1[1]); w.w = cvt_pk(v1[2], v1[3]); return w; }
DI u32x2 pk8(f32x4 v) { u32x2 w; w.x = cvt_pk(v[0], v[1]); w.y = cvt_pk(v[2], v[3]); return w; }

struct EpiA { static constexpr bool PERM = true;
    const float* P; bf16_t* zA; bf16_t* zB; bf16_t* zC; float* PA;
    DI void operator()(AccRef acc, const pg8::Unit& u, int wr, int wc, int fr, int fq) const {
        const int pn = u.pn; bf16_t* base; int ld, colt;
        if (pn < 3) { base = zA; ld = 768; colt = pn * 256; } else if (pn < 11) { base = zB; ld = 2048; colt = (pn - 3) * 256; } else { base = zC; ld = 1024; colt = (pn - 11) * 256; }
        const int row0 = u.pm * 256 + wr * 64 + fr, col0 = colt + wc * 32 + 8 * fq;
float rsv[2][4];
#pragma unroll
        for (int ai = 0; ai < 2; ++ai)
#pragma unroll
            for (int m = 0; m < 4; ++m) rsv[ai][m] = rsqrtf(row_ssq_q(P, 16, 4, row0 + ai * 128 + m * 16, fq) * (1.0f / 1024.0f) + EPS);
#pragma unroll
        for (int ai = 0; ai < 2; ++ai)
#pragma unroll
            for (int m = 0; m < 4; ++m) { const int row = row0 + ai * 128 + m * 16; const float rs = rsv[ai][m];
#pragma unroll
                for (int bj = 0; bj < 2; ++bj) { const f32x4 v0 = acc[ai][bj][m][0] * rs, v1 = acc[ai][bj][m][1] * rs;
                    if (pn < 3) { float s = dot4(v0) + dot4(v1); s += __shfl_xor(s, 16); s += __shfl_xor(s, 32); if (fq == 0) PA[(size_t)row * 32 + pn * 8 + bj * 4 + wc] = s; }
                    *(u32x4*)(base + (size_t)row * ld + col0 + bj * 128) = pk16(v0, v1); } }
    }
};
template <bool SIG> struct EpiPlain { static constexpr bool PERM = true;
    const float* P; bf16_t* O; int ldo; float scale;
    DI void operator()(AccRef acc, const pg8::Unit& u, int wr, int wc, int fr, int fq) const {
        const int row0 = u.pm * 256 + wr * 64 + fr, col0 = u.pn * 256 + wc * 32 + 8 * fq;
float rsv[2][4];
#pragma unroll
        for (int ai = 0; ai < 2; ++ai)
#pragma unroll
            for (int m = 0; m < 4; ++m) rsv[ai][m] = rsqrtf(row_ssq_q(P, 16, 4, row0 + ai * 128 + m * 16, fq) * (1.0f / 1024.0f) + EPS) * scale;
#pragma unroll
        for (int ai = 0; ai < 2; ++ai)
#pragma unroll
            for (int m = 0; m < 4; ++m) { const int row = row0 + ai * 128 + m * 16; const float rs = rsv[ai][m];
#pragma unroll
                for (int bj = 0; bj < 2; ++bj) { f32x4 v0 = acc[ai][bj][m][0] * rs, v1 = acc[ai][bj][m][1] * rs;
                    if (SIG) {
#pragma unroll
                        for (int e = 0; e < 4; ++e) { v0[e] = sigm(v0[e]); v1[e] = sigm(v1[e]); } }
                    *(u32x4*)(O + (size_t)row * ldo + col0 + bj * 128) = pk16(v0, v1); } }
    }
};
struct EpiQ { static constexpr bool PERM = false;
    const float* PA; const float* CS; bf16_t* Q;
    DI void operator()(AccRef acc, const pg8::Unit& u, int wr, int wc, int fr, int fq) const {
        const int row0 = u.pm * 256 + wr * 64 + fr;
float rsv[2][4];
#pragma unroll
        for (int ai = 0; ai < 2; ++ai)
#pragma unroll
            for (int m = 0; m < 4; ++m) rsv[ai][m] = rsqrtf(row_ssq_q(PA, 32, 3, row0 + ai * 128 + m * 16, fq) * (1.0f / 384.0f) + EPS);
#pragma unroll
        for (int ai = 0; ai < 2; ++ai)
#pragma unroll
            for (int m = 0; m < 4; ++m) { const int row = row0 + ai * 128 + m * 16;
                const float rs = rsv[ai][m];
                const f32x4 cs = *(const f32x4*)(CS + (size_t)row * 32 + 4 * fq), sn = *(const f32x4*)(CS + (size_t)row * 32 + 16 + 4 * fq);
#pragma unroll
                for (int bj = 0; bj < 2; ++bj) { const int g32 = u.pn * 8 + bj * 4 + wc;
                    f32x4 v0 = acc[ai][bj][m][0] * rs, v1 = acc[ai][bj][m][1] * rs;
                    if ((g32 % 3) == 2) { const f32x4 y0 = v0 * cs - v1 * sn, y1 = v0 * sn + v1 * cs; v0 = y0; v1 = y1; }
                    v0 = v0 * QSC; v1 = v1 * QSC;
                    bf16_t* o = Q + (size_t)row * 768 + u.pn * 256 + bj * 128 + wc * 32 + 4 * fq;
                    *(u32x2*)(o) = pk8(v0); *(u32x2*)(o + 16) = pk8(v1); } }
    }
};
struct EpiKV { static constexpr bool PERM = true;
    const float* PA; bf16_t* Kn; bf16_t* Vt;
    DI void operator()(AccRef acc, const pg8::Unit& u, int wr, int wc, int fr, int fq) const {
        const int row0 = u.pm * 256 + wr * 64 + fr;
float rsv[2][4];
#pragma unroll
        for (int ai = 0; ai < 2; ++ai)
#pragma unroll
            for (int m = 0; m < 4; ++m) rsv[ai][m] = rsqrtf(row_ssq_q(PA + 12, 32, 2, row0 + ai * 128 + m * 16, fq) * (1.0f / 256.0f) + EPS);
#pragma unroll
        for (int ai = 0; ai < 2; ++ai)
#pragma unroll
            for (int m = 0; m < 4; ++m) { const int row = row0 + ai * 128 + m * 16;
                const float rs = rsv[ai][m];
                const int b = row / SEQ, tok = row % SEQ;
#pragma unroll
                for (int bj = 0; bj < 2; ++bj) { const int h = 2 * u.pn + bj;
                    const f32x4 v0 = acc[ai][bj][m][0] * rs, v1 = acc[ai][bj][m][1] * rs;
                    if (wc < 2) { *(u32x4*)(Kn + (size_t)row * 512 + h * 64 + wc * 32 + 8 * fq) = pk16(v0, v1); }
                    else { bf16_t* vp = Vt + ((size_t)(b * 8 + h) * 64 + (wc - 2) * 32 + 8 * fq) * SEQ + tok;
#pragma unroll
                        for (int e = 0; e < 4; ++e) { vp[(size_t)e * SEQ] = f2bf(v0[e]); vp[(size_t)(4 + e) * SEQ] = f2bf(v1[e]); } } } }
    }
};
struct EpiBr { static constexpr bool PERM = true;
    const bf16_t* G; bf16_t* MX; int j;
    DI void operator()(AccRef acc, const pg8::Unit& u, int wr, int wc, int fr, int fq) const {
        const int row0 = u.pm * 256 + wr * 64 + fr, col0 = u.pn * 256 + wc * 32 + 8 * fq;
#pragma unroll
        for (int ai = 0; ai < 2; ++ai)
#pragma unroll
            for (int m = 0; m < 4; ++m) { const int row = row0 + ai * 128 + m * 16;
#pragma unroll
                for (int bj = 0; bj < 2; ++bj) { const int col = col0 + bj * 128;
                    const u32x4 gw = *(const u32x4*)(G + (size_t)row * 3072 + j * 1024 + col);
                    f32x4 v0 = acc[ai][bj][m][0], v1 = acc[ai][bj][m][1];
                    v0[0] *= bflo(gw.x); v0[1] *= bfhi(gw.x); v0[2] *= bflo(gw.y); v0[3] *= bfhi(gw.y);
                    v1[0] *= bflo(gw.z); v1[1] *= bfhi(gw.z); v1[2] *= bflo(gw.w); v1[3] *= bfhi(gw.w);
                    bf16_t* mp = MX + (size_t)row * 1024 + col;
                    if (j > 0) { const u32x4 ow = *(const u32x4*)mp;
                        v0[0] += bflo(ow.x); v0[1] += bfhi(ow.x); v0[2] += bflo(ow.y); v0[3] += bfhi(ow.y);
                        v1[0] += bflo(ow.z); v1[1] += bfhi(ow.z); v1[2] += bflo(ow.w); v1[3] += bfhi(ow.w); }
                    *(u32x4*)mp = pk16(v0, v1); } }
    }
};
struct EpiRes { static constexpr bool PERM = false;
    const float* xin; float* xout; bf16_t* xb; float* P;
    DI void operator()(AccRef acc, const pg8::Unit& u, int wr, int wc, int fr, int fq) const {
        const int row0 = u.pm * 256 + wr * 64 + fr, col0 = u.pn * 256 + wc * 32 + 4 * fq;
#pragma unroll
        for (int ai = 0; ai < 2; ++ai)
#pragma unroll
            for (int m = 0; m < 4; ++m) { const int row = row0 + ai * 128 + m * 16; float s = 0.f;
#pragma unroll
                for (int bj = 0; bj < 2; ++bj)
#pragma unroll
                    for (int n = 0; n < 2; ++n) { const size_t off = (size_t)row * 1024 + col0 + bj * 128 + n * 16;
                        const f32x4 xo = *(const f32x4*)(xin + off) + acc[ai][bj][m][n];
                        *(f32x4*)(xout + off) = xo; *(u32x2*)(xb + off) = pk8(xo); s += dot4(xo); }
                s += __shfl_xor(s, 16); s += __shfl_xor(s, 32);
                if (fq == 0) P[(size_t)row * 16 + u.pn * 4 + wc] = s; }
    }
};
struct EpiKVm { static constexpr bool PERM = true;
    const float* mrstd; bf16_t* Km; bf16_t* Vmt;
    DI void operator()(AccRef acc, const pg8::Unit& u, int wr, int wc, int fr, int fq) const {
        const int row0 = u.pm * 256 + wr * 64 + fr;
#pragma unroll
        for (int ai = 0; ai < 2; ++ai)
#pragma unroll
            for (int m = 0; m < 4; ++m) { const int row = row0 + ai * 128 + m * 16; const float rs = mrstd[row];
                const int b = row >> 8, key = row & 255;
#pragma unroll
                for (int bj = 0; bj < 2; ++bj) { const f32x4 v0 = acc[ai][bj][m][0] * rs, v1 = acc[ai][bj][m][1] * rs;
                    const int c = u.pn * 256 + bj * 128 + wc * 32 + 8 * fq;
                    if (u.pn < 4) { *(u32x4*)(Km + (size_t)row * 1024 + c) = pk16(v0, v1); }
                    else { const int c2 = c - 1024, h = c2 >> 8, dv = c2 & 255;
                        bf16_t* vp = Vmt + ((size_t)(b * 4 + h) * 256 + dv) * 256 + key;
#pragma unroll
                        for (int e = 0; e < 4; ++e) { vp[e * 256] = f2bf(v0[e]); vp[(4 + e) * 256] = f2bf(v1[e]); } } } }
    }
};
struct EpiFF { static constexpr bool PERM = false;
    const float* P; bf16_t* ACT;
    DI void operator()(AccRef acc, const pg8::Unit& u, int wr, int wc, int fr, int fq) const {
        const int row0 = u.pm * 256 + wr * 64 + fr;
float rsv[2][4];
#pragma unroll
        for (int ai = 0; ai < 2; ++ai)
#pragma unroll
            for (int m = 0; m < 4; ++m) rsv[ai][m] = rsqrtf(row_ssq_q(P, 16, 4, row0 + ai * 128 + m * 16, fq) * (1.0f / 1024.0f) + EPS);
#pragma unroll
        for (int ai = 0; ai < 2; ++ai)
#pragma unroll
            for (int m = 0; m < 4; ++m) { const int row = row0 + ai * 128 + m * 16; const float rs = rsv[ai][m];
#pragma unroll
                for (int bj = 0; bj < 2; ++bj) { const int G = u.pn * 8 + bj * 4 + wc;
                    const f32x4 gt = acc[ai][bj][m][0] * rs, up = acc[ai][bj][m][1] * rs; f32x4 a;
#pragma unroll
                    for (int e = 0; e < 4; ++e) a[e] = gt[e] * sigm(gt[e]) * up[e];
                    *(u32x2*)(ACT + (size_t)row * DFF + 16 * G + 4 * fq) = pk8(a); } }
    }
};

DI int srccol(int mode, int np) {
    if (mode == 1) return np < 672 ? np : (np < 768 ? -1 : np - 96);
    if (mode == 2) { const int G = np >> 5, s = (np >> 4) & 1, j = np & 15; return s * DFF + 16 * G + j; }
    return np;
}
DI void conv_item(const float* W, int K, int N, int Np, int mode, const float* gain, bf16_t* WT, LAS float* scr, int item, int lane) {
    const int nblk = Np / 64, kb = item / nblk, nb = item % nblk, k0 = 64 * kb, n0 = 64 * nb;
    const int r = lane >> 4, c4 = (lane & 15) * 4;
    const int sc = srccol(mode, n0 + c4);
    f32x4 v[16];
#pragma unroll
    for (int i = 0; i < 16; ++i) v[i] = (sc >= 0) ? *(const f32x4*)(W + (size_t)(k0 + 4 * i + r) * N + sc) : (f32x4){0.f, 0.f, 0.f, 0.f};
#pragma unroll
    for (int i = 0; i < 16; ++i) { const int row = 4 * i + r; const float gn = gain ? gain[k0 + row] : 1.0f; LAS float* d = scr + row * 65 + c4;
        d[0] = v[i][0] * gn; d[1] = v[i][1] * gn; d[2] = v[i][2] * gn; d[3] = v[i][3] * gn; }
    asm volatile("s_waitcnt lgkmcnt(0)" ::: "memory");
    const int c = lane & 7;
#pragma unroll
    for (int jj = 0; jj < 8; ++jj) { const int n = (lane >> 3) + 8 * jj; const LAS float* sp = scr + (8 * c) * 65 + n;
        u32x4 o; o.x = cvt_pk(sp[0 * 65], sp[1 * 65]); o.y = cvt_pk(sp[2 * 65], sp[3 * 65]); o.z = cvt_pk(sp[4 * 65], sp[5 * 65]); o.w = cvt_pk(sp[6 * 65], sp[7 * 65]);
        *(u32x4*)(WT + (size_t)(n0 + n) * K + k0 + 8 * c) = o; }
    asm volatile("s_waitcnt lgkmcnt(0)" ::: "memory");
}

DI void attn_unit(LAS unsigned char* lds, const bf16_t* Q, const bf16_t* Kn, const bf16_t* Kr, const bf16_t* Vt, bf16_t* Oa, int b, int h, int qb, int wv) {
    const int tid = otid(wv), lane = tid & 63, w = wv, l32 = lane & 31, hi = lane >> 5;
    constexpr int KST = 208, VST = 264, KBUF = 128 * KST, VBUF = 64 * VST, VOFF = 2 * KBUF;
    const size_t rowb = (size_t)b * SEQ;
    const int qrow = qb * 256 + 32 * w + l32;
    bf16x8 qf[6];
#pragma unroll
    for (int ks = 0; ks < 6; ++ks) qf[ks] = *(const bf16x8*)(Q + (rowb + qrow) * 768 + h * 96 + 16 * ks + 8 * hi);
    f32x16 o0, o1;
#pragma unroll
    for (int r = 0; r < 16; ++r) { o0[r] = 0.f; o1[r] = 0.f; }
    float mrun = -INFINITY, lrun = 0.f;
    const int NT = 2 * qb + 2, tlast = 2 * qb + (w >> 2);
    const int kkey = tid >> 3, kch = tid & 7, rkey = tid >> 2, rch = tid & 3, vdv = tid >> 4, vch = tid & 15;
    const bf16_t* gK = Kn + (rowb + kkey) * 512 + h * 64 + kch * 8;
    const bf16_t* gR = Kr + (rowb + rkey) * 32 + rch * 8;
    const bf16_t* gV = Vt + ((size_t)(b * 8 + h) * 64 + vdv) * SEQ + vch * 8;
    u32x4 rk0, rk1, rr, rv0, rv1;
#define ATT_LOAD(t) do { rk0 = *(const u32x4*)(gK + (size_t)(t) * 128 * 512); rk1 = *(const u32x4*)(gK + (size_t)(t) * 128 * 512 + 64 * 512); \
        rr = *(const u32x4*)(gR + (size_t)(t) * 128 * 32); rv0 = *(const u32x4*)(gV + (size_t)(t) * 128); rv1 = *(const u32x4*)(gV + (size_t)(t) * 128 + (size_t)32 * SEQ); } while (0)
#define ATT_STORE(kd, vd) do { *(LAS u32x4*)((kd) + kkey * KST + kch * 16) = rk0; *(LAS u32x4*)((kd) + (64 + kkey) * KST + kch * 16) = rk1; \
        *(LAS u32x4*)((kd) + rkey * KST + 128 + rch * 16) = rr; \
        *(LAS u32x2*)((vd) + vdv * VST + vch * 16) = (u32x2){rv0.x, rv0.y}; *(LAS u32x2*)((vd) + vdv * VST + vch * 16 + 8) = (u32x2){rv0.z, rv0.w}; \
        *(LAS u32x2*)((vd) + (32 + vdv) * VST + vch * 16) = (u32x2){rv1.x, rv1.y}; *(LAS u32x2*)((vd) + (32 + vdv) * VST + vch * 16 + 8) = (u32x2){rv1.z, rv1.w}; } while (0)
    ATT_LOAD(0);
    ATT_STORE(lds, lds + VOFF);
    __syncthreads();
#pragma unroll
    for (int ks = 0; ks < 6; ++ks) asm volatile("" : "+v"(qf[ks]));
    for (int t = 0; t < NT; ++t) {
        const int cur = t & 1;
        if (t + 1 < NT) ATT_LOAD(t + 1);
        if (t <= tlast) {
            const LAS unsigned char* kb_ = lds + cur * KBUF;
            const LAS unsigned char* vb_ = lds + VOFF + cur * VBUF;
            f32x16 s[4];
#pragma unroll
            for (int kb = 0; kb < 4; ++kb)
#pragma unroll
                for (int r = 0; r < 16; ++r) s[kb][r] = 0.f;
#pragma unroll
            for (int ks = 0; ks < 6; ++ks)
#pragma unroll
                for (int kb = 0; kb < 4; ++kb) {
                    const bf16x8 a = *(const LAS bf16x8*)(kb_ + (32 * kb + l32) * KST + (16 * ks + 8 * hi) * 2);
                    s[kb] = MFMA32(a, qf[ks], s[kb]);
                }
            if (t == tlast) {
#pragma unroll
                for (int kb = 0; kb < 4; ++kb)
#pragma unroll
                    for (int r = 0; r < 16; ++r) { const int key = 128 * t + 32 * kb + crow(r, hi); if (key > qrow) s[kb][r] = -INFINITY; }
            }
            float mx = fmaxf(fmaxf(s[0][0], s[1][0]), fmaxf(s[2][0], s[3][0]));
#pragma unroll
            for (int r = 1; r < 16; ++r) mx = fmaxf(mx, fmaxf(fmaxf(s[0][r], s[1][r]), fmaxf(s[2][r], s[3][r])));
            mx = fmaxf(mx, __shfl_xor(mx, 32));
            const float mnew = fmaxf(mrun, mx);
            if (__builtin_amdgcn_ballot_w64(mnew > mrun) != 0ull) {
                const float alpha = __builtin_amdgcn_exp2f(mrun - mnew);
                mrun = mnew; lrun *= alpha;
#pragma unroll
                for (int r = 0; r < 16; ++r) { o0[r] *= alpha; o1[r] *= alpha; }
            }
            float ps = 0.f;
#pragma unroll
            for (int kb = 0; kb < 4; ++kb)
#pragma unroll
                for (int r = 0; r < 16; ++r) { s[kb][r] = __builtin_amdgcn_exp2f(s[kb][r] - mrun); ps += s[kb][r]; }
            lrun += ps;
#pragma unroll
            for (int kb = 0; kb < 4; ++kb)
#pragma unroll
                for (int sub = 0; sub < 2; ++sub) {
                    const bf16x8 P = pack8(s[kb][8 * sub + 0], s[kb][8 * sub + 1], s[kb][8 * sub + 2], s[kb][8 * sub + 3], s[kb][8 * sub + 4], s[kb][8 * sub + 5], s[kb][8 * sub + 6], s[kb][8 * sub + 7]);
                    const int koff = (32 * kb + 16 * sub + 4 * hi) * 2;
                    const u32x2 a0l = *(const LAS u32x2*)(vb_ + l32 * VST + koff), a0h = *(const LAS u32x2*)(vb_ + l32 * VST + koff + 16);
                    const u32x2 a1l = *(const LAS u32x2*)(vb_ + (32 + l32) * VST + koff), a1h = *(const LAS u32x2*)(vb_ + (32 + l32) * VST + koff + 16);
                    o0 = MFMA32(mk8(a0l, a0h), P, o0); o1 = MFMA32(mk8(a1l, a1h), P, o1);
                }
        }
        if (t + 1 < NT) ATT_STORE(lds + (cur ^ 1) * KBUF, lds + VOFF + (cur ^ 1) * VBUF);
        __syncthreads();
    }
#undef ATT_LOAD
#undef ATT_STORE
    const float lt = lrun + __shfl_xor(lrun, 32);
    const float inv = 1.0f / lt;
    bf16_t* op = Oa + (rowb + qrow) * 512 + h * 64;
#pragma unroll
    for (int g = 0; g < 4; ++g) {
        u32x2 w0, w1;
        w0.x = cvt_pk(o0[4 * g] * inv, o0[4 * g + 1] * inv); w0.y = cvt_pk(o0[4 * g + 2] * inv, o0[4 * g + 3] * inv);
        w1.x = cvt_pk(o1[4 * g] * inv, o1[4 * g + 1] * inv); w1.y = cvt_pk(o1[4 * g + 2] * inv, o1[4 * g + 3] * inv);
        *(u32x2*)(op + 8 * g + 4 * hi) = w0; *(u32x2*)(op + 32 + 8 * g + 4 * hi) = w1;
    }
}

DI void xattn_unit(LAS unsigned char* lds, bf16_t* QX, const bf16_t* Km, const bf16_t* Vmt, int b, int h, int qb, int wv) {
    const int tid = otid(wv), lane = tid & 63, w = __builtin_amdgcn_readfirstlane(tid >> 6), l32 = lane & 31, hi = lane >> 5;
    constexpr int KST = 272, VST = 520, BUF = 64 * VST;
    const size_t row = (size_t)b * SEQ + qb * 256 + 32 * w + l32;
    bf16_t* qp = QX + row * 1024 + h * 256;
    f32x16 sacc[8];
#pragma unroll
    for (int i = 0; i < 8; ++i)
#pragma unroll
        for (int r = 0; r < 16; ++r) sacc[i][r] = 0.f;
    unsigned pp[8][8];
    bf16x8 qf[8];
    u32x4 pf[4];
#define XLOAD(i) do { if ((i) < 8) { const int dh_ = (i) >> 2, kt_ = (i) & 3; \
        _Pragma("unroll") for (int j = 0; j < 2; ++j) { const int id = tid + 512 * j, key = id >> 4, ch = id & 15; \
            pf[j] = *(const u32x4*)(Km + ((size_t)(b * 256 + 64 * kt_ + key)) * 1024 + h * 256 + 128 * dh_ + 8 * ch); } } \
      else { const int c_ = (i) - 8; \
        _Pragma("unroll") for (int j = 0; j < 4; ++j) { const int id = tid + 512 * j, dv = id >> 5, ch = id & 31; \
            pf[j] = *(const u32x4*)(Vmt + ((size_t)((b * 4 + h) * 256 + 64 * c_ + dv)) * 256 + 8 * ch); } } } while (0)
#define XSTORE(i, bufp) do { if ((i) < 8) { \
        _Pragma("unroll") for (int j = 0; j < 2; ++j) { const int id = tid + 512 * j, key = id >> 4, ch = id & 15; *(LAS u32x4*)((bufp) + key * KST + ch * 16) = pf[j]; } } \
      else { \
        _Pragma("unroll") for (int j = 0; j < 4; ++j) { const int id = tid + 512 * j, dv = id >> 5, ch = id & 31; \
            *(LAS u32x2*)((bufp) + dv * VST + ch * 16) = (u32x2){pf[j].x, pf[j].y}; *(LAS u32x2*)((bufp) + dv * VST + ch * 16 + 8) = (u32x2){pf[j].z, pf[j].w}; } } } while (0)
    XLOAD(0); XSTORE(0, lds);
    __syncthreads();
#pragma unroll
    for (int i = 0; i < 12; ++i) {
        const LAS unsigned char* cb_ = lds + (i & 1) * BUF;
        if (i + 1 < 12) XLOAD(i + 1);
        if (i < 8) {
            const int dh = i >> 2, kt = i & 3;
            if (kt == 0) {
#pragma unroll
                for (int ks = 0; ks < 8; ++ks) qf[ks] = *(const bf16x8*)(qp + 128 * dh + 16 * ks + 8 * hi);
            }
#pragma unroll
            for (int ks = 0; ks < 8; ++ks) {
                const bf16x8 a0 = *(const LAS bf16x8*)(cb_ + l32 * KST + (16 * ks + 8 * hi) * 2);
                const bf16x8 a1 = *(const LAS bf16x8*)(cb_ + (32 + l32) * KST + (16 * ks + 8 * hi) * 2);
                sacc[2 * kt] = MFMA32(a0, qf[ks], sacc[2 * kt]); sacc[2 * kt + 1] = MFMA32(a1, qf[ks], sacc[2 * kt + 1]);
            }
            if (i == 7) {
                float mx = sacc[0][0];
#pragma unroll
                for (int j = 0; j < 8; ++j)
#pragma unroll
                    for (int r = 0; r < 16; ++r) mx = fmaxf(mx, sacc[j][r]);
                mx = fmaxf(mx, __shfl_xor(mx, 32));
                float ps = 0.f;
#pragma unroll
                for (int j = 0; j < 8; ++j)
#pragma unroll
                    for (int r = 0; r < 16; ++r) { sacc[j][r] = __builtin_amdgcn_exp2f(sacc[j][r] - mx); ps += sacc[j][r]; }
                ps += __shfl_xor(ps, 32);
                const float inv = 1.0f / ps;
#pragma unroll
                for (int j = 0; j < 8; ++j)
#pragma unroll
                    for (int r2 = 0; r2 < 8; ++r2) pp[j][r2] = cvt_pk(sacc[j][2 * r2] * inv, sacc[j][2 * r2 + 1] * inv);
            }
        } else {
            const int c = i - 8;
            f32x16 o0, o1;
#pragma unroll
            for (int r = 0; r < 16; ++r) { o0[r] = 0.f; o1[r] = 0.f; }
#pragma unroll
            for (int s = 0; s < 16; ++s) {
                const int kb = s >> 1, sub = s & 1;
                const u32x4 pw = {pp[kb][4 * sub], pp[kb][4 * sub + 1], pp[kb][4 * sub + 2], pp[kb][4 * sub + 3]};
                const bf16x8 P = __builtin_bit_cast(bf16x8, pw);
                const int koff = (32 * kb + 16 * sub + 4 * hi) * 2;
                const u32x2 a0l = *(const LAS u32x2*)(cb_ + l32 * VST + koff), a0h = *(const LAS u32x2*)(cb_ + l32 * VST + koff + 16);
                const u32x2 a1l = *(const LAS u32x2*)(cb_ + (32 + l32) * VST + koff), a1h = *(const LAS u32x2*)(cb_ + (32 + l32) * VST + koff + 16);
                o0 = MFMA32(mk8(a0l, a0h), P, o0); o1 = MFMA32(mk8(a1l, a1h), P, o1);
            }
#pragma unroll
            for (int g = 0; g < 4; ++g) {
                u32x2 w0, w1;
                w0.x = cvt_pk(o0[4 * g], o0[4 * g + 1]); w0.y = cvt_pk(o0[4 * g + 2], o0[4 * g + 3]);
                w1.x = cvt_pk(o1[4 * g], o1[4 * g + 1]); w1.y = cvt_pk(o1[4 * g + 2], o1[4 * g + 3]);
                *(u32x2*)(qp + 64 * c + 8 * g + 4 * hi) = w0; *(u32x2*)(qp + 64 * c + 32 + 8 * g + 4 * hi) = w1;
            }
        }
        if (i + 1 < 12) XSTORE(i + 1, lds + ((i + 1) & 1) * BUF);
        __syncthreads();
    }
#undef XLOAD
#undef XSTORE
}

DI void memkv_tile(LAS unsigned char* lds, const bf16_t* memb, const bf16_t* Wt, const float* mrstd, bf16_t* Km, bf16_t* Vmt, int tile, int wv) {
    const int tid = otid(wv), lane = tid & 63, w = wv, l32 = lane & 31, hi = lane >> 5;
    const int r0 = (tile >> 5) * 64, c0 = (tile & 31) * 64;
    f32x16 acc[2][2];
#pragma unroll
    for (int i = 0; i < 2; ++i)
#pragma unroll
        for (int j = 0; j < 2; ++j)
#pragma unroll
            for (int r = 0; r < 16; ++r) acc[i][j][r] = 0.f;
    const bf16_t* ap = memb + (size_t)(r0 + l32) * 1024 + 128 * w + 8 * hi;
    const bf16_t* bp = Wt + (size_t)(c0 + l32) * 1024 + 128 * w + 8 * hi;
#pragma unroll
    for (int ks = 0; ks < 8; ++ks) {
        const bf16x8 a0 = *(const bf16x8*)(ap + 16 * ks), a1 = *(const bf16x8*)(ap + 32 * 1024 + 16 * ks);
        const bf16x8 b0 = *(const bf16x8*)(bp + 16 * ks), b1 = *(const bf16x8*)(bp + 32 * 1024 + 16 * ks);
        acc[0][0] = MFMA32(b0, a0, acc[0][0]); acc[0][1] = MFMA32(b1, a0, acc[0][1]);
        acc[1][0] = MFMA32(b0, a1, acc[1][0]); acc[1][1] = MFMA32(b1, a1, acc[1][1]);
    }
    LAS float* red = (LAS float*)lds;
#pragma unroll
    for (int i = 0; i < 2; ++i)
#pragma unroll
        for (int j = 0; j < 2; ++j)
#pragma unroll
            for (int r = 0; r < 16; ++r) red[((w * 4 + i * 2 + j) * 16 + r) * 64 + lane] = acc[i][j][r];
    LBAR();
#pragma unroll
    for (int q = 0; q < 8; ++q) {
        const int idx = tid + 512 * q, ln = idx & 63, r = (idx >> 6) & 15, blk = idx >> 10;
        float s = 0.f;
#pragma unroll
        for (int ww = 0; ww < 8; ++ww) s += red[ww * 4096 + idx];
        const int i = blk >> 1, j = blk & 1;
        const int col = c0 + 32 * j + crow(r, ln >> 5), row = r0 + 32 * i + (ln & 31);
        const float val = s * mrstd[row];
        if (col < 1024) Km[(size_t)row * 1024 + col] = f2bf(val);
        else { const int c2 = col - 1024, h = c2 >> 8, dv = c2 & 255, b = row >> 8, key = row & 255; Vmt[((size_t)(b * 4 + h) * 256 + dv) * 256 + key] = f2bf(val); }
    }
    LBAR();
}

DI void gmlp_unit(LAS unsigned char* lds, bf16_t* zC, const float* ln_g, const float* ln_b, const float* w_s, const float* b_s, int chunk, int g, int wv) {
    const int tid = otid(wv), lane = tid & 63, w = __builtin_amdgcn_readfirstlane(tid >> 6), l32 = lane & 31, hi = lane >> 5;
    constexpr int VST = 272;
    const size_t row0 = (size_t)chunk * 128;
    LAS bf16_t* vnT = (LAS bf16_t*)lds;
    {
        f32x4 lg0, lg1, lb0, lb1;
        lg0 = *(const f32x4*)(ln_g + 8 * lane); lg1 = *(const f32x4*)(ln_g + 8 * lane + 4);
        lb0 = *(const f32x4*)(ln_b + 8 * lane); lb1 = *(const f32x4*)(ln_b + 8 * lane + 4);
        u32x4 rawv[16];
#pragma unroll
        for (int tt = 0; tt < 16; ++tt) rawv[tt] = *(const u32x4*)(zC + (row0 + 16 * w + tt) * 1024 + 512 + 8 * lane);
#pragma unroll
        for (int tt = 0; tt < 16; ++tt) {
            const int t = 16 * w + tt;
            const u32x4 raw = rawv[tt];
            float x[8];
            x[0] = gelu_erf(bflo(raw.x)); x[1] = gelu_erf(bfhi(raw.x)); x[2] = gelu_erf(bflo(raw.y)); x[3] = gelu_erf(bfhi(raw.y));
            x[4] = gelu_erf(bflo(raw.z)); x[5] = gelu_erf(bfhi(raw.z)); x[6] = gelu_erf(bflo(raw.w)); x[7] = gelu_erf(bfhi(raw.w));
            float s = 0.f;
#pragma unroll
            for (int e = 0; e < 8; ++e) s += x[e];
            const float mean = wave_sum(s) * (1.0f / 512.0f);
            float q = 0.f;
#pragma unroll
            for (int e = 0; e < 8; ++e) { x[e] -= mean; q += x[e] * x[e]; }
            const float rstd = rsqrtf(wave_sum(q) * (1.0f / 512.0f) + EPS);
            if ((lane >> 4) == g) {
                const int cl = 8 * (lane & 15);
                vnT[(cl + 0) * (VST / 2) + t] = f2bf(x[0] * rstd * lg0[0] + lb0[0]); vnT[(cl + 1) * (VST / 2) + t] = f2bf(x[1] * rstd * lg0[1] + lb0[1]);
                vnT[(cl + 2) * (VST / 2) + t] = f2bf(x[2] * rstd * lg0[2] + lb0[2]); vnT[(cl + 3) * (VST / 2) + t] = f2bf(x[3] * rstd * lg0[3] + lb0[3]);
                vnT[(cl + 4) * (VST / 2) + t] = f2bf(x[4] * rstd * lg1[0] + lb1[0]); vnT[(cl + 5) * (VST / 2) + t] = f2bf(x[5] * rstd * lg1[1] + lb1[1]);
                vnT[(cl + 6) * (VST / 2) + t] = f2bf(x[6] * rstd * lg1[2] + lb1[2]); vnT[(cl + 7) * (VST / 2) + t] = f2bf(x[7] * rstd * lg1[3] + lb1[3]);
            }
        }
    }
    LBAR();
    {
        const int tb = w >> 1, cb0 = 2 * (w & 1);
        f32x16 a0, a1;
#pragma unroll
        for (int r = 0; r < 16; ++r) { a0[r] = 0.f; a1[r] = 0.f; }
        const int trow = 32 * tb + l32;
        const float* wrow = w_s + ((size_t)(g * 128 + trow)) * 128;
        f32x4 wq0[8], wq1[8];
#pragma unroll
        for (int ks = 0; ks < 8; ++ks) { wq0[ks] = (f32x4){0.f, 0.f, 0.f, 0.f}; wq1[ks] = wq0[ks];
            if (ks <= 2 * tb + 1) { wq0[ks] = *(const f32x4*)(wrow + 16 * ks + 8 * hi); wq1[ks] = *(const f32x4*)(wrow + 16 * ks + 8 * hi + 4); } }
#pragma unroll
        for (int ks = 0; ks < 8; ++ks) {
            if (ks > 2 * tb + 1) break;
            const int s0 = 16 * ks + 8 * hi;
            f32x4 w0 = wq0[ks], w1 = wq1[ks];
#pragma unroll
            for (int e = 0; e < 4; ++e) { if (s0 + e > trow) w0[e] = 0.f; if (s0 + 4 + e > trow) w1[e] = 0.f; }
            const bf16x8 A = pack8(w0[0], w0[1], w0[2], w0[3], w1[0], w1[1], w1[2], w1[3]);
            const bf16x8 B0 = *(const LAS bf16x8*)(lds + (32 * cb0 + l32) * VST + s0 * 2);
            const bf16x8 B1 = *(const LAS bf16x8*)(lds + (32 * (cb0 + 1) + l32) * VST + s0 * 2);
            a0 = MFMA32(A, B0, a0); a1 = MFMA32(A, B1, a1);
        }
#pragma unroll
        for (int r = 0; r < 16; ++r) {
            const int t = 32 * tb + crow(r, hi);
            const float bs = b_s[g * 128 + t];
            bf16_t* up0 = zC + (row0 + t) * 1024 + g * 128 + 32 * cb0 + l32;
            const float u0 = gelu_erf(bf2f(up0[0])), u1 = gelu_erf(bf2f(up0[32]));
            up0[0] = f2bf((a0[r] + bs) * u0); up0[32] = f2bf((a1[r] + bs) * u1);
        }
    }
    LBAR();
}

#define HG_IDS() \
    const int k = tid & 127, seg = tid >> 7; \
    const size_t row0 = (size_t)b * SEQ + (size_t)c * 64 + 16 * seg; \
    bf16_t hfr[16], vrw[16]; \
    _Pragma("unroll") for (int i = 0; i < 16; ++i) { hfr[i] = zB[(row0 + i) * 2048 + 512 + h * 128 + k]; vrw[i] = zB[(row0 + i) * 2048 + 1024 + h * 128 + k]; }
#define HG_PREP() \
    float cum[16], kv[16]; float bref, blast; \
    { const float lb = lbv[h * 128 + k]; float run = 0.f; \
      _Pragma("unroll") for (int i = 0; i < 16; ++i) { const float fr_ = bf2f(hfr[i]); \
          const float e_ = __expf(-fr_), sg_ = __builtin_amdgcn_rcpf(1.f + e_); const float f_ = lb + (1.f - lb) * sg_; \
          run += __logf(f_); cum[i] = run; kv[i] = (1.f - lb) * e_ * sg_; } \
      segs[seg * 128 + k] = run; LBAR(); \
      const float s0_ = segs[k], s1_ = segs[128 + k], s2_ = segs[256 + k], s3_ = segs[384 + k]; \
      const float off_ = (seg > 0 ? s0_ : 0.f) + (seg > 1 ? s1_ : 0.f) + (seg > 2 ? s2_ : 0.f); \
      bref = s0_ + s1_; blast = (s0_ + s1_) + (s2_ + s3_); \
      _Pragma("unroll") for (int i = 0; i < 16; ++i) cum[i] += off_; }

constexpr int HG_QR = 0, HG_KR = 17408, HG_QD = 34816, HG_VT = 52224, HG_KDT = 70656, HG_SEG = 89088, HG_SSL = 91136;

DI void hg_u_unit(LAS unsigned char* lds, const bf16_t* zB, const float* lbv, bf16_t* ST, float* dC, int b, int h, int c, int wv) {
    const int tid = otid(wv), lane = tid & 63, w = __builtin_amdgcn_readfirstlane(tid >> 6), l32 = lane & 31, hi = lane >> 5;
    LAS float* segs = (LAS float*)(lds + HG_SEG);
    HG_IDS();
    HG_PREP();
    const int unit = (b * 4 + h) * 128 + c;
    {
        float kd[16]; unsigned vr[8];
#pragma unroll
        for (int i = 0; i < 16; ++i) kd[i] = kv[i] * __expf(blast - cum[i]);
#pragma unroll
        for (int i = 0; i < 8; ++i) { const unsigned lo = vrw[2 * i], hi2 = vrw[2 * i + 1]; vr[i] = lo | (hi2 << 16); }
        LAS unsigned char* kp = lds + HG_KDT + k * 144 + seg * 32;
        *(LAS u32x4*)kp = (u32x4){cvt_pk(kd[0], kd[1]), cvt_pk(kd[2], kd[3]), cvt_pk(kd[4], kd[5]), cvt_pk(kd[6], kd[7])};
        *(LAS u32x4*)(kp + 16) = (u32x4){cvt_pk(kd[8], kd[9]), cvt_pk(kd[10], kd[11]), cvt_pk(kd[12], kd[13]), cvt_pk(kd[14], kd[15])};
        LAS unsigned char* vp = lds + HG_VT + k * 144 + seg * 32;
        *(LAS u32x4*)vp = (u32x4){vr[0], vr[1], vr[2], vr[3]};
        *(LAS u32x4*)(vp + 16) = (u32x4){vr[4], vr[5], vr[6], vr[7]};
        if (seg == 0) dC[(size_t)unit * 128 + k] = __expf(blast);
    }
    LBAR();
    {
        const int vb = w & 3;
#pragma unroll
        for (int kbi = 0; kbi < 2; ++kbi) {
            const int kb = 2 * (w >> 2) + kbi;
            f32x16 acc;
#pragma unroll
            for (int r = 0; r < 16; ++r) acc[r] = 0.f;
#pragma unroll
            for (int ks = 0; ks < 4; ++ks) {
                const bf16x8 A = *(const LAS bf16x8*)(lds + HG_VT + (32 * vb + l32) * 144 + (16 * ks + 8 * hi) * 2);
                const bf16x8 B = *(const LAS bf16x8*)(lds + HG_KDT + (32 * kb + l32) * 144 + (16 * ks + 8 * hi) * 2);
                acc = MFMA32(A, B, acc);
            }
            bf16_t* sp = ST + (size_t)unit * 16384 + 32 * kb + l32;
#pragma unroll
            for (int r = 0; r < 16; ++r) sp[(32 * vb + crow(r, hi)) * 128] = f2bf(acc[r]);
        }
    }
    LBAR();
}

DI void hg_out_unit(LAS unsigned char* lds, const bf16_t* zB, const float* lbv, const bf16_t* ST, const float* hnorm, bf16_t* Ob, int b, int h, int c, int wv) {
    const int tid = otid(wv), lane = tid & 63, w = __builtin_amdgcn_readfirstlane(tid >> 6), l32 = lane & 31, hi = lane >> 5;
    LAS float* segs = (LAS float*)(lds + HG_SEG);
    LAS float* ssl = (LAS float*)(lds + HG_SSL);
    HG_IDS();
    const int unit = (b * 4 + h) * 128 + c;
    const int vb = w & 3, tb = w >> 2;
    bf16_t hqr[16];
#pragma unroll
    for (int i = 0; i < 16; ++i) hqr[i] = zB[(row0 + i) * 2048 + h * 128 + k];
    bf16x8 stf[8];
    {
        const bf16_t* sp = ST + (size_t)unit * 16384 + (size_t)(32 * vb + l32) * 128 + 8 * hi;
#pragma unroll
        for (int ks = 0; ks < 8; ++ks) stf[ks] = *(const bf16x8*)(sp + 16 * ks);
    }
    u32x2 grw[4];
    {
        const size_t rowg = (size_t)b * SEQ + (size_t)c * 64 + 32 * tb + l32;
#pragma unroll
        for (int g = 0; g < 4; ++g) grw[g] = *(const u32x2*)(zB + rowg * 2048 + 1536 + h * 128 + 32 * vb + 8 * g + 4 * hi);
    }
    HG_PREP();
    {
        LAS bf16_t* Qr = (LAS bf16_t*)(lds + HG_QR); LAS bf16_t* Kr = (LAS bf16_t*)(lds + HG_KR); LAS bf16_t* Qd = (LAS bf16_t*)(lds + HG_QD);
        unsigned vr[8];
#pragma unroll
        for (int i = 0; i < 16; ++i) { const int t = 16 * seg + i;
            const float qraw = bf2f(hqr[i]); const float q = qraw * sigm(qraw);
            Qr[t * 136 + k] = f2bf(q * __expf(cum[i] - bref)); Kr[t * 136 + k] = f2bf(kv[i] * __expf(bref - cum[i])); Qd[t * 136 + k] = f2bf(q * __expf(cum[i])); }
#pragma unroll
        for (int i = 0; i < 8; ++i) { const unsigned lo = vrw[2 * i], hi2 = vrw[2 * i + 1]; vr[i] = lo | (hi2 << 16); }
        LAS unsigned char* vp = lds + HG_VT + k * 144 + seg * 32;
        *(LAS u32x4*)vp = (u32x4){vr[0], vr[1], vr[2], vr[3]};
        *(LAS u32x4*)(vp + 16) = (u32x4){vr[4], vr[5], vr[6], vr[7]};
    }
    LBAR();
    f32x16 o;
#pragma unroll
    for (int r = 0; r < 16; ++r) o[r] = 0.f;
    {
#pragma unroll
        for (int ks = 0; ks < 8; ++ks) {
            const bf16x8 A = stf[ks];
            const bf16x8 B = *(const LAS bf16x8*)(lds + HG_QD + (32 * tb + l32) * 272 + (16 * ks + 8 * hi) * 2);
            o = MFMA32(A, B, o);
        }
    }
#pragma unroll
    for (int sb = 0; sb < 2; ++sb) {
        if (sb <= tb) {
            f32x16 at;
#pragma unroll
            for (int r = 0; r < 16; ++r) at[r] = 0.f;
#pragma unroll
            for (int ks = 0; ks < 8; ++ks) {
                const bf16x8 A = *(const LAS bf16x8*)(lds + HG_KR + (32 * sb + l32) * 272 + (16 * ks + 8 * hi) * 2);
                const bf16x8 B = *(const LAS bf16x8*)(lds + HG_QR + (32 * tb + l32) * 272 + (16 * ks + 8 * hi) * 2);
                at = MFMA32(A, B, at);
            }
            if (sb == tb) {
#pragma unroll
                for (int r = 0; r < 16; ++r) if (crow(r, hi) > l32) at[r] = 0.f;
            }
#pragma unroll
            for (int sub = 0; sub < 2; ++sub) {
                const bf16x8 P = pack8(at[8 * sub + 0], at[8 * sub + 1], at[8 * sub + 2], at[8 * sub + 3], at[8 * sub + 4], at[8 * sub + 5], at[8 * sub + 6], at[8 * sub + 7]);
                const int koff = (32 * sb + 16 * sub + 4 * hi) * 2;
                const u32x2 al = *(const LAS u32x2*)(lds + HG_VT + (32 * vb + l32) * 144 + koff), ah = *(const LAS u32x2*)(lds + HG_VT + (32 * vb + l32) * 144 + koff + 16);
                o = MFMA32(mk8(al, ah), P, o);
            }
        }
    }
    float ss = 0.f;
#pragma unroll
    for (int r = 0; r < 16; ++r) ss += o[r] * o[r];
    ss += __shfl_xor(ss, 32);
    if (hi == 0) ssl[vb * 64 + 32 * tb + l32] = ss;
    LBAR();
    {
        const int t = 32 * tb + l32;
        const float tot = (ssl[t] + ssl[64 + t]) + (ssl[128 + t] + ssl[192 + t]);
        const float rstd = rsqrtf(tot * (1.0f / 128.0f) + EPS);
        const size_t row = (size_t)b * SEQ + (size_t)c * 64 + t;
#pragma unroll
        for (int g = 0; g < 4; ++g) {
            const int v0 = 32 * vb + 8 * g + 4 * hi;
            const u32x2 gr = grw[g];
            const f32x4 hn = *(const f32x4*)(hnorm + v0);
            const float g0 = bflo(gr.x), g1 = bfhi(gr.x), g2 = bflo(gr.y), g3 = bfhi(gr.y);
            u32x2 ow;
            ow.x = cvt_pk(o[4 * g] * rstd * hn[0] * (g0 * sigm(g0)), o[4 * g + 1] * rstd * hn[1] * (g1 * sigm(g1)));
            ow.y = cvt_pk(o[4 * g + 2] * rstd * hn[2] * (g2 * sigm(g2)), o[4 * g + 3] * rstd * hn[3] * (g3 * sigm(g3)));
            *(u32x2*)(Ob + row * 512 + h * 128 + v0) = ow;
        }
    }
    LBAR();
}


#define XB_TMO      128
#define XB_XCNT(j)  (256  + 64 * (j))
#define XB_XSUB(j)  (1280 + 64 * (j))
#define XB_XGEN(j)  (2304 + 64 * (j))
#define XB_TOP      3328
#define XB_TOPGEN   3392
#define XCD_BAR_WORDS 3456
#define XB_SPIN_CAP (1u << 18)
DI unsigned xb_ld(unsigned* p)              { return __hip_atomic_load(p, __ATOMIC_RELAXED, __HIP_MEMORY_SCOPE_AGENT); }
DI unsigned xb_add(unsigned* p, unsigned v) { return __hip_atomic_fetch_add(p, v, __ATOMIC_RELAXED, __HIP_MEMORY_SCOPE_AGENT); }
DI unsigned xb_xcc_id() { return (unsigned)__builtin_amdgcn_s_getreg((3 << 11) | 20) & 0xFu; }
#define XB_SPIN(cond, bar) do { unsigned _sp = 0; while (cond) { __builtin_amdgcn_s_sleep(1); \
    if ((++_sp & 255u) == 0u) { if (xb_ld(&(bar)[XB_TMO])) break; if (_sp > XB_SPIN_CAP) { atomicAdd(&(bar)[XB_TMO], 1u); break; } } } } while (0)
DI void xcd_barrier_complete(unsigned* bar, unsigned x, unsigned& nloc, unsigned& nx) {
    const unsigned G = gridDim.x * gridDim.y * gridDim.z;
    unsigned sum, cnt, mine, sp = 0u;
    for (;;) {
        sum = 0u; cnt = 0u; mine = 0u;
#pragma unroll
        for (unsigned j = 0; j < 16; ++j) { const unsigned c = xb_ld(&bar[XB_XCNT(j)]); sum += c; cnt += (c > 0u) ? 1u : 0u; mine = (j == x) ? c : mine; }
        if (sum == G) break;
        __builtin_amdgcn_s_sleep(1);
        if ((++sp & 255u) == 0u) { if (xb_ld(&bar[XB_TMO])) break; if (sp > XB_SPIN_CAP) { atomicAdd(&bar[XB_TMO], 1u); break; } }
    }
    nloc = mine > 0u ? mine : 1u; nx = cnt > 0u ? cnt : 1u;
}
DI void xcd_barrier(unsigned* bar, volatile LAS unsigned* st) {
    asm volatile("s_waitcnt vmcnt(0)" ::: "memory");
    __syncthreads();
    if (threadIdx.x == 0) {
        const unsigned x = xb_xcc_id();
        __builtin_amdgcn_s_waitcnt(0);
        unsigned nloc = st[0], nx = st[1];
        if (nloc == 0u) { xcd_barrier_complete(bar, x, nloc, nx); st[0] = nloc; st[1] = nx; }
        const unsigned old = xb_add(&bar[XB_XSUB(x)], 1u);
        const unsigned gen = old / nloc;
        if (old + 1u == (gen + 1u) * nloc) {
            __builtin_amdgcn_fence(__ATOMIC_RELEASE, "agent");
            asm volatile("s_waitcnt vmcnt(0)" ::: "memory");
            const unsigned og = xb_add(&bar[XB_TOP], 1u);
            const unsigned tg = og / nx;
            if (og + 1u == (tg + 1u) * nx) xb_add(&bar[XB_TOPGEN], 1u);
            else XB_SPIN(xb_ld(&bar[XB_TOPGEN]) == tg, bar);
            __builtin_amdgcn_fence(__ATOMIC_ACQUIRE, "agent");
            xb_add(&bar[XB_XGEN(x)], 1u);
            asm volatile("s_waitcnt vmcnt(0)" ::: "memory");
        } else {
            XB_SPIN(xb_ld(&bar[XB_XGEN(x)]) == gen, bar);
            __builtin_amdgcn_fence(__ATOMIC_ACQUIRE, "agent");
            asm volatile("s_waitcnt vmcnt(0)" ::: "memory");
        }
    }
    __syncthreads();
}

constexpr size_t MiB = 1u << 20;
constexpr size_t WS_X0 = 0, WS_R2 = 32 * MiB, WS_R3 = 96 * MiB, WS_X1 = 128 * MiB, WS_R1 = 160 * MiB, WS_R4 = 184 * MiB, WS_RW = 216 * MiB;
constexpr size_t WS_CTL = 250 * MiB + 512 * 1024, CTL_BYTES = 16384;
constexpr size_t WS_P = 241 * MiB, WS_PA = 242 * MiB, WS_CS = 244 * MiB, WS_DC = 246 * MiB, WS_MEMB = 247 * MiB, WS_KM = 248 * MiB, WS_VMT = 249 * MiB, WS_MISC = 250 * MiB, WS_END = 251 * MiB;
constexpr size_t W1_IN = 0, W1_UQ = W1_IN + (size_t)6912 * 1024, W1_UKV = W1_UQ + (size_t)768 * 384, W1_BA = W1_UKV + (size_t)1024 * 256, W1_BB = W1_BA + (size_t)1024 * 512,
                 W1_BC = W1_BB + (size_t)1024 * 512, W1_MIX = W1_BC + (size_t)1024 * 512, W1_END = W1_MIX + (size_t)1024 * 1024;
constexpr size_t W2_XQ = 0, W2_XKV = W2_XQ + (size_t)1024 * 1024, W2_XO = W2_XKV + (size_t)2048 * 1024, W2_FI = W2_XO + (size_t)1024 * 1024, W2_FO = W2_FI + (size_t)5632 * 1024, W2_END = W2_FO + (size_t)1024 * 2816;
static_assert(W1_END * 2 <= 25 * MiB && W2_END * 2 <= 25 * MiB, "weight region");

constexpr int LDS_BYTES = 147456;

struct Args { const float* in[28]; float* out; unsigned char* ws; };

constexpr int PTAB_OFF = 135168;
DI void* ldptr(LAS unsigned char* lds, int i) {
    unsigned off_ = PTAB_OFF + 8 * i; asm volatile("" : "+v"(off_));
    const LAS unsigned* t = (const LAS unsigned*)(lds + off_);
    const unsigned lo = __builtin_amdgcn_readfirstlane(t[0]), hi = __builtin_amdgcn_readfirstlane(t[1]);
    typedef __attribute__((address_space(1))) unsigned char* gptr_t;
    return (void*)(gptr_t)(((unsigned long long)hi << 32) | (unsigned long long)lo);
}
#define INP(i) ((const float*)ldptr(lds, (i)))
#define PH_HEAD() \
    int G = G0_, bid = bid0_; asm volatile("" : "+s"(G), "+s"(bid)); \
    int wv = wv0_; asm volatile("" : "+s"(wv)); const int tid = otid(wv), lane = tid & 63, wave = wv; \
    const int gw = bid * 8 + wave, NGW = G * 8; (void)lane; (void)gw; (void)NGW; \
    unsigned char* ws = (unsigned char*)ldptr(lds, 29); \
    bf16_t* const X0 = (bf16_t*)(ws + WS_X0); bf16_t* const X1 = (bf16_t*)(ws + WS_X1); \
    bf16_t* const R1 = (bf16_t*)(ws + WS_R1); bf16_t* const R2 = (bf16_t*)(ws + WS_R2); bf16_t* const R3 = (bf16_t*)(ws + WS_R3); bf16_t* const R4 = (bf16_t*)(ws + WS_R4); \
    bf16_t* const RW = (bf16_t*)(ws + WS_RW); \
    float* const P = (float*)(ws + WS_P); float* const PA = (float*)(ws + WS_PA); float* const CS = (float*)(ws + WS_CS); float* const dC = (float*)(ws + WS_DC); \
    bf16_t* const memb = (bf16_t*)(ws + WS_MEMB); bf16_t* const Km = (bf16_t*)(ws + WS_KM); bf16_t* const Vmt = (bf16_t*)(ws + WS_VMT); \
    float* const mrstd = (float*)(ws + WS_MISC); float* const lbv = mrstd + 512; \
    bf16_t* const xcur = par ? X1 : X0; bf16_t* const xfree = par ? X0 : X1; \
    bf16_t* const zA = R1; bf16_t* const zB = R2; bf16_t* const zC = R4; \
    bf16_t* const Qb = R3; bf16_t* const Krb = R3 + (size_t)MTOK * 768; \
    bf16_t* const Knb = xfree; bf16_t* const Vtb = xfree + (size_t)MTOK * 512; \
    bf16_t* const Oa = R1; bf16_t* const Ob = xfree; bf16_t* const STb = R3; bf16_t* const Gt = R2; bf16_t* const MX = xcur; \
    bf16_t* const QX = R2; bf16_t* const ACT = R2; float* const xres = (float*)ldptr(lds, 28); \
    (void)X0; (void)X1; (void)R1; (void)R2; (void)R3; (void)R4; (void)RW; (void)P; (void)PA; (void)CS; (void)dC; (void)memb; (void)Km; (void)Vmt; (void)mrstd; (void)lbv; \
    (void)xcur; (void)xfree; (void)zA; (void)zB; (void)zC; (void)Qb; (void)Krb; (void)Knb; (void)Vtb; (void)Oa; (void)Ob; (void)STb; (void)Gt; (void)MX; (void)QX; (void)ACT; (void)xres;

#ifdef TPROBE
#define TSTAMP(cls) do { if (blockIdx.x == 0 && threadIdx.x == 0) { LAS unsigned long long* tp_ = (LAS unsigned long long*)(lds + PTAB_OFF + 512); \
    const unsigned long long now_ = __builtin_amdgcn_s_memrealtime(); tp_[1 + (cls)] += now_ - tp_[0]; tp_[0] = now_; } } while (0)
#else
#define TSTAMP(cls) do { } while (0)
#endif
#define GSYNC() xcd_barrier((unsigned*)((unsigned char*)ldptr(lds, 29) + WS_CTL), (volatile LAS unsigned*)(lds + PTAB_OFF + 256))
__global__ void __launch_bounds__(512, 2) mega_fwd(Args args) {
    extern __shared__ __attribute__((aligned(16))) unsigned char lds_raw[];
    LAS unsigned char* lds = (LAS unsigned char*)lds_raw;
    cg::grid_group grid = cg::this_grid();
    const int G0_ = gridDim.x, bid0_ = blockIdx.x, wv0_ = __builtin_amdgcn_readfirstlane(threadIdx.x >> 6);
    int par = 0;
    if (threadIdx.x == 0) {
        LAS unsigned long long* pt = (LAS unsigned long long*)(lds + PTAB_OFF);
#pragma unroll
        for (int i = 0; i < 28; ++i) pt[i] = (unsigned long long)args.in[i];
        pt[28] = (unsigned long long)args.out; pt[29] = (unsigned long long)args.ws;
        pt[32] = 0ull;
#ifdef TPROBE
        for (int i = 0; i < 8; ++i) pt[64 + i] = 0ull; pt[64] = __builtin_amdgcn_s_memrealtime();
#endif
        (void)xb_add((unsigned*)(args.ws + WS_CTL) + XB_XCNT(xb_xcc_id()), 1u);
    }
    __syncthreads();

    for (int l = 0; l < 2; ++l) {
        {
            PH_HEAD();
            LAS float* scr = (LAS float*)(lds + wave * 16640);
            const float* w_in = INP(4) + (size_t)l * 1024 * INW; const float* mixn = INP(3) + l * 1024;
            const float* wuq = INP(6) + (size_t)l * 384 * 768; const float* qn = INP(5) + l * 384;
            const float* wukv = INP(8) + (size_t)l * 256 * 1024; const float* kvn = INP(7) + l * 256;
            const float* wba = INP(15) + (size_t)l * 512 * 1024; const float* wbb = INP(16) + (size_t)l * 512 * 1024; const float* wbc = INP(17) + (size_t)l * 512 * 1024;
            const float* wmx = INP(18) + (size_t)l * 1024 * 1024;
            constexpr int I_IN = 16 * 108, I_UQ = 6 * 12, I_UKV = 4 * 16, I_B = 8 * 16, I_MX = 16 * 16;
            constexpr int NIT = I_IN + I_UQ + I_UKV + 3 * I_B + I_MX;
            for (int it = gw; it < NIT; it += NGW) {
                int r = it;
                if (r < I_IN) { conv_item(w_in, 1024, INW, 6912, 1, mixn, RW + W1_IN, scr, r, lane); continue; } r -= I_IN;
                if (r < I_UQ) { conv_item(wuq, 384, 768, 768, 0, qn, RW + W1_UQ, scr, r, lane); continue; } r -= I_UQ;
                if (r < I_UKV) { conv_item(wukv, 256, 1024, 1024, 0, kvn, RW + W1_UKV, scr, r, lane); continue; } r -= I_UKV;
                if (r < I_B) { conv_item(wba, 512, 1024, 1024, 0, nullptr, RW + W1_BA, scr, r, lane); continue; } r -= I_B;
                if (r < I_B) { conv_item(wbb, 512, 1024, 1024, 0, nullptr, RW + W1_BB, scr, r, lane); continue; } r -= I_B;
                if (r < I_B) { conv_item(wbc, 512, 1024, 1024, 0, nullptr, RW + W1_BC, scr, r, lane); continue; } r -= I_B;
                conv_item(wmx, 1024, 1024, 1024, 0, nullptr, RW + W1_MIX, scr, r, lane);
            }
            if (l == 0) {
                const float* xin0 = INP(0);
                for (int m0 = 4 * gw; m0 < MTOK; m0 += 4 * NGW) {
                    f32x4 vv[4][4];
#pragma unroll
                    for (int q = 0; q < 4; ++q)
#pragma unroll
                        for (int j = 0; j < 4; ++j) vv[q][j] = ((const f32x4*)(xin0 + (size_t)(m0 + q) * 1024) + lane)[64 * j];
#pragma unroll
                    for (int q = 0; q < 4; ++q) { const int m = m0 + q; float s = 0.f;
                        unsigned long long* o8 = (unsigned long long*)(xcur + (size_t)m * 1024) + lane;
#pragma unroll
                        for (int j = 0; j < 4; ++j) { const f32x4 v = vv[q][j]; s += dot4(v); o8[64 * j] = (unsigned long long)cvt_pk(v.x, v.y) | ((unsigned long long)cvt_pk(v.z, v.w) << 32); }
                        s = wave_sum(s);
                        if (lane < 16) P[(size_t)m * 16 + lane] = (lane == 0) ? s : 0.f; }
                }
                for (int m = gw; m < NB * NMEM; m += NGW) {
                    const f32x4* xr = (const f32x4*)(INP(1) + (size_t)m * 1024) + lane; float s = 0.f;
                    unsigned long long* o8 = (unsigned long long*)(memb + (size_t)m * 1024) + lane;
#pragma unroll
                    for (int j = 0; j < 4; ++j) { const f32x4 v = xr[64 * j]; s += dot4(v); o8[64 * j] = (unsigned long long)cvt_pk(v.x, v.y) | ((unsigned long long)cvt_pk(v.z, v.w) << 32); }
                    s = wave_sum(s);
                    if (lane == 0) mrstd[m] = rsqrtf(s * (1.0f / 1024.0f) + EPS);
                }
                const int* pos = (const int*)INP(2);
                for (int idx = bid * 512 + tid; idx < MTOK * 16; idx += G * 512) {
                    const int row = idx >> 4, j = idx & 15;
                    const float invf = powf(10000.0f, -(float)(2 * j) / 32.0f);
                    const float ang = (float)pos[row] * invf;
                    double tt = (double)ang * 0.15915494309189535; tt -= rint(tt);
                    const float rv = (float)tt;
                    CS[(size_t)row * 32 + j] = __builtin_amdgcn_cosf(rv); CS[(size_t)row * 32 + 16 + j] = __builtin_amdgcn_sinf(rv);
                }
                for (int idx = bid * 512 + tid; idx < 512; idx += G * 512) {
                    const float p0 = INP(9)[idx], p1 = INP(9)[512 + idx];
                    lbv[idx] = 0.f; lbv[512 + idx] = 1.0f / (1.0f + expf(p0 - p1));
                }
            }
        }
        __syncthreads();
        if (l == 0) grid.sync(); else GSYNC();
        TSTAMP(0);
        {
            PH_HEAD();
            pg8::Gemm g{xcur, RW + W1_IN, MTOK, 3840, 1024, 1024, 1024}; pg8::StaticOrder S; S.init(MTOK, 3840, G, bid);
            EpiA E{P, zA, zB, zC, PA};
            pg8::gemm_phase<EpiA>(lds, g, S, E, wv);
        }
        GSYNC();
        TSTAMP(1);
        {
            PH_HEAD();
            for (int idx = bid * 512 + tid; idx < MTOK * 16; idx += G * 512) {
                const int row = idx >> 4, j = idx & 15;
                const float x1 = bf2f(zA[(size_t)row * 768 + 640 + j]), x2 = bf2f(zA[(size_t)row * 768 + 656 + j]);
                const float cs = CS[(size_t)row * 32 + j], sn = CS[(size_t)row * 32 + 16 + j];
                Krb[(size_t)row * 32 + j] = f2bf(x1 * cs - x2 * sn); Krb[(size_t)row * 32 + 16 + j] = f2bf(x1 * sn + x2 * cs);
            }
            { pg8::Gemm g{zA, RW + W1_UQ, MTOK, 768, 384, 768, 384}; pg8::StaticOrder S; S.init(MTOK, 768, G, bid);
              EpiQ E{PA, CS, Qb}; pg8::gemm_phase<EpiQ>(lds, g, S, E, wv); }
            { pg8::Gemm g{zA + 384, RW + W1_UKV, MTOK, 1024, 256, 768, 256}; pg8::StaticOrder S; S.init(MTOK, 1024, G, bid);
              EpiKV E{PA, Knb, Vtb}; pg8::gemm_phase<EpiKV>(lds, g, S, E, wv); }
        }
        __syncthreads();
        GSYNC();
        TSTAMP(1);
        {
            PH_HEAD();
            for (int item = bid; item < 256; item += G) {
                const int b = item >> 7, h = (item >> 4) & 7, s = item & 15;
                attn_unit(lds, Qb, Knb, Krb, Vtb, Oa, b, h, 31 - s, wv);
                attn_unit(lds, Qb, Knb, Krb, Vtb, Oa, b, h, s, wv);
            }
#ifdef TPROBE
            GSYNC(); TSTAMP(2);
#endif
            const float* lng = INP(11) + l * 512; const float* lnb = INP(12) + l * 512;
            const float* wsp = INP(13) + (size_t)l * 4 * 128 * 128; const float* bsp = INP(14) + l * 512;
            for (int u = bid; u < 512; u += G) gmlp_unit(lds, zC, lng, lnb, wsp, bsp, u >> 2, u & 3, wv);
        }
        GSYNC();
#ifdef TPROBE
        TSTAMP(5);
#else
        TSTAMP(2);
#endif
        {
            PH_HEAD();
            for (int u = bid; u < 1024; u += G) hg_u_unit(lds, zB, lbv + l * 512, STb, dC, u >> 9, (u >> 7) & 3, u & 127, wv);
        }
        GSYNC();
        TSTAMP(3);
        {
            PH_HEAD();
            if (tid < 256) {
                for (int p = bid * 256 + tid; p < 65536; p += G * 256) {
                    const int bh = p >> 13, e2 = p & 8191;
                    unsigned* sp = (unsigned*)STb + (size_t)bh * 128 * 8192 + e2;
                    const float* dp = dC + (size_t)bh * 128 * 128 + ((2 * e2) & 127);
                    float S0 = 0.f, S1 = 0.f;
                    for (int c0 = 0; c0 < 128; c0 += 16) {
                        unsigned uu[16]; f32x2 dd[16];
#pragma unroll
                        for (int i = 0; i < 16; ++i) { uu[i] = sp[(size_t)(c0 + i) * 8192]; dd[i] = *(const f32x2*)(dp + (size_t)(c0 + i) * 128); }
#pragma unroll
                        for (int i = 0; i < 16; ++i) { sp[(size_t)(c0 + i) * 8192] = cvt_pk(S0, S1); S0 = dd[i].x * S0 + bflo(uu[i]); S1 = dd[i].y * S1 + bfhi(uu[i]); }
                    }
                }
            }
        }
        GSYNC();
        TSTAMP(3);
        {
            PH_HEAD();
            for (int u = bid; u < 1024; u += G) hg_out_unit(lds, zB, lbv + l * 512, STb, INP(10) + l * 128, Ob, u >> 9, (u >> 7) & 3, u & 127, wv);
        }
        GSYNC();
        TSTAMP(3);
        {
            PH_HEAD();
            pg8::Gemm g{xcur, RW + W1_IN + (size_t)3840 * 1024, MTOK, 3072, 1024, 1024, 1024}; pg8::StaticOrder S; S.init(MTOK, 3072, G, bid);
            EpiPlain<true> E{P, Gt, 3072, 1.0f};
            pg8::gemm_phase<EpiPlain<true>>(lds, g, S, E, wv);
        }
        GSYNC();
        TSTAMP(1);
        {
            PH_HEAD();
            pg8::StaticOrder S; S.init(MTOK, 1024, G, bid);
            { pg8::Gemm g{Oa, RW + W1_BA, MTOK, 1024, 512, 512, 512}; EpiBr E{Gt, MX, 0}; pg8::gemm_phase<EpiBr>(lds, g, S, E, wv); }
            { pg8::Gemm g{Ob, RW + W1_BB, MTOK, 1024, 512, 512, 512}; EpiBr E{Gt, MX, 1}; pg8::gemm_phase<EpiBr>(lds, g, S, E, wv); }
            { pg8::Gemm g{zC, RW + W1_BC, MTOK, 1024, 512, 1024, 512}; EpiBr E{Gt, MX, 2}; pg8::gemm_phase<EpiBr>(lds, g, S, E, wv); }
        }
        GSYNC();
        TSTAMP(1);
        {
            PH_HEAD();
            pg8::Gemm g{MX, RW + W1_MIX, MTOK, 1024, 1024, 1024, 1024}; pg8::StaticOrder S; S.init(MTOK, 1024, G, bid);
            EpiRes E{l == 0 ? INP(0) : (const float*)xres, xres, xfree, P};
            pg8::gemm_phase<EpiRes>(lds, g, S, E, wv);
        }
        par ^= 1;
        GSYNC();
        TSTAMP(1);
        {
            PH_HEAD();
            LAS float* scr = (LAS float*)(lds + wave * 16640);
            const float* wxq = INP(21) + (size_t)l * 1024 * 1024; const float* xan = INP(19) + l * 1024;
            const float* wxkv = INP(22) + (size_t)l * 1024 * 2048; const float* memn = INP(20) + l * 1024;
            const float* wxo = INP(23) + (size_t)l * 1024 * 1024;
            const float* wfi = INP(25) + (size_t)l * 1024 * 2 * DFF; const float* ffn = INP(24) + l * 1024;
            const float* wfo = INP(26) + (size_t)l * DFF * 1024;
            constexpr int I_XQ = 16 * 16, I_XKV = 16 * 32, I_FI = 16 * 88, I_FO = 44 * 16;
            constexpr int NIT = 2 * I_XQ + I_XKV + I_FI + I_FO;
            for (int it = gw; it < NIT; it += NGW) {
                int r = it;
                if (r < I_XQ) { conv_item(wxq, 1024, 1024, 1024, 0, xan, RW + W2_XQ, scr, r, lane); continue; } r -= I_XQ;
                if (r < I_XKV) { conv_item(wxkv, 1024, 2048, 2048, 0, memn, RW + W2_XKV, scr, r, lane); continue; } r -= I_XKV;
                if (r < I_XQ) { conv_item(wxo, 1024, 1024, 1024, 0, nullptr, RW + W2_XO, scr, r, lane); continue; } r -= I_XQ;
                if (r < I_FI) { conv_item(wfi, 1024, 2 * DFF, 2 * DFF, 2, ffn, RW + W2_FI, scr, r, lane); continue; } r -= I_FI;
                conv_item(wfo, DFF, 1024, 1024, 0, nullptr, RW + W2_FO, scr, r, lane);
            }
        }
        __syncthreads();
        GSYNC();
        TSTAMP(0);
        {
            PH_HEAD();
            { pg8::Gemm g{xcur, RW + W2_XQ, MTOK, 1024, 1024, 1024, 1024}; pg8::StaticOrder S; S.init(MTOK, 1024, G, bid);
              EpiPlain<false> E{P, QX, 1024, XSC}; pg8::gemm_phase<EpiPlain<false>>(lds, g, S, E, wv); }
            for (int t = bid; t < 256; t += G) memkv_tile(lds, memb, RW + W2_XKV, mrstd, Km, Vmt, t, wv);
        }
        GSYNC();
        TSTAMP(1);
        {
            PH_HEAD();
            for (int u = bid; u < 256; u += G) xattn_unit(lds, QX, Km, Vmt, u >> 7, (u >> 5) & 3, u & 31, wv);
        }
        GSYNC();
        TSTAMP(4);
        {
            PH_HEAD();
            pg8::Gemm g{QX, RW + W2_XO, MTOK, 1024, 1024, 1024, 1024}; pg8::StaticOrder S; S.init(MTOK, 1024, G, bid);
            EpiRes E{xres, xres, xcur, P};
            pg8::gemm_phase<EpiRes>(lds, g, S, E, wv);
        }
        GSYNC();
        TSTAMP(1);
        {
            PH_HEAD();
            pg8::Gemm g{xcur, RW + W2_FI, MTOK, 2 * DFF, 1024, 1024, 1024}; pg8::StaticOrder S; S.init(MTOK, 2 * DFF, G, bid);
            EpiFF E{P, ACT};
            pg8::gemm_phase<EpiFF>(lds, g, S, E, wv);
        }
        GSYNC();
        TSTAMP(1);
        {
            PH_HEAD();
            pg8::Gemm g{ACT, RW + W2_FO, MTOK, 1024, DFF, DFF, DFF}; pg8::StaticOrder S; S.init(MTOK, 1024, G, bid);
            EpiRes E{xres, xres, xcur, P};
            pg8::gemm_phase<EpiRes>(lds, g, S, E, wv);
        }
        GSYNC();
        TSTAMP(1);
    }
    {
        PH_HEAD();
        const float* fn = INP(27);
        const f32x4* gp = (const f32x4*)fn + lane;
        f32x4 gg[4];
#pragma unroll
        for (int j = 0; j < 4; ++j) gg[j] = gp[64 * j];
        for (int m0 = 4 * gw; m0 < MTOK; m0 += 4 * NGW) {
            f32x4 vv[4][4]; float rs[4];
#pragma unroll
            for (int q = 0; q < 4; ++q) { rs[q] = row_rstd16(P, m0 + q);
#pragma unroll
                for (int j = 0; j < 4; ++j) vv[q][j] = ((const f32x4*)(xres + (size_t)(m0 + q) * 1024) + lane)[64 * j]; }
#pragma unroll
            for (int q = 0; q < 4; ++q)
#pragma unroll
                for (int j = 0; j < 4; ++j) ((f32x4*)(xres + (size_t)(m0 + q) * 1024) + lane)[64 * j] = vv[q][j] * rs[q] * gg[j];
        }
#ifdef TPROBE
        GSYNC(); TSTAMP(6);
        if (blockIdx.x == 0) {
            __syncthreads();
            LAS unsigned long long* tp_ = (LAS unsigned long long*)(lds + PTAB_OFF + 512);
            const float ta = (float)tp_[1 + TPA] * 0.01f, tb = (float)tp_[1 + TPB] * 0.01f;
            if (tid == 0) xres[0] = 10.0f * ta;
            for (int i = tid; i < 10000; i += 512) xres[16 + i] = tb;
        }
#endif
    }
}

extern "C" void kernel_launch(void* const* d_in, const int* in_sizes, int n_in, void* d_out, int out_size, void* d_ws, size_t ws_size, hipStream_t stream) {
    static int grid = 0;
    if (grid == 0) {
        if (n_in != 28 || out_size != MTOK * DM || ws_size < WS_END) { fprintf(stderr, "kernel_launch: unexpected problem (n_in %d out %d ws %zu)\n", n_in, out_size, ws_size); grid = -1; return; }
        int dev = 0, cus = 0, per_cu = 0;
        (void)hipGetDevice(&dev);
        (void)hipDeviceGetAttribute(&cus, hipDeviceAttributeMultiprocessorCount, dev);
        (void)hipFuncSetAttribute((const void*)mega_fwd, hipFuncAttributeMaxDynamicSharedMemorySize, LDS_BYTES);
        (void)hipOccupancyMaxActiveBlocksPerMultiprocessor(&per_cu, (const void*)mega_fwd, 512, LDS_BYTES);
        if (per_cu < 1 || cus < 1) { fprintf(stderr, "kernel_launch: occupancy query gave %d blocks/CU on %d CUs\n", per_cu, cus); grid = -1; return; }
        grid = cus;
    }
    if (grid < 0) return;
    (void)hipMemsetAsync((char*)d_ws + WS_CTL, 0, CTL_BYTES, stream);
    Args a{};
    for (int i = 0; i < 28; ++i) a.in[i] = (const float*)d_in[i];
    a.out = (float*)d_out; a.ws = (unsigned char*)d_ws;
    void* kargs[] = {&a};
    hipError_t e = hipLaunchCooperativeKernel((const void*)mega_fwd, dim3(grid), dim3(512), kargs, LDS_BYTES, stream);
    if (e != hipSuccess) fprintf(stderr, "cooperative launch failed: %s (grid %d)\n", hipGetErrorString(e), grid);
}
```

```cpp
#include <hip/hip_runtime.h>
#include <hip/hip_cooperative_groups.h>
#include <cstdio>
#include <cstdint>
namespace cg = cooperative_groups;

#define LAS __attribute__((address_space(3)))
#define DI __device__ __forceinline__
typedef unsigned short bf16_t;
typedef short bf16x8 __attribute__((ext_vector_type(8)));
typedef float f32x2 __attribute__((ext_vector_type(2)));
typedef float f32x4 __attribute__((ext_vector_type(4)));
typedef float f32x16 __attribute__((ext_vector_type(16)));
typedef unsigned u32x2 __attribute__((ext_vector_type(2)));
typedef unsigned u32x4 __attribute__((ext_vector_type(4)));

constexpr int SEQ = 8192, NB = 2, MTOK = NB * SEQ, DM = 1024, NMEM = 256;
constexpr int INW = 6816, DFF = 2816;
constexpr float EPS = 1e-6f;
constexpr float QSC = 0.10206207261596575f * 1.4426950408889634f;
constexpr float XSC = 0.0625f * 1.4426950408889634f;

DI unsigned cvt_pk(float lo, float hi) {
    typedef __bf16 b2 __attribute__((ext_vector_type(2)));
    f32x2 v = {lo, hi}; b2 b = __builtin_convertvector(v, b2); return __builtin_bit_cast(unsigned, b);
}
DI bf16_t f2bf(float f) { return (bf16_t)(cvt_pk(f, 0.f) & 0xffffu); }
DI float bf2f(bf16_t h) { return __uint_as_float((unsigned)h << 16); }
DI float bflo(unsigned w) { return __uint_as_float(w << 16); }
DI float bfhi(unsigned w) { return __uint_as_float(w & 0xffff0000u); }
DI int olane() { int t = __builtin_amdgcn_mbcnt_hi(~0u, __builtin_amdgcn_mbcnt_lo(~0u, 0u)); asm volatile("" : "+v"(t)); return t; }
DI int otid(int wv) { return wv * 64 + olane(); }
DI float wave_sum(float v) {
#pragma unroll
    for (int o = 1; o < 64; o <<= 1) v += __shfl_xor(v, o);
    return v;
}
DI float sigm(float x) { return __builtin_amdgcn_rcpf(1.f + __expf(-x)); }
DI float gelu_erf(float v) {
    const float av = fabsf(v), t = __builtin_amdgcn_rcpf(av * 0.2316418882f + 1.0f);
    float q = t * 0.5307027145f + (-0.7265760135f); q = q * t + 0.7107068705f; q = q * t + (-0.142248368f); q = q * t + 0.127414796f; q = q * t;
    const float e = __builtin_amdgcn_exp2f((v * v) * (-0.72134752044f));
    const float m = v * (q * e);
    return v < 0.f ? m : v - m;
}
DI int crow(int r, int h) { return (r & 3) + 8 * (r >> 2) + 4 * h; }
DI float dot4(f32x4 a) { return (a.x * a.x + a.y * a.y) + (a.z * a.z + a.w * a.w); }
DI float sum4(f32x4 a) { return (a.x + a.y) + (a.z + a.w); }
#define LBAR() do { asm volatile("s_waitcnt lgkmcnt(0)" ::: "memory"); __builtin_amdgcn_s_barrier(); asm volatile("" ::: "memory"); } while (0)
#define MFMA32(a, b, c) __builtin_amdgcn_mfma_f32_32x32x16_bf16((a), (b), (c), 0, 0, 0)
DI bf16x8 mk8(u32x2 lo, u32x2 hi) { u32x4 v = {lo.x, lo.y, hi.x, hi.y}; return __builtin_bit_cast(bf16x8, v); }
DI bf16x8 pack8(float a0, float a1, float a2, float a3, float a4, float a5, float a6, float a7) {
    u32x4 v = {cvt_pk(a0, a1), cvt_pk(a2, a3), cvt_pk(a4, a5), cvt_pk(a6, a7)}; return __builtin_bit_cast(bf16x8, v);
}

namespace pg8 {
constexpr int BM = 256, BK = 64, HALF = 128, HTB = HALF * BK * 2, STAGE_BYTES = 8 * HTB, NXCD = 8, WGM = 8;
DI int lds_byte(int r, int c) { const int st = (r >> 4) * 2 + (c >> 5), rr = r & 15, cc = c & 31, ob = rr * 64 + cc * 2; return st * 1024 + (ob ^ (((ob >> 9) & 1) << 5)); }
DI void stage_rc(int b, int& R, int& C) { const int st = b / 1024, sb = b % 1024, swz = sb ^ (((sb >> 9) & 1) << 5); R = (st >> 1) * 16 + swz / 64; C = (st & 1) * 32 + (swz % 64) / 2; }
DI int perm32(int rho) { const int n = rho >> 4, i = rho & 15; return 8 * (i >> 2) + 4 * n + (i & 3); }
struct Unit { int pm, pn; };
struct Gemm { const bf16_t* A; const bf16_t* Bt; int M, N, K, lda, ldb; };
struct StaticOrder {
    int nM, nN, nwg, G, c;
    DI void init(int M, int N, int G_, int c_) { nM = M / BM; nN = N / BM; nwg = nM * nN; G = G_; c = c_; }
    DI bool next(int i, Unit& u) const {
        const long L = (long)i * G + c; if (L >= nwg) return false;
        int wgid = (int)L; { const int q = nwg / NXCD, r = nwg % NXCD, xcd = wgid % NXCD, off = wgid / NXCD; wgid = (xcd < r ? xcd * (q + 1) : r * (q + 1) + (xcd - r) * q) + off; }
        const int nig = WGM * nN, gid = wgid / nig, fm = gid * WGM, gsz = (nM - fm) < WGM ? (nM - fm) : WGM;
        u.pm = fm + ((wgid % nig) % gsz); u.pn = (wgid % nig) / gsz; return true;
    }
};
template <class Epi>
DI void gemm_phase(LAS unsigned char* lds, const Gemm g, const StaticOrder& S, const Epi& E, int wv) {
    const int tid = otid(wv), wid = __builtin_amdgcn_readfirstlane(tid >> 6), lane = tid & 63, wr = wid >> 2, wc = wid & 3, fr = lane & 15, fq = lane >> 4;
    const int K = g.K, nt = K / BK;
    unsigned voffA[2], voffB[2];
#pragma unroll
    for (int i = 0; i < 2; ++i) { int R, C; stage_rc(tid * 16 + i * 8192, R, C); const int Rb = Epi::PERM ? ((R & ~31) + perm32(R & 31)) : R;
        voffA[i] = (unsigned)(R * g.lda + C) * 2u; voffB[i] = (unsigned)(Rb * g.ldb + C) * 2u; }
    const size_t kstep = (size_t)(BK * 2);
    const size_t hsA = (size_t)HALF * g.lda * 2, hsB = (size_t)HALF * g.ldb * 2;
    const size_t tsA = 2 * hsA, tsB = 2 * hsB;
    const unsigned ldsw = (unsigned)wid * 1024u;
    const int aoff = lds_byte(wr * 64 + fr, fq * 8), boff = lds_byte(wc * 32 + fr, fq * 8);
#define PG8_SA(b, h) (((b) * 2 + (h)) * HTB)
#define PG8_SB(b, h) ((4 + (b) * 2 + (h)) * HTB)
#define PG8_STAGE(bufoff, gbase, voff) do { const char* gb_ = (const char*)(gbase); asm volatile("" : "+s"(gb_)); _Pragma("unroll") for (int _i = 0; _i < 2; ++_i) { unsigned vo_ = (voff)[_i]; asm volatile("" : "+v"(vo_)); \
        __builtin_amdgcn_global_load_lds((const unsigned*)(gb_ + vo_), (LAS unsigned*)(lds + (bufoff) + ldsw + _i * 8192), 16, 0, 0); } } while (0)
#define PG8_LDA(dst, b, h) do { _Pragma("unroll") for (int m = 0; m < 4; ++m) _Pragma("unroll") for (int k = 0; k < 2; ++k) dst[m][k] = *(const LAS bf16x8*)(lds + PG8_SA(b, h) + aoff + m * 2048 + k * 1024); } while (0)
#define PG8_LDB(dst, b, h) do { _Pragma("unroll") for (int n = 0; n < 2; ++n) _Pragma("unroll") for (int k = 0; k < 2; ++k) dst[n][k] = *(const LAS bf16x8*)(lds + PG8_SB(b, h) + boff + n * 2048 + k * 1024); } while (0)
#define PG8_MMA(ai, bj, At, Bt) do { __builtin_amdgcn_s_setprio(1); _Pragma("unroll") for (int m = 0; m < 4; ++m) _Pragma("unroll") for (int n = 0; n < 2; ++n) _Pragma("unroll") for (int k = 0; k < 2; ++k) \
        acc[ai][bj][m][n] = __builtin_amdgcn_mfma_f32_16x16x32_bf16(Bt[n][k], At[m][k], acc[ai][bj][m][n], 0, 0, 0); __builtin_amdgcn_s_setprio(0); } while (0)
#define PG8_WAIT_V(n) asm volatile("s_waitcnt vmcnt(" #n ")" ::: "memory")
#define PG8_WAIT_L(n) asm volatile("s_waitcnt lgkmcnt(" #n ")" ::: "memory")
#define PG8_BAR __builtin_amdgcn_s_barrier()
#define PG8_SCHED __builtin_amdgcn_sched_barrier(0)
    Unit cur, nxt; int ui = 0;
    if (!S.next(0, cur)) return;
    f32x4 acc[2][2][4][2];
#pragma unroll
    for (int a = 0; a < 2; ++a)
#pragma unroll
        for (int b = 0; b < 2; ++b)
#pragma unroll
            for (int m = 0; m < 4; ++m)
#pragma unroll
                for (int n = 0; n < 2; ++n) acc[a][b][m][n] = (f32x4){0.f, 0.f, 0.f, 0.f};
    bf16x8 At[4][2], B0[2][2], B1[2][2];
    const char* cA = (const char*)g.A + (size_t)cur.pm * tsA; const char* cB = (const char*)g.Bt + (size_t)cur.pn * tsB;
    PG8_STAGE(PG8_SB(0, 0), cB, voffB); PG8_STAGE(PG8_SB(0, 1), cB + hsB, voffB); PG8_STAGE(PG8_SA(0, 0), cA, voffA); PG8_STAGE(PG8_SA(0, 1), cA + hsA, voffA);
    if (wr == 1) PG8_BAR;
    PG8_WAIT_V(2); PG8_BAR;
    PG8_STAGE(PG8_SB(1, 0), cB + kstep, voffB); PG8_STAGE(PG8_SA(1, 0), cA + kstep, voffA); PG8_STAGE(PG8_SB(1, 1), cB + hsB + kstep, voffB);
    PG8_WAIT_V(6); PG8_BAR;
    for (;;) {
        const bool has_next = S.next(ui + 1, nxt);
        const char* nA = has_next ? (const char*)g.A + (size_t)nxt.pm * tsA : cA; const char* nB = has_next ? (const char*)g.Bt + (size_t)nxt.pn * tsB : cB;
        for (int t = 0; t < nt; t += 2) {
            const bool last = (t == nt - 2);
            const char* a1 = cA + (size_t)(t + 1) * kstep;
            const char* a2 = last ? nA : cA + (size_t)(t + 2) * kstep; const char* b2 = last ? nB : cB + (size_t)(t + 2) * kstep;
            const char* a3 = a2 + kstep; const char* b3 = b2 + kstep;
            PG8_LDB(B0, 0, 0); PG8_LDB(B1, 0, 1); PG8_SCHED; PG8_LDA(At, 0, 0); PG8_STAGE(PG8_SA(1, 1), a1 + hsA, voffA);
            PG8_WAIT_V(8); PG8_WAIT_L(0); PG8_BAR; PG8_MMA(0, 0, At, B0); PG8_MMA(0, 1, At, B1); PG8_BAR; PG8_SCHED;
            PG8_LDA(At, 0, 1); PG8_STAGE(PG8_SB(0, 0), b2, voffB); PG8_STAGE(PG8_SB(0, 1), b2 + hsB, voffB); PG8_STAGE(PG8_SA(0, 0), a2, voffA);
            PG8_WAIT_V(8); PG8_WAIT_L(0); PG8_BAR; PG8_MMA(1, 0, At, B0); PG8_MMA(1, 1, At, B1); PG8_BAR; PG8_SCHED;
            PG8_LDB(B0, 1, 0); PG8_LDB(B1, 1, 1); PG8_SCHED; PG8_LDA(At, 1, 0); PG8_STAGE(PG8_SA(0, 1), a2 + hsA, voffA);
            PG8_WAIT_V(8); PG8_WAIT_L(0); PG8_BAR; PG8_MMA(0, 0, At, B0); PG8_MMA(0, 1, At, B1); PG8_BAR; PG8_SCHED;
            PG8_LDA(At, 1, 1); PG8_STAGE(PG8_SB(1, 0), b3, voffB); PG8_STAGE(PG8_SB(1, 1), b3 + hsB, voffB); PG8_STAGE(PG8_SA(1, 0), a3, voffA);
            PG8_WAIT_V(8); PG8_WAIT_L(0); PG8_BAR; PG8_MMA(1, 0, At, B0); PG8_MMA(1, 1, At, B1); PG8_BAR; PG8_SCHED;
        }
        if (wr == 0) PG8_BAR;
        { const int ln_ = olane(); E(acc, cur, wr, wc, ln_ & 15, ln_ >> 4); }
        if (!has_next) break;
#pragma unroll
        for (int a = 0; a < 2; ++a)
#pragma unroll
            for (int b = 0; b < 2; ++b)
#pragma unroll
                for (int m = 0; m < 4; ++m)
#pragma unroll
                    for (int n = 0; n < 2; ++n) acc[a][b][m][n] = (f32x4){0.f, 0.f, 0.f, 0.f};
        cur = nxt; cA = nA; cB = nB; ++ui;
        if (wr == 1) PG8_BAR;
    }
    PG8_WAIT_V(0);
    PG8_BAR;
#undef PG8_SA
#undef PG8_SB
#undef PG8_STAGE
#undef PG8_LDA
#undef PG8_LDB
#undef PG8_MMA
#undef PG8_WAIT_V
#undef PG8_WAIT_L
#undef PG8_BAR
#undef PG8_SCHED
}
}
typedef const f32x4 (&AccRef)[2][2][4][2];

DI float row_rstd16(const float* P, int row) {
    const f32x4* p = (const f32x4*)(P + (size_t)row * 16);
    const float s = (sum4(p[0]) + sum4(p[1])) + (sum4(p[2]) + sum4(p[3]));
    return rsqrtf(s * (1.0f / 1024.0f) + EPS);
}
DI float row_ssq_q(const float* Pq, int stride, int nq, int row, int fq) {
    float s = 0.f;
    if (fq < nq) s = sum4(*(const f32x4*)(Pq + (size_t)row * stride + 4 * fq));
    s += __shfl_xor(s, 16); s += __shfl_xor(s, 32);
    return s;
}
DI u32x4 pk16(f32x4 v0, f32x4 v1) { u32x4 w; w.x = cvt_pk(v0[0], v0[1]); w.y = cvt_pk(v0[2], v0[3]); w.z = cvt_pk(v1[0], v1[1]); w.w = cvt_pk(v1[2], v1[3]); return w; }
DI u32x2 pk8(f32x4 v) { u32x2 w; w.x = cvt_pk(v[0], v[1]); w.y = cvt_pk(v[2], v[3]); return w; }

struct EpiA { static constexpr bool PERM = true;
    const float* P; bf16_t* zA; bf16_t* zB; bf16_t* zC; float* PA;
    DI void operator()(AccRef acc, const pg8::Unit& u, int wr, int wc, int fr, int fq) const {
        const int pn = u.pn; bf16_t* base; int ld, colt;
        if (pn < 3) { base = zA; ld = 768; colt = pn * 256; } else if (pn < 11) { base = zB; ld = 2048; colt = (pn - 3) * 256; } else { base = zC; ld = 1024; colt = (pn - 11) * 256; }
        const int row0 = u.pm * 256 + wr * 64 + fr, col0 = colt + wc * 32 + 8 * fq;
float rsv[2][4];
#pragma unroll
        for (int ai = 0; ai < 2; ++ai)
#pragma unroll
            for (int m = 0; m < 4; ++m) rsv[ai][m] = rsqrtf(row_ssq_q(P, 16, 4, row0 + ai * 128 + m * 16, fq) * (1.0f / 1024.0f) + EPS);
#pragma unroll
        for (int ai = 0; ai < 2; ++ai)
#pragma unroll
            for (int m = 0; m < 4; ++m) { const int row = row0 + ai * 128 + m * 16; const float rs = rsv[ai][m];
#pragma unroll
                for (int bj = 0; bj < 2; ++bj) { const f32x4 v0 = acc[ai][bj][m][0] * rs, v1 = acc[ai][bj][m][1] * rs;
                    if (pn < 3) { float s = dot4(v0) + dot4(v1); s += __shfl_xor(s, 16); s += __shfl_xor(s, 32); if (fq == 0) PA[(size_t)row * 32 + pn * 8 + bj * 4 + wc] = s; }
                    *(u32x4*)(base + (size_t)row * ld + col0 + bj * 128) = pk16(v0, v1); } }
    }
};
template <bool SIG> struct EpiPlain { static constexpr bool PERM = true;
    const float* P; bf16_t* O; int ldo; float scale;
    DI void operator()(AccRef acc, const pg8::Unit& u, int wr, int wc, int fr, int fq) const {
        const int row0 = u.pm * 256 + wr * 64 + fr, col0 = u.pn * 256 + wc * 32 + 8 * fq;
float rsv[2][4];
#pragma unroll
        for (int ai = 0; ai < 2; ++ai)
#pragma unroll
            for (int m = 0; m < 4; ++m) rsv[ai][m] = rsqrtf(row_ssq_q(P, 16, 4, row0 + ai * 128 + m * 16, fq) * (1.0f / 1024.0f) + EPS) * scale;
#pragma unroll
        for (int ai = 0; ai < 2; ++ai)
#pragma unroll
            for (int m = 0; m < 4; ++m) { const int row = row0 + ai * 128 + m * 16; const float rs = rsv[ai][m];
#pragma unroll
                for (int bj = 0; bj < 2; ++bj) { f32x4 v0 = acc[ai][bj][m][0] * rs, v1 = acc[ai][bj][m][1] * rs;
                    if (SIG) {
#pragma unroll
                        for (int e = 0; e < 4; ++e) { v0[e] = sigm(v0[e]); v1[e] = sigm(v1[e]); } }
                    *(u32x4*)(O + (size_t)row * ldo + col0 + bj * 128) = pk16(v0, v1); } }
    }
};
struct EpiQ { static constexpr bool PERM = false;
    const float* PA; const float* CS; bf16_t* Q;
    DI void operator()(AccRef acc, const pg8::Unit& u, int wr, int wc, int fr, int fq) const {
        const int row0 = u.pm * 256 + wr * 64 + fr;
float rsv[2][4];
#pragma unroll
        for (int ai = 0; ai < 2; ++ai)
#pragma unroll
            for (int m = 0; m < 4; ++m) rsv[ai][m] = rsqrtf(row_ssq_q(PA, 32, 3, row0 + ai * 128 + m * 16, fq) * (1.0f / 384.0f) + EPS);
#pragma unroll
        for (int ai = 0; ai < 2; ++ai)
#pragma unroll
            for (int m = 0; m < 4; ++m) { const int row = row0 + ai * 128 + m * 16;
                const float rs = rsv[ai][m];
                const f32x4 cs = *(const f32x4*)(CS + (size_t)row * 32 + 4 * fq), sn = *(const f32x4*)(CS + (size_t)row * 32 + 16 + 4 * fq);
#pragma unroll
                for (int bj = 0; bj < 2; ++bj) { const int g32 = u.pn * 8 + bj * 4 + wc;
                    f32x4 v0 = acc[ai][bj][m][0] * rs, v1 = acc[ai][bj][m][1] * rs;
                    if ((g32 % 3) == 2) { const f32x4 y0 = v0 * cs - v1 * sn, y1 = v0 * sn + v1 * cs; v0 = y0; v1 = y1; }
                    v0 = v0 * QSC; v1 = v1 * QSC;
                    bf16_t* o = Q + (size_t)row * 768 + u.pn * 256 + bj * 128 + wc * 32 + 4 * fq;
                    *(u32x2*)(o) = pk8(v0); *(u32x2*)(o + 16) = pk8(v1); } }
    }
};
struct EpiKV { static constexpr bool PERM = true;
    const float* PA; bf16_t* Kn; bf16_t* Vt;
    DI void operator()(AccRef acc, const pg8::Unit& u, int wr, int wc, int fr, int fq) const {
        const int row0 = u.pm * 256 + wr * 64 + fr;
float rsv[2][4];
#pragma unroll
        for (int ai = 0; ai < 2; ++ai)
#pragma unroll
            for (int m = 0; m < 4; ++m) rsv[ai][m] = rsqrtf(row_ssq_q(PA + 12, 32, 2, row0 + ai * 128 + m * 16, fq) * (1.0f / 256.0f) + EPS);
#pragma unroll
        for (int ai = 0; ai < 2; ++ai)
#pragma unroll
            for (int m = 0; m < 4; ++m) { const int row = row0 + ai * 128 + m * 16;
                const float rs = rsv[ai][m];
                const int b = row / SEQ, tok = row % SEQ;
#pragma unroll
                for (int bj = 0; bj < 2; ++bj) { const int h = 2 * u.pn + bj;
                    const f32x4 v0 = acc[ai][bj][m][0] * rs, v1 = acc[ai][bj][m][1] * rs;
                    if (wc < 2) { *(u32x4*)(Kn + (size_t)row * 512 + h * 64 + wc * 32 + 8 * fq) = pk16(v0, v1); }
                    else { bf16_t* vp = Vt + ((size_t)(b * 8 + h) * 64 + (wc - 2) * 32 + 8 * fq) * SEQ + tok;
#pragma unroll
                        for (int e = 0; e < 4; ++e) { vp[(size_t)e * SEQ] = f2bf(v0[e]); vp[(size_t)(4 + e) * SEQ] = f2bf(v1[e]); } } } }
    }
};
struct EpiBr { static constexpr bool PERM = true;
    const bf16_t* G; bf16_t* MX; int j;
    DI void operator()(AccRef acc, const pg8::Unit& u, int wr, int wc, int fr, int fq) const {
        const int row0 = u.pm * 256 + wr * 64 + fr, col0 = u.pn * 256 + wc * 32 + 8 * fq;
#pragma unroll
        for (int ai = 0; ai < 2; ++ai) {
            u32x4 gw[4][2], ow[4][2];
#pragma unroll
            for (int m = 0; m < 4; ++m)
#pragma unroll
                for (int bj = 0; bj < 2; ++bj) { const int row = row0 + ai * 128 + m * 16, col = col0 + bj * 128;
                    gw[m][bj] = *(const u32x4*)(G + (size_t)row * 3072 + j * 1024 + col);
                    ow[m][bj] = (j > 0) ? *(const u32x4*)(MX + (size_t)row * 1024 + col) : (u32x4){0u, 0u, 0u, 0u}; }
#pragma unroll
            for (int m = 0; m < 4; ++m)
#pragma unroll
                for (int bj = 0; bj < 2; ++bj) { const int row = row0 + ai * 128 + m * 16, col = col0 + bj * 128;
                    const u32x4 g4 = gw[m][bj], o4 = ow[m][bj];
                    f32x4 v0 = acc[ai][bj][m][0], v1 = acc[ai][bj][m][1];
                    v0[0] = v0[0] * bflo(g4.x) + bflo(o4.x); v0[1] = v0[1] * bfhi(g4.x) + bfhi(o4.x); v0[2] = v0[2] * bflo(g4.y) + bflo(o4.y); v0[3] = v0[3] * bfhi(g4.y) + bfhi(o4.y);
                    v1[0] = v1[0] * bflo(g4.z) + bflo(o4.z); v1[1] = v1[1] * bfhi(g4.z) + bfhi(o4.z); v1[2] = v1[2] * bflo(g4.w) + bflo(o4.w); v1[3] = v1[3] * bfhi(g4.w) + bfhi(o4.w);
                    *(u32x4*)(MX + (size_t)row * 1024 + col) = pk16(v0, v1); }
        }
    }
};
struct EpiRes { static constexpr bool PERM = false;
    const float* xin; float* xout; bf16_t* xb; float* P;
    DI void operator()(AccRef acc, const pg8::Unit& u, int wr, int wc, int fr, int fq) const {
        const int row0 = u.pm * 256 + wr * 64 + fr, col0 = u.pn * 256 + wc * 32 + 4 * fq;
#pragma unroll
        for (int ai = 0; ai < 2; ++ai)
#pragma unroll
            for (int mh = 0; mh < 2; ++mh) {
                f32x4 xv[2][2][2];
#pragma unroll
                for (int mm = 0; mm < 2; ++mm)
#pragma unroll
                    for (int bj = 0; bj < 2; ++bj)
#pragma unroll
                        for (int n = 0; n < 2; ++n) xv[mm][bj][n] = *(const f32x4*)(xin + (size_t)(row0 + ai * 128 + (2 * mh + mm) * 16) * 1024 + col0 + bj * 128 + n * 16);
#pragma unroll
                for (int mm = 0; mm < 2; ++mm) { const int m = 2 * mh + mm; const int row = row0 + ai * 128 + m * 16; float s = 0.f;
#pragma unroll
                    for (int bj = 0; bj < 2; ++bj)
#pragma unroll
                        for (int n = 0; n < 2; ++n) { const size_t off = (size_t)row * 1024 + col0 + bj * 128 + n * 16;
                            const f32x4 xo = xv[mm][bj][n] + acc[ai][bj][m][n];
                            *(f32x4*)(xout + off) = xo; *(u32x2*)(xb + off) = pk8(xo); s += dot4(xo); }
                    s += __shfl_xor(s, 16); s += __shfl_xor(s, 32);
                    if (fq == 0) P[(size_t)row * 16 + u.pn * 4 + wc] = s; }
            }
    }
};
struct EpiKVm { static constexpr bool PERM = true;
    const float* mrstd; bf16_t* Km; bf16_t* Vmt;
    DI void operator()(AccRef acc, const pg8::Unit& u, int wr, int wc, int fr, int fq) const {
        const int row0 = u.pm * 256 + wr * 64 + fr;
#pragma unroll
        for (int ai = 0; ai < 2; ++ai)
#pragma unroll
            for (int m = 0; m < 4; ++m) { const int row = row0 + ai * 128 + m * 16; const float rs = mrstd[row];
                const int b = row >> 8, key = row & 255;
#pragma unroll
                for (int bj = 0; bj < 2; ++bj) { const f32x4 v0 = acc[ai][bj][m][0] * rs, v1 = acc[ai][bj][m][1] * rs;
                    const int c = u.pn * 256 + bj * 128 + wc * 32 + 8 * fq;
                    if (u.pn < 4) { *(u32x4*)(Km + (size_t)row * 1024 + c) = pk16(v0, v1); }
                    else { const int c2 = c - 1024, h = c2 >> 8, dv = c2 & 255;
                        bf16_t* vp = Vmt + ((size_t)(b * 4 + h) * 256 + dv) * 256 + key;
#pragma unroll
                        for (int e = 0; e < 4; ++e) { vp[e * 256] = f2bf(v0[e]); vp[(4 + e) * 256] = f2bf(v1[e]); } } } }
    }
};
struct EpiFF { static constexpr bool PERM = false;
    const float* P; bf16_t* ACT;
    DI void operator()(AccRef acc, const pg8::Unit& u, int wr, int wc, int fr, int fq) const {
        const int row0 = u.pm * 256 + wr * 64 + fr;
float rsv[2][4];
#pragma unroll
        for (int ai = 0; ai < 2; ++ai)
#pragma unroll
            for (int m = 0; m < 4; ++m) rsv[ai][m] = rsqrtf(row_ssq_q(P, 16, 4, row0 + ai * 128 + m * 16, fq) * (1.0f / 1024.0f) + EPS);
#pragma unroll
        for (int ai = 0; ai < 2; ++ai)
#pragma unroll
            for (int m = 0; m < 4; ++m) { const int row = row0 + ai * 128 + m * 16; const float rs = rsv[ai][m];
#pragma unroll
                for (int bj = 0; bj < 2; ++bj) { const int G = u.pn * 8 + bj * 4 + wc;
                    const f32x4 gt = acc[ai][bj][m][0] * rs, up = acc[ai][bj][m][1] * rs; f32x4 a;
#pragma unroll
                    for (int e = 0; e < 4; ++e) a[e] = gt[e] * sigm(gt[e]) * up[e];
                    *(u32x2*)(ACT + (size_t)row * DFF + 16 * G + 4 * fq) = pk8(a); } }
    }
};

DI int srccol(int mode, int np) {
    if (mode == 1) return np < 672 ? np : (np < 768 ? -1 : np - 96);
    if (mode == 2) { const int G = np >> 5, s = (np >> 4) & 1, j = np & 15; return s * DFF + 16 * G + j; }
    return np;
}
DI void conv_item(const float* W, int K, int N, int Np, int mode, const float* gain, bf16_t* WT, LAS float* scr, int item, int lane) {
    const int nblk = Np / 64, kb = item / nblk, nb = item % nblk, k0 = 64 * kb, n0 = 64 * nb;
    const int r = lane >> 4, c4 = (lane & 15) * 4;
    const int sc = srccol(mode, n0 + c4);
    f32x4 v[16];
#pragma unroll
    for (int i = 0; i < 16; ++i) v[i] = (sc >= 0) ? *(const f32x4*)(W + (size_t)(k0 + 4 * i + r) * N + sc) : (f32x4){0.f, 0.f, 0.f, 0.f};
#pragma unroll
    for (int i = 0; i < 16; ++i) { const int row = 4 * i + r; const float gn = gain ? gain[k0 + row] : 1.0f; LAS float* d = scr + row * 65 + c4;
        d[0] = v[i][0] * gn; d[1] = v[i][1] * gn; d[2] = v[i][2] * gn; d[3] = v[i][3] * gn; }
    asm volatile("s_waitcnt lgkmcnt(0)" ::: "memory");
    const int c = lane & 7;
#pragma unroll
    for (int jj = 0; jj < 8; ++jj) { const int n = (lane >> 3) + 8 * jj; const LAS float* sp = scr + (8 * c) * 65 + n;
        u32x4 o; o.x = cvt_pk(sp[0 * 65], sp[1 * 65]); o.y = cvt_pk(sp[2 * 65], sp[3 * 65]); o.z = cvt_pk(sp[4 * 65], sp[5 * 65]); o.w = cvt_pk(sp[6 * 65], sp[7 * 65]);
        *(u32x4*)(WT + (size_t)(n0 + n) * K + k0 + 8 * c) = o; }
    asm volatile("s_waitcnt lgkmcnt(0)" ::: "memory");
}

DI void attn_unit(LAS unsigned char* lds, const bf16_t* Q, const bf16_t* Kn, const bf16_t* Kr, const bf16_t* Vt, bf16_t* Oa, int b, int h, int qb, int wv) {
    const int tid = otid(wv), lane = tid & 63, w = wv, l32 = lane & 31, hi = lane >> 5;
    constexpr int KST = 208, VST = 264, KBUF = 128 * KST, VBUF = 64 * VST, VOFF = 2 * KBUF;
    const size_t rowb = (size_t)b * SEQ;
    const int qrow = qb * 256 + 32 * w + l32;
    bf16x8 qf[6];
#pragma unroll
    for (int ks = 0; ks < 6; ++ks) qf[ks] = *(const bf16x8*)(Q + (rowb + qrow) * 768 + h * 96 + 16 * ks + 8 * hi);
    f32x16 o0, o1;
#pragma unroll
    for (int r = 0; r < 16; ++r) { o0[r] = 0.f; o1[r] = 0.f; }
    float mrun = -INFINITY, lrun = 0.f;
    const int NT = 2 * qb + 2, tlast = 2 * qb + (w >> 2);
    const int kkey = tid >> 3, kch = tid & 7, rkey = tid >> 2, rch = tid & 3, vdv = tid >> 4, vch = tid & 15;
    const bf16_t* gK = Kn + (rowb + kkey) * 512 + h * 64 + kch * 8;
    const bf16_t* gR = Kr + (rowb + rkey) * 32 + rch * 8;
    const bf16_t* gV = Vt + ((size_t)(b * 8 + h) * 64 + vdv) * SEQ + vch * 8;
    u32x4 rk0, rk1, rr, rv0, rv1;
#define ATT_LOAD(t) do { rk0 = *(const u32x4*)(gK + (size_t)(t) * 128 * 512); rk1 = *(const u32x4*)(gK + (size_t)(t) * 128 * 512 + 64 * 512); \
        rr = *(const u32x4*)(gR + (size_t)(t) * 128 * 32); rv0 = *(const u32x4*)(gV + (size_t)(t) * 128); rv1 = *(const u32x4*)(gV + (size_t)(t) * 128 + (size_t)32 * SEQ); } while (0)
#define ATT_STORE(kd, vd) do { *(LAS u32x4*)((kd) + kkey * KST + kch * 16) = rk0; *(LAS u32x4*)((kd) + (64 + kkey) * KST + kch * 16) = rk1; \
        *(LAS u32x4*)((kd) + rkey * KST + 128 + rch * 16) = rr; \
        *(LAS u32x2*)((vd) + vdv * VST + vch * 16) = (u32x2){rv0.x, rv0.y}; *(LAS u32x2*)((vd) + vdv * VST + vch * 16 + 8) = (u32x2){rv0.z, rv0.w}; \
        *(LAS u32x2*)((vd) + (32 + vdv) * VST + vch * 16) = (u32x2){rv1.x, rv1.y}; *(LAS u32x2*)((vd) + (32 + vdv) * VST + vch * 16 + 8) = (u32x2){rv1.z, rv1.w}; } while (0)
    ATT_LOAD(0);
    ATT_STORE(lds, lds + VOFF);
    __syncthreads();
#pragma unroll
    for (int ks = 0; ks < 6; ++ks) asm volatile("" : "+v"(qf[ks]));
    for (int t = 0; t < NT; ++t) {
        const int cur = t & 1;
        if (t + 1 < NT) ATT_LOAD(t + 1);
        if (t <= tlast) {
            const LAS unsigned char* kb_ = lds + cur * KBUF;
            const LAS unsigned char* vb_ = lds + VOFF + cur * VBUF;
            f32x16 s[4];
#pragma unroll
            for (int kb = 0; kb < 4; ++kb)
#pragma unroll
                for (int r = 0; r < 16; ++r) s[kb][r] = 0.f;
#pragma unroll
            for (int ks = 0; ks < 6; ++ks)
#pragma unroll
                for (int kb = 0; kb < 4; ++kb) {
                    const bf16x8 a = *(const LAS bf16x8*)(kb_ + (32 * kb + l32) * KST + (16 * ks + 8 * hi) * 2);
                    s[kb] = MFMA32(a, qf[ks], s[kb]);
                }
            if (t == tlast) {
#pragma unroll
                for (int kb = 0; kb < 4; ++kb)
#pragma unroll
                    for (int r = 0; r < 16; ++r) { const int key = 128 * t + 32 * kb + crow(r, hi); if (key > qrow) s[kb][r] = -INFINITY; }
            }
            float mx = fmaxf(fmaxf(s[0][0], s[1][0]), fmaxf(s[2][0], s[3][0]));
#pragma unroll
            for (int r = 1; r < 16; ++r) mx = fmaxf(mx, fmaxf(fmaxf(s[0][r], s[1][r]), fmaxf(s[2][r], s[3][r])));
            mx = fmaxf(mx, __shfl_xor(mx, 32));
            const float mnew = fmaxf(mrun, mx);
            if (__builtin_amdgcn_ballot_w64(mnew > mrun) != 0ull) {
                const float alpha = __builtin_amdgcn_exp2f(mrun - mnew);
                mrun = mnew; lrun *= alpha;
#pragma unroll
                for (int r = 0; r < 16; ++r) { o0[r] *= alpha; o1[r] *= alpha; }
            }
            float ps = 0.f;
#pragma unroll
            for (int kb = 0; kb < 4; ++kb)
#pragma unroll
                for (int r = 0; r < 16; ++r) { s[kb][r] = __builtin_amdgcn_exp2f(s[kb][r] - mrun); ps += s[kb][r]; }
            lrun += ps;
#pragma unroll
            for (int kb = 0; kb < 4; ++kb)
#pragma unroll
                for (int sub = 0; sub < 2; ++sub) {
                    const bf16x8 P = pack8(s[kb][8 * sub + 0], s[kb][8 * sub + 1], s[kb][8 * sub + 2], s[kb][8 * sub + 3], s[kb][8 * sub + 4], s[kb][8 * sub + 5], s[kb][8 * sub + 6], s[kb][8 * sub + 7]);
                    const int koff = (32 * kb + 16 * sub + 4 * hi) * 2;
                    const u32x2 a0l = *(const LAS u32x2*)(vb_ + l32 * VST + koff), a0h = *(const LAS u32x2*)(vb_ + l32 * VST + koff + 16);
                    const u32x2 a1l = *(const LAS u32x2*)(vb_ + (32 + l32) * VST + koff), a1h = *(const LAS u32x2*)(vb_ + (32 + l32) * VST + koff + 16);
                    o0 = MFMA32(mk8(a0l, a0h), P, o0); o1 = MFMA32(mk8(a1l, a1h), P, o1);
                }
        }
        if (t + 1 < NT) ATT_STORE(lds + (cur ^ 1) * KBUF, lds + VOFF + (cur ^ 1) * VBUF);
        __syncthreads();
    }
#undef ATT_LOAD
#undef ATT_STORE
    const float lt = lrun + __shfl_xor(lrun, 32);
    const float inv = 1.0f / lt;
    bf16_t* op = Oa + (rowb + qrow) * 512 + h * 64;
#pragma unroll
    for (int g = 0; g < 4; ++g) {
        u32x2 w0, w1;
        w0.x = cvt_pk(o0[4 * g] * inv, o0[4 * g + 1] * inv); w0.y = cvt_pk(o0[4 * g + 2] * inv, o0[4 * g + 3] * inv);
        w1.x = cvt_pk(o1[4 * g] * inv, o1[4 * g + 1] * inv); w1.y = cvt_pk(o1[4 * g + 2] * inv, o1[4 * g + 3] * inv);
        *(u32x2*)(op + 8 * g + 4 * hi) = w0; *(u32x2*)(op + 32 + 8 * g + 4 * hi) = w1;
    }
}

DI void xattn_unit(LAS unsigned char* lds, bf16_t* QX, const bf16_t* Km, const bf16_t* Vmt, int b, int h, int qb, int wv) {
    const int tid = otid(wv), lane = tid & 63, w = __builtin_amdgcn_readfirstlane(tid >> 6), l32 = lane & 31, hi = lane >> 5;
    constexpr int KST = 272, VST = 520, BUF = 128 * KST;
    const size_t row = (size_t)b * SEQ + qb * 256 + 32 * w + l32;
    bf16_t* qp = QX + row * 1024 + h * 256;
    f32x16 sacc[8];
#pragma unroll
    for (int i = 0; i < 8; ++i)
#pragma unroll
        for (int r = 0; r < 16; ++r) sacc[i][r] = 0.f;
    unsigned pp[8][8];
    bf16x8 qf[8];
    u32x4 pf[4];
#define XLOAD(i) do { if ((i) < 4) { const int dh_ = (i) >> 1, kt_ = (i) & 1; \
        _Pragma("unroll") for (int j = 0; j < 4; ++j) { const int id = tid + 512 * j, key = id >> 4, ch = id & 15; \
            pf[j] = *(const u32x4*)(Km + ((size_t)(b * 256 + 128 * kt_ + key)) * 1024 + h * 256 + 128 * dh_ + 8 * ch); } } \
      else { const int c_ = (i) - 4; \
        _Pragma("unroll") for (int j = 0; j < 4; ++j) { const int id = tid + 512 * j, dv = id >> 5, ch = id & 31; \
            pf[j] = *(const u32x4*)(Vmt + ((size_t)((b * 4 + h) * 256 + 64 * c_ + dv)) * 256 + 8 * ch); } } } while (0)
#define XSTORE(i, bufp) do { if ((i) < 4) { \
        _Pragma("unroll") for (int j = 0; j < 4; ++j) { const int id = tid + 512 * j, key = id >> 4, ch = id & 15; *(LAS u32x4*)((bufp) + key * KST + ch * 16) = pf[j]; } } \
      else { \
        _Pragma("unroll") for (int j = 0; j < 4; ++j) { const int id = tid + 512 * j, dv = id >> 5, ch = id & 31; \
            *(LAS u32x2*)((bufp) + dv * VST + ch * 16) = (u32x2){pf[j].x, pf[j].y}; *(LAS u32x2*)((bufp) + dv * VST + ch * 16 + 8) = (u32x2){pf[j].z, pf[j].w}; } } } while (0)
    XLOAD(0); XSTORE(0, lds);
    __syncthreads();
#pragma unroll
    for (int i = 0; i < 8; ++i) {
        const LAS unsigned char* cb_ = lds + (i & 1) * BUF;
        if (i + 1 < 8) XLOAD(i + 1);
        if (i < 4) {
            const int dh = i >> 1, kt = i & 1;
            if (kt == 0) {
#pragma unroll
                for (int ks = 0; ks < 8; ++ks) qf[ks] = *(const bf16x8*)(qp + 128 * dh + 16 * ks + 8 * hi);
            }
#pragma unroll
            for (int ks = 0; ks < 8; ++ks) {
#pragma unroll
                for (int j = 0; j < 4; ++j) {
                    const bf16x8 a0 = *(const LAS bf16x8*)(cb_ + (32 * j + l32) * KST + (16 * ks + 8 * hi) * 2);
                    sacc[4 * kt + j] = MFMA32(a0, qf[ks], sacc[4 * kt + j]);
                }
            }
            if (i == 3) {
                float mx = sacc[0][0];
#pragma unroll
                for (int j = 0; j < 8; ++j)
#pragma unroll
                    for (int r = 0; r < 16; ++r) mx = fmaxf(mx, sacc[j][r]);
                mx = fmaxf(mx, __shfl_xor(mx, 32));
                float ps = 0.f;
#pragma unroll
                for (int j = 0; j < 8; ++j)
#pragma unroll
                    for (int r = 0; r < 16; ++r) { sacc[j][r] = __builtin_amdgcn_exp2f(sacc[j][r] - mx); ps += sacc[j][r]; }
                ps += __shfl_xor(ps, 32);
                const float inv = 1.0f / ps;
#pragma unroll
                for (int j = 0; j < 8; ++j)
#pragma unroll
                    for (int r2 = 0; r2 < 8; ++r2) pp[j][r2] = cvt_pk(sacc[j][2 * r2] * inv, sacc[j][2 * r2 + 1] * inv);
            }
        } else {
            const int c = i - 4;
            f32x16 o0, o1;
#pragma unroll
            for (int r = 0; r < 16; ++r) { o0[r] = 0.f; o1[r] = 0.f; }
#pragma unroll
            for (int s = 0; s < 16; ++s) {
                const int kb = s >> 1, sub = s & 1;
                const u32x4 pw = {pp[kb][4 * sub], pp[kb][4 * sub + 1], pp[kb][4 * sub + 2], pp[kb][4 * sub + 3]};
                const bf16x8 P = __builtin_bit_cast(bf16x8, pw);
                const int koff = (32 * kb + 16 * sub + 4 * hi) * 2;
                const u32x2 a0l = *(const LAS u32x2*)(cb_ + l32 * VST + koff), a0h = *(const LAS u32x2*)(cb_ + l32 * VST + koff + 16);
                const u32x2 a1l = *(const LAS u32x2*)(cb_ + (32 + l32) * VST + koff), a1h = *(const LAS u32x2*)(cb_ + (32 + l32) * VST + koff + 16);
                o0 = MFMA32(mk8(a0l, a0h), P, o0); o1 = MFMA32(mk8(a1l, a1h), P, o1);
            }
#pragma unroll
            for (int g = 0; g < 4; ++g) {
                u32x2 w0, w1;
                w0.x = cvt_pk(o0[4 * g], o0[4 * g + 1]); w0.y = cvt_pk(o0[4 * g + 2], o0[4 * g + 3]);
                w1.x = cvt_pk(o1[4 * g], o1[4 * g + 1]); w1.y = cvt_pk(o1[4 * g + 2], o1[4 * g + 3]);
                *(u32x2*)(qp + 64 * c + 8 * g + 4 * hi) = w0; *(u32x2*)(qp + 64 * c + 32 + 8 * g + 4 * hi) = w1;
            }
        }
        if (i + 1 < 8) XSTORE(i + 1, lds + ((i + 1) & 1) * BUF);
        __syncthreads();
    }
#undef XLOAD
#undef XSTORE
}

DI void memkv_tile(LAS unsigned char* lds, const bf16_t* memb, const bf16_t* Wt, const float* mrstd, bf16_t* Km, bf16_t* Vmt, int tile, int wv) {
    const int tid = otid(wv), lane = tid & 63, w = wv, l32 = lane & 31, hi = lane >> 5;
    const int r0 = (tile >> 5) * 64, c0 = (tile & 31) * 64;
    f32x16 acc[2][2];
#pragma unroll
    for (int i = 0; i < 2; ++i)
#pragma unroll
        for (int j = 0; j < 2; ++j)
#pragma unroll
            for (int r = 0; r < 16; ++r) acc[i][j][r] = 0.f;
    const bf16_t* ap = memb + (size_t)(r0 + l32) * 1024 + 128 * w + 8 * hi;
    const bf16_t* bp = Wt + (size_t)(c0 + l32) * 1024 + 128 * w + 8 * hi;
#pragma unroll
    for (int ks = 0; ks < 8; ++ks) {
        const bf16x8 a0 = *(const bf16x8*)(ap + 16 * ks), a1 = *(const bf16x8*)(ap + 32 * 1024 + 16 * ks);
        const bf16x8 b0 = *(const bf16x8*)(bp + 16 * ks), b1 = *(const bf16x8*)(bp + 32 * 1024 + 16 * ks);
        acc[0][0] = MFMA32(b0, a0, acc[0][0]); acc[0][1] = MFMA32(b1, a0, acc[0][1]);
        acc[1][0] = MFMA32(b0, a1, acc[1][0]); acc[1][1] = MFMA32(b1, a1, acc[1][1]);
    }
    LAS float* red = (LAS float*)lds;
#pragma unroll
    for (int i = 0; i < 2; ++i)
#pragma unroll
        for (int j = 0; j < 2; ++j)
#pragma unroll
            for (int r = 0; r < 16; ++r) red[((w * 4 + i * 2 + j) * 16 + r) * 64 + lane] = acc[i][j][r];
    LBAR();
#pragma unroll
    for (int q = 0; q < 8; ++q) {
        const int idx = tid + 512 * q, ln = idx & 63, r = (idx >> 6) & 15, blk = idx >> 10;
        float s = 0.f;
#pragma unroll
        for (int ww = 0; ww < 8; ++ww) s += red[ww * 4096 + idx];
        const int i = blk >> 1, j = blk & 1;
        const int col = c0 + 32 * j + crow(r, ln >> 5), row = r0 + 32 * i + (ln & 31);
        const float val = s * mrstd[row];
        if (col < 1024) Km[(size_t)row * 1024 + col] = f2bf(val);
        else { const int c2 = col - 1024, h = c2 >> 8, dv = c2 & 255, b = row >> 8, key = row & 255; Vmt[((size_t)(b * 4 + h) * 256 + dv) * 256 + key] = f2bf(val); }
    }
    LBAR();
}

DI void gmlp_unit(LAS unsigned char* lds, bf16_t* zC, const float* ln_g, const float* ln_b, const float* w_s, const float* b_s, int chunk, int gp, int wv) {
    const int tid = otid(wv), lane = tid & 63, w = __builtin_amdgcn_readfirstlane(tid >> 6), l32 = lane & 31, hi = lane >> 5;
    constexpr int VST = 272;
    const size_t row0 = (size_t)chunk * 128;
    LAS bf16_t* vnT = (LAS bf16_t*)lds;
    {
        f32x4 lg0, lg1, lb0, lb1;
        lg0 = *(const f32x4*)(ln_g + 8 * lane); lg1 = *(const f32x4*)(ln_g + 8 * lane + 4);
        lb0 = *(const f32x4*)(ln_b + 8 * lane); lb1 = *(const f32x4*)(ln_b + 8 * lane + 4);
        u32x4 rawv[16];
#pragma unroll
        for (int tt = 0; tt < 16; ++tt) rawv[tt] = *(const u32x4*)(zC + (row0 + 16 * w + tt) * 1024 + 512 + 8 * lane);
#pragma unroll
        for (int tt = 0; tt < 16; ++tt) {
            const int t = 16 * w + tt;
            const u32x4 raw = rawv[tt];
            float x[8];
            x[0] = gelu_erf(bflo(raw.x)); x[1] = gelu_erf(bfhi(raw.x)); x[2] = gelu_erf(bflo(raw.y)); x[3] = gelu_erf(bfhi(raw.y));
            x[4] = gelu_erf(bflo(raw.z)); x[5] = gelu_erf(bfhi(raw.z)); x[6] = gelu_erf(bflo(raw.w)); x[7] = gelu_erf(bfhi(raw.w));
            float s = 0.f;
#pragma unroll
            for (int e = 0; e < 8; ++e) s += x[e];
            const float mean = wave_sum(s) * (1.0f / 512.0f);
            float q = 0.f;
#pragma unroll
            for (int e = 0; e < 8; ++e) { x[e] -= mean; q += x[e] * x[e]; }
            const float rstd = rsqrtf(wave_sum(q) * (1.0f / 512.0f) + EPS);
            if ((lane >> 5) == gp) {
                const int cl = 8 * (lane & 15) + 128 * ((lane >> 4) & 1);
                vnT[(cl + 0) * (VST / 2) + t] = f2bf(x[0] * rstd * lg0[0] + lb0[0]); vnT[(cl + 1) * (VST / 2) + t] = f2bf(x[1] * rstd * lg0[1] + lb0[1]);
                vnT[(cl + 2) * (VST / 2) + t] = f2bf(x[2] * rstd * lg0[2] + lb0[2]); vnT[(cl + 3) * (VST / 2) + t] = f2bf(x[3] * rstd * lg0[3] + lb0[3]);
                vnT[(cl + 4) * (VST / 2) + t] = f2bf(x[4] * rstd * lg1[0] + lb1[0]); vnT[(cl + 5) * (VST / 2) + t] = f2bf(x[5] * rstd * lg1[1] + lb1[1]);
                vnT[(cl + 6) * (VST / 2) + t] = f2bf(x[6] * rstd * lg1[2] + lb1[2]); vnT[(cl + 7) * (VST / 2) + t] = f2bf(x[7] * rstd * lg1[3] + lb1[3]);
            }
        }
    }
    LBAR();
#pragma unroll 1
    for (int gl = 0; gl < 2; ++gl) {
        const int g = 2 * gp + gl; const LAS unsigned char* vb_ = lds + gl * 128 * VST;
        const int tb = w >> 1, cb0 = 2 * (w & 1);
        f32x16 a0, a1;
#pragma unroll
        for (int r = 0; r < 16; ++r) { a0[r] = 0.f; a1[r] = 0.f; }
        const int trow = 32 * tb + l32;
        const float* wrow = w_s + ((size_t)(g * 128 + trow)) * 128;
        f32x4 wq0[8], wq1[8];
#pragma unroll
        for (int ks = 0; ks < 8; ++ks) { wq0[ks] = (f32x4){0.f, 0.f, 0.f, 0.f}; wq1[ks] = wq0[ks];
            if (ks <= 2 * tb + 1) { wq0[ks] = *(const f32x4*)(wrow + 16 * ks + 8 * hi); wq1[ks] = *(const f32x4*)(wrow + 16 * ks + 8 * hi + 4); } }
#pragma unroll
        for (int ks = 0; ks < 8; ++ks) {
            if (ks > 2 * tb + 1) break;
            const int s0 = 16 * ks + 8 * hi;
            f32x4 w0 = wq0[ks], w1 = wq1[ks];
#pragma unroll
            for (int e = 0; e < 4; ++e) { if (s0 + e > trow) w0[e] = 0.f; if (s0 + 4 + e > trow) w1[e] = 0.f; }
            const bf16x8 A = pack8(w0[0], w0[1], w0[2], w0[3], w1[0], w1[1], w1[2], w1[3]);
            const bf16x8 B0 = *(const LAS bf16x8*)(vb_ + (32 * cb0 + l32) * VST + s0 * 2);
            const bf16x8 B1 = *(const LAS bf16x8*)(vb_ + (32 * (cb0 + 1) + l32) * VST + s0 * 2);
            a0 = MFMA32(A, B0, a0); a1 = MFMA32(A, B1, a1);
        }
#pragma unroll
        for (int r = 0; r < 16; ++r) {
            const int t = 32 * tb + crow(r, hi);
            const float bs = b_s[g * 128 + t];
            bf16_t* up0 = zC + (row0 + t) * 1024 + g * 128 + 32 * cb0 + l32;
            const float u0 = gelu_erf(bf2f(up0[0])), u1 = gelu_erf(bf2f(up0[32]));
            up0[0] = f2bf((a0[r] + bs) * u0); up0[32] = f2bf((a1[r] + bs) * u1);
        }
    }
    LBAR();
}

#define HG_IDS() \
    const int k = tid & 127, seg = tid >> 7; \
    const size_t row0 = (size_t)b * SEQ + (size_t)c * 64 + 16 * seg; \
    bf16_t hfr[16], vrw[16]; \
    _Pragma("unroll") for (int i = 0; i < 16; ++i) { hfr[i] = zB[(row0 + i) * 2048 + 512 + h * 128 + k]; vrw[i] = zB[(row0 + i) * 2048 + 1024 + h * 128 + k]; }
#define HG_PREP() \
    float cum[16], kv[16]; float bref, blast; \
    { const float lb = lbv[h * 128 + k]; float run = 0.f; \
      _Pragma("unroll") for (int i = 0; i < 16; ++i) { const float fr_ = bf2f(hfr[i]); \
          const float e_ = __expf(-fr_), sg_ = __builtin_amdgcn_rcpf(1.f + e_); const float f_ = lb + (1.f - lb) * sg_; \
          run += __logf(f_); cum[i] = run; kv[i] = (1.f - lb) * e_ * sg_; } \
      segs[seg * 128 + k] = run; LBAR(); \
      const float s0_ = segs[k], s1_ = segs[128 + k], s2_ = segs[256 + k], s3_ = segs[384 + k]; \
      const float off_ = (seg > 0 ? s0_ : 0.f) + (seg > 1 ? s1_ : 0.f) + (seg > 2 ? s2_ : 0.f); \
      bref = s0_ + s1_; blast = (s0_ + s1_) + (s2_ + s3_); \
      _Pragma("unroll") for (int i = 0; i < 16; ++i) cum[i] += off_; }

constexpr int HG_QR = 0, HG_KR = 17408, HG_QD = 34816, HG_VT = 52224, HG_KDT = 70656, HG_SEG = 89088, HG_SSL = 91136;

DI void hg_u_unit(LAS unsigned char* lds, const bf16_t* zB, const float* lbv, bf16_t* ST, float* dC, int b, int h, int c, int wv) {
    const int tid = otid(wv), lane = tid & 63, w = __builtin_amdgcn_readfirstlane(tid >> 6), l32 = lane & 31, hi = lane >> 5;
    LAS float* segs = (LAS float*)(lds + HG_SEG);
    HG_IDS();
    HG_PREP();
    const int unit = (b * 4 + h) * 128 + c;
    {
        float kd[16]; unsigned vr[8];
#pragma unroll
        for (int i = 0; i < 16; ++i) kd[i] = kv[i] * __expf(blast - cum[i]);
#pragma unroll
        for (int i = 0; i < 8; ++i) { const unsigned lo = vrw[2 * i], hi2 = vrw[2 * i + 1]; vr[i] = lo | (hi2 << 16); }
        LAS unsigned char* kp = lds + HG_KDT + k * 144 + seg * 32;
        *(LAS u32x4*)kp = (u32x4){cvt_pk(kd[0], kd[1]), cvt_pk(kd[2], kd[3]), cvt_pk(kd[4], kd[5]), cvt_pk(kd[6], kd[7])};
        *(LAS u32x4*)(kp + 16) = (u32x4){cvt_pk(kd[8], kd[9]), cvt_pk(kd[10], kd[11]), cvt_pk(kd[12], kd[13]), cvt_pk(kd[14], kd[15])};
        LAS unsigned char* vp = lds + HG_VT + k * 144 + seg * 32;
        *(LAS u32x4*)vp = (u32x4){vr[0], vr[1], vr[2], vr[3]};
        *(LAS u32x4*)(vp + 16) = (u32x4){vr[4], vr[5], vr[6], vr[7]};
        if (seg == 0) dC[(size_t)unit * 128 + k] = __expf(blast);
    }
    LBAR();
    {
        const int vb = w & 3;
#pragma unroll
        for (int kbi = 0; kbi < 2; ++kbi) {
            const int kb = 2 * (w >> 2) + kbi;
            f32x16 acc;
#pragma unroll
            for (int r = 0; r < 16; ++r) acc[r] = 0.f;
#pragma unroll
            for (int ks = 0; ks < 4; ++ks) {
                const bf16x8 A = *(const LAS bf16x8*)(lds + HG_VT + (32 * vb + l32) * 144 + (16 * ks + 8 * hi) * 2);
                const bf16x8 B = *(const LAS bf16x8*)(lds + HG_KDT + (32 * kb + l32) * 144 + (16 * ks + 8 * hi) * 2);
                acc = MFMA32(A, B, acc);
            }
            bf16_t* sp = ST + (size_t)unit * 16384 + 32 * kb + l32;
#pragma unroll
            for (int r = 0; r < 16; ++r) sp[(32 * vb + crow(r, hi)) * 128] = f2bf(acc[r]);
        }
    }
    LBAR();
}

DI void hg_out_unit(LAS unsigned char* lds, const bf16_t* zB, const float* lbv, const bf16_t* ST, const float* hnorm, bf16_t* Ob, int b, int h, int c, int wv) {
    const int tid = otid(wv), lane = tid & 63, w = __builtin_amdgcn_readfirstlane(tid >> 6), l32 = lane & 31, hi = lane >> 5;
    LAS float* segs = (LAS float*)(lds + HG_SEG);
    LAS float* ssl = (LAS float*)(lds + HG_SSL);
    HG_IDS();
    const int unit = (b * 4 + h) * 128 + c;
    const int vb = w & 3, tb = w >> 2;
    bf16_t hqr[16];
#pragma unroll
    for (int i = 0; i < 16; ++i) hqr[i] = zB[(row0 + i) * 2048 + h * 128 + k];
    bf16x8 stf[8];
    {
        const bf16_t* sp = ST + (size_t)unit * 16384 + (size_t)(32 * vb + l32) * 128 + 8 * hi;
#pragma unroll
        for (int ks = 0; ks < 8; ++ks) stf[ks] = *(const bf16x8*)(sp + 16 * ks);
    }
    u32x2 grw[4];
    {
        const size_t rowg = (size_t)b * SEQ + (size_t)c * 64 + 32 * tb + l32;
#pragma unroll
        for (int g = 0; g < 4; ++g) grw[g] = *(const u32x2*)(zB + rowg * 2048 + 1536 + h * 128 + 32 * vb + 8 * g + 4 * hi);
    }
    HG_PREP();
    {
        LAS bf16_t* Qr = (LAS bf16_t*)(lds + HG_QR); LAS bf16_t* Kr = (LAS bf16_t*)(lds + HG_KR); LAS bf16_t* Qd = (LAS bf16_t*)(lds + HG_QD);
        unsigned vr[8];
#pragma unroll
        for (int i = 0; i < 16; ++i) { const int t = 16 * seg + i;
            const float qraw = bf2f(hqr[i]); const float q = qraw * sigm(qraw);
            Qr[t * 136 + k] = f2bf(q * __expf(cum[i] - bref)); Kr[t * 136 + k] = f2bf(kv[i] * __expf(bref - cum[i])); Qd[t * 136 + k] = f2bf(q * __expf(cum[i])); }
#pragma unroll
        for (int i = 0; i < 8; ++i) { const unsigned lo = vrw[2 * i], hi2 = vrw[2 * i + 1]; vr[i] = lo | (hi2 << 16); }
        LAS unsigned char* vp = lds + HG_VT + k * 144 + seg * 32;
        *(LAS u32x4*)vp = (u32x4){vr[0], vr[1], vr[2], vr[3]};
        *(LAS u32x4*)(vp + 16) = (u32x4){vr[4], vr[5], vr[6], vr[7]};
    }
    LBAR();
    f32x16 o;
#pragma unroll
    for (int r = 0; r < 16; ++r) o[r] = 0.f;
    {
#pragma unroll
        for (int ks = 0; ks < 8; ++ks) {
            const bf16x8 A = stf[ks];
            const bf16x8 B = *(const LAS bf16x8*)(lds + HG_QD + (32 * tb + l32) * 272 + (16 * ks + 8 * hi) * 2);
            o = MFMA32(A, B, o);
        }
    }
#pragma unroll
    for (int sb = 0; sb < 2; ++sb) {
        if (sb <= tb) {
            f32x16 at;
#pragma unroll
            for (int r = 0; r < 16; ++r) at[r] = 0.f;
#pragma unroll
            for (int ks = 0; ks < 8; ++ks) {
                const bf16x8 A = *(const LAS bf16x8*)(lds + HG_KR + (32 * sb + l32) * 272 + (16 * ks + 8 * hi) * 2);
                const bf16x8 B = *(const LAS bf16x8*)(lds + HG_QR + (32 * tb + l32) * 272 + (16 * ks + 8 * hi) * 2);
                at = MFMA32(A, B, at);
            }
            if (sb == tb) {
#pragma unroll
                for (int r = 0; r < 16; ++r) if (crow(r, hi) > l32) at[r] = 0.f;
            }
#pragma unroll
            for (int sub = 0; sub < 2; ++sub) {
                const bf16x8 P = pack8(at[8 * sub + 0], at[8 * sub + 1], at[8 * sub + 2], at[8 * sub + 3], at[8 * sub + 4], at[8 * sub + 5], at[8 * sub + 6], at[8 * sub + 7]);
                const int koff = (32 * sb + 16 * sub + 4 * hi) * 2;
                const u32x2 al = *(const LAS u32x2*)(lds + HG_VT + (32 * vb + l32) * 144 + koff), ah = *(const LAS u32x2*)(lds + HG_VT + (32 * vb + l32) * 144 + koff + 16);
                o = MFMA32(mk8(al, ah), P, o);
            }
        }
    }
    float ss = 0.f;
#pragma unroll
    for (int r = 0; r < 16; ++r) ss += o[r] * o[r];
    ss += __shfl_xor(ss, 32);
    if (hi == 0) ssl[vb * 64 + 32 * tb + l32] = ss;
    LBAR();
    {
        const int t = 32 * tb + l32;
        const float tot = (ssl[t] + ssl[64 + t]) + (ssl[128 + t] + ssl[192 + t]);
        const float rstd = rsqrtf(tot * (1.0f / 128.0f) + EPS);
        const size_t row = (size_t)b * SEQ + (size_t)c * 64 + t;
#pragma unroll
        for (int g = 0; g < 4; ++g) {
            const int v0 = 32 * vb + 8 * g + 4 * hi;
            const u32x2 gr = grw[g];
            const f32x4 hn = *(const f32x4*)(hnorm + v0);
            const float g0 = bflo(gr.x), g1 = bfhi(gr.x), g2 = bflo(gr.y), g3 = bfhi(gr.y);
            u32x2 ow;
            ow.x = cvt_pk(o[4 * g] * rstd * hn[0] * (g0 * sigm(g0)), o[4 * g + 1] * rstd * hn[1] * (g1 * sigm(g1)));
            ow.y = cvt_pk(o[4 * g + 2] * rstd * hn[2] * (g2 * sigm(g2)), o[4 * g + 3] * rstd * hn[3] * (g3 * sigm(g3)));
            *(u32x2*)(Ob + row * 512 + h * 128 + v0) = ow;
        }
    }
    LBAR();
}


#define XB_TMO      128
#define XB_XCNT(j)  (256  + 64 * (j))
#define XB_XSUB(j)  (1280 + 64 * (j))
#define XB_XGEN(j)  (2304 + 64 * (j))
#define XB_TOP      3328
#define XB_TOPGEN   3392
#define XCD_BAR_WORDS 3456
#define XB_SPIN_CAP (1u << 18)
DI unsigned xb_ld(unsigned* p)              { return __hip_atomic_load(p, __ATOMIC_RELAXED, __HIP_MEMORY_SCOPE_AGENT); }
DI unsigned xb_add(unsigned* p, unsigned v) { return __hip_atomic_fetch_add(p, v, __ATOMIC_RELAXED, __HIP_MEMORY_SCOPE_AGENT); }
DI unsigned xb_xcc_id() { return (unsigned)__builtin_amdgcn_s_getreg((3 << 11) | 20) & 0xFu; }
#define XB_SPIN(cond, bar) do { unsigned _sp = 0; while (cond) { __builtin_amdgcn_s_sleep(1); \
    if ((++_sp & 255u) == 0u) { if (xb_ld(&(bar)[XB_TMO])) break; if (_sp > XB_SPIN_CAP) { atomicAdd(&(bar)[XB_TMO], 1u); break; } } } } while (0)
DI void xcd_barrier_complete(unsigned* bar, unsigned x, unsigned& nloc, unsigned& nx) {
    const unsigned G = gridDim.x * gridDim.y * gridDim.z;
    unsigned sum, cnt, mine, sp = 0u;
    for (;;) {
        sum = 0u; cnt = 0u; mine = 0u;
#pragma unroll
        for (unsigned j = 0; j < 16; ++j) { const unsigned c = xb_ld(&bar[XB_XCNT(j)]); sum += c; cnt += (c > 0u) ? 1u : 0u; mine = (j == x) ? c : mine; }
        if (sum == G) break;
        __builtin_amdgcn_s_sleep(1);
        if ((++sp & 255u) == 0u) { if (xb_ld(&bar[XB_TMO])) break; if (sp > XB_SPIN_CAP) { atomicAdd(&bar[XB_TMO], 1u); break; } }
    }
    nloc = mine > 0u ? mine : 1u; nx = cnt > 0u ? cnt : 1u;
}
DI void xcd_barrier(unsigned* bar, volatile LAS unsigned* st) {
    asm volatile("s_waitcnt vmcnt(0)" ::: "memory");
    __syncthreads();
    if (threadIdx.x == 0) {
        const unsigned x = xb_xcc_id();
        __builtin_amdgcn_s_waitcnt(0);
        unsigned nloc = st[0], nx = st[1];
        if (nloc == 0u) { xcd_barrier_complete(bar, x, nloc, nx); st[0] = nloc; st[1] = nx; }
        const unsigned old = xb_add(&bar[XB_XSUB(x)], 1u);
        const unsigned gen = old / nloc;
        if (old + 1u == (gen + 1u) * nloc) {
            __builtin_amdgcn_fence(__ATOMIC_RELEASE, "agent");
            asm volatile("s_waitcnt vmcnt(0)" ::: "memory");
            const unsigned og = xb_add(&bar[XB_TOP], 1u);
            const unsigned tg = og / nx;
            if (og + 1u == (tg + 1u) * nx) xb_add(&bar[XB_TOPGEN], 1u);
            else XB_SPIN(xb_ld(&bar[XB_TOPGEN]) == tg, bar);
            __builtin_amdgcn_fence(__ATOMIC_ACQUIRE, "agent");
            xb_add(&bar[XB_XGEN(x)], 1u);
            asm volatile("s_waitcnt vmcnt(0)" ::: "memory");
        } else {
            XB_SPIN(xb_ld(&bar[XB_XGEN(x)]) == gen, bar);
            __builtin_amdgcn_fence(__ATOMIC_ACQUIRE, "agent");
            asm volatile("s_waitcnt vmcnt(0)" ::: "memory");
        }
    }
    __syncthreads();
}

constexpr size_t MiB = 1u << 20;
constexpr size_t WS_X0 = 0, WS_R2 = 32 * MiB, WS_R3 = 96 * MiB, WS_X1 = 128 * MiB, WS_R1 = 160 * MiB, WS_R4 = 184 * MiB, WS_RW = 216 * MiB;
constexpr size_t WS_CTL = 250 * MiB + 512 * 1024, CTL_BYTES = 16384;
constexpr size_t WS_P = 241 * MiB, WS_PA = 242 * MiB, WS_CS = 244 * MiB, WS_DC = 246 * MiB, WS_MEMB = 247 * MiB, WS_KM = 248 * MiB, WS_VMT = 249 * MiB, WS_MISC = 250 * MiB, WS_END = 251 * MiB;
constexpr size_t W1_IN = 0, W1_UQ = W1_IN + (size_t)6912 * 1024, W1_UKV = W1_UQ + (size_t)768 * 384, W1_BA = W1_UKV + (size_t)1024 * 256, W1_BB = W1_BA + (size_t)1024 * 512,
                 W1_BC = W1_BB + (size_t)1024 * 512, W1_MIX = W1_BC + (size_t)1024 * 512, W1_END = W1_MIX + (size_t)1024 * 1024;
constexpr size_t W2_XQ = 0, W2_XKV = W2_XQ + (size_t)1024 * 1024, W2_XO = W2_XKV + (size_t)2048 * 1024, W2_FI = W2_XO + (size_t)1024 * 1024, W2_FO = W2_FI + (size_t)5632 * 1024, W2_END = W2_FO + (size_t)1024 * 2816;
static_assert(W1_END * 2 <= 25 * MiB && W2_END * 2 <= 25 * MiB, "weight region");

constexpr int LDS_BYTES = 147456;

struct Args { const float* in[28]; float* out; unsigned char* ws; };

constexpr int PTAB_OFF = 135168;
DI void* ldptr(LAS unsigned char* lds, int i) {
    unsigned off_ = PTAB_OFF + 8 * i; asm volatile("" : "+v"(off_));
    const LAS unsigned* t = (const LAS unsigned*)(lds + off_);
    const unsigned lo = __builtin_amdgcn_readfirstlane(t[0]), hi = __builtin_amdgcn_readfirstlane(t[1]);
    typedef __attribute__((address_space(1))) unsigned char* gptr_t;
    return (void*)(gptr_t)(((unsigned long long)hi << 32) | (unsigned long long)lo);
}
#define INP(i) ((const float*)ldptr(lds, (i)))
#define PH_HEAD() \
    int G = G0_, bid = bid0_; asm volatile("" : "+s"(G), "+s"(bid)); \
    int wv = wv0_; asm volatile("" : "+s"(wv)); const int tid = otid(wv), lane = tid & 63, wave = wv; \
    const int gw = bid * 8 + wave, NGW = G * 8; (void)lane; (void)gw; (void)NGW; \
    unsigned char* ws = (unsigned char*)ldptr(lds, 29); \
    bf16_t* const X0 = (bf16_t*)(ws + WS_X0); bf16_t* const X1 = (bf16_t*)(ws + WS_X1); \
    bf16_t* const R1 = (bf16_t*)(ws + WS_R1); bf16_t* const R2 = (bf16_t*)(ws + WS_R2); bf16_t* const R3 = (bf16_t*)(ws + WS_R3); bf16_t* const R4 = (bf16_t*)(ws + WS_R4); \
    bf16_t* const RW = (bf16_t*)(ws + WS_RW); \
    float* const P = (float*)(ws + WS_P); float* const PA = (float*)(ws + WS_PA); float* const CS = (float*)(ws + WS_CS); float* const dC = (float*)(ws + WS_DC); \
    bf16_t* const memb = (bf16_t*)(ws + WS_MEMB); bf16_t* const Km = (bf16_t*)(ws + WS_KM); bf16_t* const Vmt = (bf16_t*)(ws + WS_VMT); \
    float* const mrstd = (float*)(ws + WS_MISC); float* const lbv = mrstd + 512; \
    bf16_t* const xcur = par ? X1 : X0; bf16_t* const xfree = par ? X0 : X1; \
    bf16_t* const zA = R1; bf16_t* const zB = R2; bf16_t* const zC = R4; \
    bf16_t* const Qb = R3; bf16_t* const Krb = R3 + (size_t)MTOK * 768; \
    bf16_t* const Knb = xfree; bf16_t* const Vtb = xfree + (size_t)MTOK * 512; \
    bf16_t* const Oa = R1; bf16_t* const Ob = xfree; bf16_t* const STb = R3; bf16_t* const Gt = R2; bf16_t* const MX = xcur; \
    bf16_t* const QX = R2; bf16_t* const ACT = R2; float* const xres = (float*)ldptr(lds, 28); \
    (void)X0; (void)X1; (void)R1; (void)R2; (void)R3; (void)R4; (void)RW; (void)P; (void)PA; (void)CS; (void)dC; (void)memb; (void)Km; (void)Vmt; (void)mrstd; (void)lbv; \
    (void)xcur; (void)xfree; (void)zA; (void)zB; (void)zC; (void)Qb; (void)Krb; (void)Knb; (void)Vtb; (void)Oa; (void)Ob; (void)STb; (void)Gt; (void)MX; (void)QX; (void)ACT; (void)xres;

#ifdef TPROBE
#define TSTAMP(cls) do { if (blockIdx.x == 0 && threadIdx.x == 0) { LAS unsigned long long* tp_ = (LAS unsigned long long*)(lds + PTAB_OFF + 512); \
    const unsigned long long now_ = __builtin_amdgcn_s_memrealtime(); tp_[1 + (cls)] += now_ - tp_[0]; tp_[0] = now_; } } while (0)
#else
#define TSTAMP(cls) do { } while (0)
#endif
#define GSYNC() xcd_barrier((unsigned*)((unsigned char*)ldptr(lds, 29) + WS_CTL), (volatile LAS unsigned*)(lds + PTAB_OFF + 256))
__global__ void __launch_bounds__(512, 2) mega_fwd(Args args) {
    extern __shared__ __attribute__((aligned(16))) unsigned char lds_raw[];
    LAS unsigned char* lds = (LAS unsigned char*)lds_raw;
    cg::grid_group grid = cg::this_grid();
    const int G0_ = gridDim.x, bid0_ = blockIdx.x, wv0_ = __builtin_amdgcn_readfirstlane(threadIdx.x >> 6);
    int par = 0;
    if (threadIdx.x == 0) {
        LAS unsigned long long* pt = (LAS unsigned long long*)(lds + PTAB_OFF);
#pragma unroll
        for (int i = 0; i < 28; ++i) pt[i] = (unsigned long long)args.in[i];
        pt[28] = (unsigned long long)args.out; pt[29] = (unsigned long long)args.ws;
        pt[32] = 0ull;
#ifdef TPROBE
        for (int i = 0; i < 8; ++i) pt[64 + i] = 0ull; pt[64] = __builtin_amdgcn_s_memrealtime();
#endif
        (void)xb_add((unsigned*)(args.ws + WS_CTL) + XB_XCNT(xb_xcc_id()), 1u);
    }
    __syncthreads();

    for (int l = 0; l < 2; ++l) {
        {
            PH_HEAD();
            LAS float* scr = (LAS float*)(lds + wave * 16640);
            const float* w_in = INP(4) + (size_t)l * 1024 * INW; const float* mixn = INP(3) + l * 1024;
            const float* wuq = INP(6) + (size_t)l * 384 * 768; const float* qn = INP(5) + l * 384;
            const float* wukv = INP(8) + (size_t)l * 256 * 1024; const float* kvn = INP(7) + l * 256;
            const float* wba = INP(15) + (size_t)l * 512 * 1024; const float* wbb = INP(16) + (size_t)l * 512 * 1024; const float* wbc = INP(17) + (size_t)l * 512 * 1024;
            const float* wmx = INP(18) + (size_t)l * 1024 * 1024;
            constexpr int I_IN = 16 * 108, I_UQ = 6 * 12, I_UKV = 4 * 16, I_B = 8 * 16, I_MX = 16 * 16;
            constexpr int NIT = I_IN + I_UQ + I_UKV + 3 * I_B + I_MX;
            for (int it = gw; it < NIT; it += NGW) {
                int r = it;
                if (r < I_IN) { conv_item(w_in, 1024, INW, 6912, 1, mixn, RW + W1_IN, scr, r, lane); continue; } r -= I_IN;
                if (r < I_UQ) { conv_item(wuq, 384, 768, 768, 0, qn, RW + W1_UQ, scr, r, lane); continue; } r -= I_UQ;
                if (r < I_UKV) { conv_item(wukv, 256, 1024, 1024, 0, kvn, RW + W1_UKV, scr, r, lane); continue; } r -= I_UKV;
                if (r < I_B) { conv_item(wba, 512, 1024, 1024, 0, nullptr, RW + W1_BA, scr, r, lane); continue; } r -= I_B;
                if (r < I_B) { conv_item(wbb, 512, 1024, 1024, 0, nullptr, RW + W1_BB, scr, r, lane); continue; } r -= I_B;
                if (r < I_B) { conv_item(wbc, 512, 1024, 1024, 0, nullptr, RW + W1_BC, scr, r, lane); continue; } r -= I_B;
                conv_item(wmx, 1024, 1024, 1024, 0, nullptr, RW + W1_MIX, scr, r, lane);
            }
            if (l == 0) {
                const float* xin0 = INP(0);
                for (int m0 = 4 * gw; m0 < MTOK; m0 += 4 * NGW) {
                    f32x4 vv[4][4];
#pragma unroll
                    for (int q = 0; q < 4; ++q)
#pragma unroll
                        for (int j = 0; j < 4; ++j) vv[q][j] = ((const f32x4*)(xin0 + (size_t)(m0 + q) * 1024) + lane)[64 * j];
#pragma unroll
                    for (int q = 0; q < 4; ++q) { const int m = m0 + q; float s = 0.f;
                        unsigned long long* o8 = (unsigned long long*)(xcur + (size_t)m * 1024) + lane;
#pragma unroll
                        for (int j = 0; j < 4; ++j) { const f32x4 v = vv[q][j]; s += dot4(v); o8[64 * j] = (unsigned long long)cvt_pk(v.x, v.y) | ((unsigned long long)cvt_pk(v.z, v.w) << 32); }
                        s = wave_sum(s);
                        if (lane < 16) P[(size_t)m * 16 + lane] = (lane == 0) ? s : 0.f; }
                }
                for (int m = gw; m < NB * NMEM; m += NGW) {
                    const f32x4* xr = (const f32x4*)(INP(1) + (size_t)m * 1024) + lane; float s = 0.f;
                    unsigned long long* o8 = (unsigned long long*)(memb + (size_t)m * 1024) + lane;
#pragma unroll
                    for (int j = 0; j < 4; ++j) { const f32x4 v = xr[64 * j]; s += dot4(v); o8[64 * j] = (unsigned long long)cvt_pk(v.x, v.y) | ((unsigned long long)cvt_pk(v.z, v.w) << 32); }
                    s = wave_sum(s);
                    if (lane == 0) mrstd[m] = rsqrtf(s * (1.0f / 1024.0f) + EPS);
                }
                const int* pos = (const int*)INP(2);
                for (int idx = bid * 512 + tid; idx < MTOK * 16; idx += G * 512) {
                    const int row = idx >> 4, j = idx & 15;
                    const float invf = powf(10000.0f, -(float)(2 * j) / 32.0f);
                    const float ang = (float)pos[row] * invf;
                    double tt = (double)ang * 0.15915494309189535; tt -= rint(tt);
                    const float rv = (float)tt;
                    CS[(size_t)row * 32 + j] = __builtin_amdgcn_cosf(rv); CS[(size_t)row * 32 + 16 + j] = __builtin_amdgcn_sinf(rv);
                }
                for (int idx = bid * 512 + tid; idx < 512; idx += G * 512) {
                    const float p0 = INP(9)[idx], p1 = INP(9)[512 + idx];
                    lbv[idx] = 0.f; lbv[512 + idx] = 1.0f / (1.0f + expf(p0 - p1));
                }
            }
        }
        __syncthreads();
        if (l == 0) grid.sync(); else GSYNC();
        TSTAMP(0);
        {
            PH_HEAD();
            pg8::Gemm g{xcur, RW + W1_IN, MTOK, 3840, 1024, 1024, 1024}; pg8::StaticOrder S; S.init(MTOK, 3840, G, bid);
            EpiA E{P, zA, zB, zC, PA};
            pg8::gemm_phase<EpiA>(lds, g, S, E, wv);
        }
        GSYNC();
        TSTAMP(1);
        {
            PH_HEAD();
            for (int idx = bid * 512 + tid; idx < MTOK * 16; idx += G * 512) {
                const int row = idx >> 4, j = idx & 15;
                const float x1 = bf2f(zA[(size_t)row * 768 + 640 + j]), x2 = bf2f(zA[(size_t)row * 768 + 656 + j]);
                const float cs = CS[(size_t)row * 32 + j], sn = CS[(size_t)row * 32 + 16 + j];
                Krb[(size_t)row * 32 + j] = f2bf(x1 * cs - x2 * sn); Krb[(size_t)row * 32 + 16 + j] = f2bf(x1 * sn + x2 * cs);
            }
            { pg8::Gemm g{zA, RW + W1_UQ, MTOK, 768, 384, 768, 384}; pg8::StaticOrder S; S.init(MTOK, 768, G, bid);
              EpiQ E{PA, CS, Qb}; pg8::gemm_phase<EpiQ>(lds, g, S, E, wv); }
            { pg8::Gemm g{zA + 384, RW + W1_UKV, MTOK, 1024, 256, 768, 256}; pg8::StaticOrder S; S.init(MTOK, 1024, G, bid);
              EpiKV E{PA, Knb, Vtb}; pg8::gemm_phase<EpiKV>(lds, g, S, E, wv); }
        }
        __syncthreads();
        GSYNC();
        TSTAMP(1);
        {
            PH_HEAD();
            for (int item = bid; item < 256; item += G) {
                const int b = item >> 7, h = (item >> 4) & 7, s = item & 15;
                attn_unit(lds, Qb, Knb, Krb, Vtb, Oa, b, h, 31 - s, wv);
                attn_unit(lds, Qb, Knb, Krb, Vtb, Oa, b, h, s, wv);
            }
#ifdef TPROBE
            GSYNC(); TSTAMP(2);
#endif
            const float* lng = INP(11) + l * 512; const float* lnb = INP(12) + l * 512;
            const float* wsp = INP(13) + (size_t)l * 4 * 128 * 128; const float* bsp = INP(14) + l * 512;
            for (int u = bid; u < 256; u += G) gmlp_unit(lds, zC, lng, lnb, wsp, bsp, u >> 1, u & 1, wv);
        }
        GSYNC();
#ifdef TPROBE
        TSTAMP(5);
#else
        TSTAMP(2);
#endif
        {
            PH_HEAD();
            for (int u = bid; u < 1024; u += G) hg_u_unit(lds, zB, lbv + l * 512, STb, dC, u >> 9, (u >> 7) & 3, u & 127, wv);
        }
        GSYNC();
        TSTAMP(3);
        {
            PH_HEAD();
            if (tid < 256) {
                for (int p = bid * 256 + tid; p < 65536; p += G * 256) {
                    const int bh = p >> 13, e2 = p & 8191;
                    unsigned* sp = (unsigned*)STb + (size_t)bh * 128 * 8192 + e2;
                    const float* dp = dC + (size_t)bh * 128 * 128 + ((2 * e2) & 127);
                    float S0 = 0.f, S1 = 0.f;
                    for (int c0 = 0; c0 < 128; c0 += 32) {
                        unsigned uu[32]; f32x2 dd[32];
#pragma unroll
                        for (int i = 0; i < 32; ++i) { uu[i] = sp[(size_t)(c0 + i) * 8192]; dd[i] = *(const f32x2*)(dp + (size_t)(c0 + i) * 128); }
#pragma unroll
                        for (int i = 0; i < 32; ++i) { sp[(size_t)(c0 + i) * 8192] = cvt_pk(S0, S1); S0 = dd[i].x * S0 + bflo(uu[i]); S1 = dd[i].y * S1 + bfhi(uu[i]); }
                    }
                }
            }
        }
        GSYNC();
        TSTAMP(3);
        {
            PH_HEAD();
            for (int u = bid; u < 1024; u += G) hg_out_unit(lds, zB, lbv + l * 512, STb, INP(10) + l * 128, Ob, u >> 9, (u >> 7) & 3, u & 127, wv);
        }
        GSYNC();
        TSTAMP(3);
        {
            PH_HEAD();
            pg8::Gemm g{xcur, RW + W1_IN + (size_t)3840 * 1024, MTOK, 3072, 1024, 1024, 1024}; pg8::StaticOrder S; S.init(MTOK, 3072, G, bid);
            EpiPlain<true> E{P, Gt, 3072, 1.0f};
            pg8::gemm_phase<EpiPlain<true>>(lds, g, S, E, wv);
        }
        GSYNC();
        TSTAMP(1);
        {
            PH_HEAD();
            pg8::StaticOrder S; S.init(MTOK, 1024, G, bid);
            { pg8::Gemm g{Oa, RW + W1_BA, MTOK, 1024, 512, 512, 512}; EpiBr E{Gt, MX, 0}; pg8::gemm_phase<EpiBr>(lds, g, S, E, wv); }
            { pg8::Gemm g{Ob, RW + W1_BB, MTOK, 1024, 512, 512, 512}; EpiBr E{Gt, MX, 1}; pg8::gemm_phase<EpiBr>(lds, g, S, E, wv); }
            { pg8::Gemm g{zC, RW + W1_BC, MTOK, 1024, 512, 1024, 512}; EpiBr E{Gt, MX, 2}; pg8::gemm_phase<EpiBr>(lds, g, S, E, wv); }
        }
        GSYNC();
        TSTAMP(1);
        {
            PH_HEAD();
            pg8::Gemm g{MX, RW + W1_MIX, MTOK, 1024, 1024, 1024, 1024}; pg8::StaticOrder S; S.init(MTOK, 1024, G, bid);
            EpiRes E{l == 0 ? INP(0) : (const float*)xres, xres, xfree, P};
            pg8::gemm_phase<EpiRes>(lds, g, S, E, wv);
        }
        par ^= 1;
        GSYNC();
        TSTAMP(1);
        {
            PH_HEAD();
            LAS float* scr = (LAS float*)(lds + wave * 16640);
            const float* wxq = INP(21) + (size_t)l * 1024 * 1024; const float* xan = INP(19) + l * 1024;
            const float* wxkv = INP(22) + (size_t)l * 1024 * 2048; const float* memn = INP(20) + l * 1024;
            const float* wxo = INP(23) + (size_t)l * 1024 * 1024;
            const float* wfi = INP(25) + (size_t)l * 1024 * 2 * DFF; const float* ffn = INP(24) + l * 1024;
            const float* wfo = INP(26) + (size_t)l * DFF * 1024;
            constexpr int I_XQ = 16 * 16, I_XKV = 16 * 32, I_FI = 16 * 88, I_FO = 44 * 16;
            constexpr int NIT = 2 * I_XQ + I_XKV + I_FI + I_FO;
            for (int it = gw; it < NIT; it += NGW) {
                int r = it;
                if (r < I_XQ) { conv_item(wxq, 1024, 1024, 1024, 0, xan, RW + W2_XQ, scr, r, lane); continue; } r -= I_XQ;
                if (r < I_XKV) { conv_item(wxkv, 1024, 2048, 2048, 0, memn, RW + W2_XKV, scr, r, lane); continue; } r -= I_XKV;
                if (r < I_XQ) { conv_item(wxo, 1024, 1024, 1024, 0, nullptr, RW + W2_XO, scr, r, lane); continue; } r -= I_XQ;
                if (r < I_FI) { conv_item(wfi, 1024, 2 * DFF, 2 * DFF, 2, ffn, RW + W2_FI, scr, r, lane); continue; } r -= I_FI;
                conv_item(wfo, DFF, 1024, 1024, 0, nullptr, RW + W2_FO, scr, r, lane);
            }
        }
        __syncthreads();
        GSYNC();
        TSTAMP(0);
        {
            PH_HEAD();
            { pg8::Gemm g{xcur, RW + W2_XQ, MTOK, 1024, 1024, 1024, 1024}; pg8::StaticOrder S; S.init(MTOK, 1024, G, bid);
              EpiPlain<false> E{P, QX, 1024, XSC}; pg8::gemm_phase<EpiPlain<false>>(lds, g, S, E, wv); }
            for (int t = bid; t < 256; t += G) memkv_tile(lds, memb, RW + W2_XKV, mrstd, Km, Vmt, t, wv);
        }
        GSYNC();
        TSTAMP(1);
        {
            PH_HEAD();
            for (int u = bid; u < 256; u += G) xattn_unit(lds, QX, Km, Vmt, u >> 7, (u >> 5) & 3, u & 31, wv);
        }
        GSYNC();
        TSTAMP(4);
        {
            PH_HEAD();
            pg8::Gemm g{QX, RW + W2_XO, MTOK, 1024, 1024, 1024, 1024}; pg8::StaticOrder S; S.init(MTOK, 1024, G, bid);
            EpiRes E{xres, xres, xcur, P};
            pg8::gemm_phase<EpiRes>(lds, g, S, E, wv);
        }
        GSYNC();
        TSTAMP(1);
        {
            PH_HEAD();
            pg8::Gemm g{xcur, RW + W2_FI, MTOK, 2 * DFF, 1024, 1024, 1024}; pg8::StaticOrder S; S.init(MTOK, 2 * DFF, G, bid);
            EpiFF E{P, ACT};
            pg8::gemm_phase<EpiFF>(lds, g, S, E, wv);
        }
        GSYNC();
        TSTAMP(1);
        {
            PH_HEAD();
            pg8::Gemm g{ACT, RW + W2_FO, MTOK, 1024, DFF, DFF, DFF}; pg8::StaticOrder S; S.init(MTOK, 1024, G, bid);
            EpiRes E{xres, xres, xcur, P};
            pg8::gemm_phase<EpiRes>(lds, g, S, E, wv);
        }
        GSYNC();
        TSTAMP(1);
    }
    {
        PH_HEAD();
        const float* fn = INP(27);
        const f32x4* gp = (const f32x4*)fn + lane;
        f32x4 gg[4];
#pragma unroll
        for (int j = 0; j < 4; ++j) gg[j] = gp[64 * j];
        for (int m0 = 4 * gw; m0 < MTOK; m0 += 4 * NGW) {
            f32x4 vv[4][4]; float rs[4];
#pragma unroll
            for (int q = 0; q < 4; ++q) { rs[q] = row_rstd16(P, m0 + q);
#pragma unroll
                for (int j = 0; j < 4; ++j) vv[q][j] = ((const f32x4*)(xres + (size_t)(m0 + q) * 1024) + lane)[64 * j]; }
#pragma unroll
            for (int q = 0; q < 4; ++q)
#pragma unroll
                for (int j = 0; j < 4; ++j) ((f32x4*)(xres + (size_t)(m0 + q) * 1024) + lane)[64 * j] = vv[q][j] * rs[q] * gg[j];
        }
#ifdef TPROBE
        GSYNC(); TSTAMP(6);
        if (blockIdx.x == 0) {
            __syncthreads();
            LAS unsigned long long* tp_ = (LAS unsigned long long*)(lds + PTAB_OFF + 512);
            const float ta = (float)tp_[1 + TPA] * 0.01f, tb = (float)tp_[1 + TPB] * 0.01f;
            if (tid == 0) xres[0] = 10.0f * ta;
            for (int i = tid; i < 10000; i += 512) xres[16 + i] = tb;
        }
#endif
    }
}

extern "C" void kernel_launch(void* const* d_in, const int* in_sizes, int n_in, void* d_out, int out_size, void* d_ws, size_t ws_size, hipStream_t stream) {
    static int grid = 0;
    if (grid == 0) {
        if (n_in != 28 || out_size != MTOK * DM || ws_size < WS_END) { fprintf(stderr, "kernel_launch: unexpected problem (n_in %d out %d ws %zu)\n", n_in, out_size, ws_size); grid = -1; return; }
        int dev = 0, cus = 0, per_cu = 0;
        (void)hipGetDevice(&dev);
        (void)hipDeviceGetAttribute(&cus, hipDeviceAttributeMultiprocessorCount, dev);
        (void)hipFuncSetAttribute((const void*)mega_fwd, hipFuncAttributeMaxDynamicSharedMemorySize, LDS_BYTES);
        (void)hipOccupancyMaxActiveBlocksPerMultiprocessor(&per_cu, (const void*)mega_fwd, 512, LDS_BYTES);
        if (per_cu < 1 || cus < 1) { fprintf(stderr, "kernel_launch: occupancy query gave %d blocks/CU on %d CUs\n", per_cu, cus); grid = -1; return; }
        grid = cus;
    }
    if (grid < 0) return;
    (void)hipMemsetAsync((char*)d_ws + WS_CTL, 0, CTL_BYTES, stream);
    Args a{};
    for (int i = 0; i < 28; ++i) a.in[i] = (const float*)d_in[i];
    a.out = (float*)d_out; a.ws = (unsigned char*)d_ws;
    void* kargs[] = {&a};
    hipError_t e = hipLaunchCooperativeKernel((const void*)mega_fwd, dim3(grid), dim3(512), kargs, LDS_BYTES, stream);
    if (e != hipSuccess) fprintf(stderr, "cooperative launch failed: %s (grid %d)\n", hipGetErrorString(e), grid);
}
```

```cpp
#include <hip/hip_runtime.h>
#include <hip/hip_cooperative_groups.h>
#include <cstdio>
#include <cstdint>
namespace cg = cooperative_groups;

#define LAS __attribute__((address_space(3)))
#define DI __device__ __forceinline__
typedef unsigned short bf16_t;
typedef short bf16x8 __attribute__((ext_vector_type(8)));
typedef float f32x2 __attribute__((ext_vector_type(2)));
typedef float f32x4 __attribute__((ext_vector_type(4)));
typedef float f32x16 __attribute__((ext_vector_type(16)));
typedef unsigned u32x2 __attribute__((ext_vector_type(2)));
typedef unsigned u32x4 __attribute__((ext_vector_type(4)));

constexpr int SEQ = 8192, NB = 2, MTOK = NB * SEQ, DM = 1024, NMEM = 256;
constexpr int INW = 6816, DFF = 2816;
constexpr float EPS = 1e-6f;
constexpr float QSC = 0.10206207261596575f * 1.4426950408889634f;
constexpr float XSC = 0.0625f * 1.4426950408889634f;

DI unsigned cvt_pk(float lo, float hi) {
    typedef __bf16 b2 __attribute__((ext_vector_type(2)));
    f32x2 v = {lo, hi}; b2 b = __builtin_convertvector(v, b2); return __builtin_bit_cast(unsigned, b);
}
DI bf16_t f2bf(float f) { return (bf16_t)(cvt_pk(f, 0.f) & 0xffffu); }
DI float bf2f(bf16_t h) { return __uint_as_float((unsigned)h << 16); }
DI float bflo(unsigned w) { return __uint_as_float(w << 16); }
DI float bfhi(unsigned w) { return __uint_as_float(w & 0xffff0000u); }
DI int olane() { int t = __builtin_amdgcn_mbcnt_hi(~0u, __builtin_amdgcn_mbcnt_lo(~0u, 0u)); asm volatile("" : "+v"(t)); return t; }
DI int otid(int wv) { return wv * 64 + olane(); }
DI float wave_sum(float v) {
#pragma unroll
    for (int o = 1; o < 64; o <<= 1) v += __shfl_xor(v, o);
    return v;
}
DI float sigm(float x) { return __builtin_amdgcn_rcpf(1.f + __expf(-x)); }
DI float gelu_erf(float v) {
    const float av = fabsf(v), t = __builtin_amdgcn_rcpf(av * 0.2316418882f + 1.0f);
    float q = t * 0.5307027145f + (-0.7265760135f); q = q * t + 0.7107068705f; q = q * t + (-0.142248368f); q = q * t + 0.127414796f; q = q * t;
    const float e = __builtin_amdgcn_exp2f((v * v) * (-0.72134752044f));
    const float m = v * (q * e);
    return v < 0.f ? m : v - m;
}
DI int crow(int r, int h) { return (r & 3) + 8 * (r >> 2) + 4 * h; }
DI float dot4(f32x4 a) { return (a.x * a.x + a.y * a.y) + (a.z * a.z + a.w * a.w); }
DI float sum4(f32x4 a) { return (a.x + a.y) + (a.z + a.w); }
#define LBAR() do { asm volatile("s_waitcnt lgkmcnt(0)" ::: "memory"); __builtin_amdgcn_s_barrier(); asm volatile("" ::: "memory"); } while (0)
#define MFMA32(a, b, c) __builtin_amdgcn_mfma_f32_32x32x16_bf16((a), (b), (c), 0, 0, 0)
DI bf16x8 mk8(u32x2 lo, u32x2 hi) { u32x4 v = {lo.x, lo.y, hi.x, hi.y}; return __builtin_bit_cast(bf16x8, v); }
DI bf16x8 pack8(float a0, float a1, float a2, float a3, float a4, float a5, float a6, float a7) {
    u32x4 v = {cvt_pk(a0, a1), cvt_pk(a2, a3), cvt_pk(a4, a5), cvt_pk(a6, a7)}; return __builtin_bit_cast(bf16x8, v);
}

namespace pg8 {
constexpr int BM = 256, BK = 64, HALF = 128, HTB = HALF * BK * 2, STAGE_BYTES = 8 * HTB, NXCD = 8, WGM = 8;
DI int lds_byte(int r, int c) { const int st = (r >> 4) * 2 + (c >> 5), rr = r & 15, cc = c & 31, ob = rr * 64 + cc * 2; return st * 1024 + (ob ^ (((ob >> 9) & 1) << 5)); }
DI void stage_rc(int b, int& R, int& C) { const int st = b / 1024, sb = b % 1024, swz = sb ^ (((sb >> 9) & 1) << 5); R = (st >> 1) * 16 + swz / 64; C = (st & 1) * 32 + (swz % 64) / 2; }
DI int perm32(int rho) { const int n = rho >> 4, i = rho & 15; return 8 * (i >> 2) + 4 * n + (i & 3); }
struct Unit { int pm, pn; };
struct Gemm { const bf16_t* A; const bf16_t* Bt; int M, N, K, lda, ldb; };
struct StaticOrder {
    int nM, nN, nwg, G, c;
    DI void init(int M, int N, int G_, int c_) { nM = M / BM; nN = N / BM; nwg = nM * nN; G = G_; c = c_; }
    DI bool next(int i, Unit& u) const {
        const long L = (long)i * G + c; if (L >= nwg) return false;
        int wgid = (int)L; { const int q = nwg / NXCD, r = nwg % NXCD, xcd = wgid % NXCD, off = wgid / NXCD; wgid = (xcd < r ? xcd * (q + 1) : r * (q + 1) + (xcd - r) * q) + off; }
        const int nig = WGM * nN, gid = wgid / nig, fm = gid * WGM, gsz = (nM - fm) < WGM ? (nM - fm) : WGM;
        u.pm = fm + ((wgid % nig) % gsz); u.pn = (wgid % nig) / gsz; return true;
    }
};
template <class Epi>
DI void gemm_phase(LAS unsigned char* lds, const Gemm g, const StaticOrder& S, const Epi& E, int wv) {
    const int tid = otid(wv), wid = __builtin_amdgcn_readfirstlane(tid >> 6), lane = tid & 63, wr = wid >> 2, wc = wid & 3, fr = lane & 15, fq = lane >> 4;
    const int K = g.K, nt = K / BK;
    unsigned voffA[2], voffB[2];
#pragma unroll
    for (int i = 0; i < 2; ++i) { int R, C; stage_rc(tid * 16 + i * 8192, R, C); const int Rb = Epi::PERM ? ((R & ~31) + perm32(R & 31)) : R;
        voffA[i] = (unsigned)(R * g.lda + C) * 2u; voffB[i] = (unsigned)(Rb * g.ldb + C) * 2u; }
    const size_t kstep = (size_t)(BK * 2);
    const size_t hsA = (size_t)HALF * g.lda * 2, hsB = (size_t)HALF * g.ldb * 2;
    const size_t tsA = 2 * hsA, tsB = 2 * hsB;
    const unsigned ldsw = (unsigned)wid * 1024u;
    const int aoff = lds_byte(wr * 64 + fr, fq * 8), boff = lds_byte(wc * 32 + fr, fq * 8);
#define PG8_SA(b, h) (((b) * 2 + (h)) * HTB)
#define PG8_SB(b, h) ((4 + (b) * 2 + (h)) * HTB)
#define PG8_STAGE(bufoff, gbase, voff) do { const char* gb_ = (const char*)(gbase); asm volatile("" : "+s"(gb_)); _Pragma("unroll") for (int _i = 0; _i < 2; ++_i) { unsigned vo_ = (voff)[_i]; asm volatile("" : "+v"(vo_)); \
        __builtin_amdgcn_global_load_lds((const unsigned*)(gb_ + vo_), (LAS unsigned*)(lds + (bufoff) + ldsw + _i * 8192), 16, 0, 0); } } while (0)
#define PG8_LDA(dst, b, h) do { _Pragma("unroll") for (int m = 0; m < 4; ++m) _Pragma("unroll") for (int k = 0; k < 2; ++k) dst[m][k] = *(const LAS bf16x8*)(lds + PG8_SA(b, h) + aoff + m * 2048 + k * 1024); } while (0)
#define PG8_LDB(dst, b, h) do { _Pragma("unroll") for (int n = 0; n < 2; ++n) _Pragma("unroll") for (int k = 0; k < 2; ++k) dst[n][k] = *(const LAS bf16x8*)(lds + PG8_SB(b, h) + boff + n * 2048 + k * 1024); } while (0)
#define PG8_MMA(ai, bj, At, Bt) do { __builtin_amdgcn_s_setprio(1); _Pragma("unroll") for (int m = 0; m < 4; ++m) _Pragma("unroll") for (int n = 0; n < 2; ++n) _Pragma("unroll") for (int k = 0; k < 2; ++k) \
        acc[ai][bj][m][n] = __builtin_amdgcn_mfma_f32_16x16x32_bf16(Bt[n][k], At[m][k], acc[ai][bj][m][n], 0, 0, 0); __builtin_amdgcn_s_setprio(0); } while (0)
#define PG8_WAIT_V(n) asm volatile("s_waitcnt vmcnt(" #n ")" ::: "memory")
#define PG8_WAIT_L(n) asm volatile("s_waitcnt lgkmcnt(" #n ")" ::: "memory")
#define PG8_BAR __builtin_amdgcn_s_barrier()
#define PG8_SCHED __builtin_amdgcn_sched_barrier(0)
    Unit cur, nxt; int ui = 0;
    if (!S.next(0, cur)) return;
    f32x4 acc[2][2][4][2];
#pragma unroll
    for (int a = 0; a < 2; ++a)
#pragma unroll
        for (int b = 0; b < 2; ++b)
#pragma unroll
            for (int m = 0; m < 4; ++m)
#pragma unroll
                for (int n = 0; n < 2; ++n) acc[a][b][m][n] = (f32x4){0.f, 0.f, 0.f, 0.f};
    bf16x8 At[4][2], B0[2][2], B1[2][2];
    const char* cA = (const char*)g.A + (size_t)cur.pm * tsA; const char* cB = (const char*)g.Bt + (size_t)cur.pn * tsB;
    PG8_STAGE(PG8_SB(0, 0), cB, voffB); PG8_STAGE(PG8_SB(0, 1), cB + hsB, voffB); PG8_STAGE(PG8_SA(0, 0), cA, voffA); PG8_STAGE(PG8_SA(0, 1), cA + hsA, voffA);
    if (wr == 1) PG8_BAR;
    PG8_WAIT_V(2); PG8_BAR;
    PG8_STAGE(PG8_SB(1, 0), cB + kstep, voffB); PG8_STAGE(PG8_SA(1, 0), cA + kstep, voffA); PG8_STAGE(PG8_SB(1, 1), cB + hsB + kstep, voffB);
    PG8_WAIT_V(6); PG8_BAR;
    for (;;) {
        const bool has_next = S.next(ui + 1, nxt);
        const char* nA = has_next ? (const char*)g.A + (size_t)nxt.pm * tsA : cA; const char* nB = has_next ? (const char*)g.Bt + (size_t)nxt.pn * tsB : cB;
        for (int t = 0; t < nt; t += 2) {
            const bool last = (t == nt - 2);
            const char* a1 = cA + (size_t)(t + 1) * kstep;
            const char* a2 = last ? nA : cA + (size_t)(t + 2) * kstep; const char* b2 = last ? nB : cB + (size_t)(t + 2) * kstep;
            const char* a3 = a2 + kstep; const char* b3 = b2 + kstep;
            PG8_LDB(B0, 0, 0); PG8_LDB(B1, 0, 1); PG8_SCHED; PG8_LDA(At, 0, 0); PG8_STAGE(PG8_SA(1, 1), a1 + hsA, voffA);
            PG8_WAIT_V(8); PG8_WAIT_L(0); PG8_BAR; PG8_MMA(0, 0, At, B0); PG8_MMA(0, 1, At, B1); PG8_BAR; PG8_SCHED;
            PG8_LDA(At, 0, 1); PG8_STAGE(PG8_SB(0, 0), b2, voffB); PG8_STAGE(PG8_SB(0, 1), b2 + hsB, voffB); PG8_STAGE(PG8_SA(0, 0), a2, voffA);
            PG8_WAIT_V(8); PG8_WAIT_L(0); PG8_BAR; PG8_MMA(1, 0, At, B0); PG8_MMA(1, 1, At, B1); PG8_BAR; PG8_SCHED;
            PG8_LDB(B0, 1, 0); PG8_LDB(B1, 1, 1); PG8_SCHED; PG8_LDA(At, 1, 0); PG8_STAGE(PG8_SA(0, 1), a2 + hsA, voffA);
            PG8_WAIT_V(8); PG8_WAIT_L(0); PG8_BAR; PG8_MMA(0, 0, At, B0); PG8_MMA(0, 1, At, B1); PG8_BAR; PG8_SCHED;
            PG8_LDA(At, 1, 1); PG8_STAGE(PG8_SB(1, 0), b3, voffB); PG8_STAGE(PG8_SB(1, 1), b3 + hsB, voffB); PG8_STAGE(PG8_SA(1, 0), a3, voffA);
            PG8_WAIT_V(8); PG8_WAIT_L(0); PG8_BAR; PG8_MMA(1, 0, At, B0); PG8_MMA(1, 1, At, B1); PG8_BAR; PG8_SCHED;
        }
        if (wr == 0) PG8_BAR;
        { const int ln_ = olane(); E(acc, cur, wr, wc, ln_ & 15, ln_ >> 4); }
        if (!has_next) break;
#pragma unroll
        for (int a = 0; a < 2; ++a)
#pragma unroll
            for (int b = 0; b < 2; ++b)
#pragma unroll
                for (int m = 0; m < 4; ++m)
#pragma unroll
                    for (int n = 0; n < 2; ++n) acc[a][b][m][n] = (f32x4){0.f, 0.f, 0.f, 0.f};
        cur = nxt; cA = nA; cB = nB; ++ui;
        if (wr == 1) PG8_BAR;
    }
    PG8_WAIT_V(0);
    PG8_BAR;
#undef PG8_SA
#undef PG8_SB
#undef PG8_STAGE
#undef PG8_LDA
#undef PG8_LDB
#undef PG8_MMA
#undef PG8_WAIT_V
#undef PG8_WAIT_L
#undef PG8_BAR
#undef PG8_SCHED
}
}
typedef const f32x4 (&AccRef)[2][2][4][2];

DI float row_rstd16(const float* P, int row) {
    const f32x4* p = (const f32x4*)(P + (size_t)row * 16);
    const float s = (sum4(p[0]) + sum4(p[1])) + (sum4(p[2]) + sum4(p[3]));
    return rsqrtf(s * (1.0f / 1024.0f) + EPS);
}
DI float row_ssq_q(const float* Pq, int stride, int nq, int row, int fq) {
    float s = 0.f;
    if (fq < nq) s = sum4(*(const f32x4*)(Pq + (size_t)row * stride + 4 * fq));
    s += __shfl_xor(s, 16); s += __shfl_xor(s, 32);
    return s;
}
DI u32x4 pk16(f32x4 v0, f32x4 v1) { u32x4 w; w.x = cvt_pk(v0[0], v0[1]); w.y = cvt_pk(v0[2], v0[3]); w.z = cvt_pk(v1[0], v1[1]); w.w = cvt_pk(v1[2], v1[3]); return w; }
DI u32x2 pk8(f32x4 v) { u32x2 w; w.x = cvt_pk(v[0], v[1]); w.y = cvt_pk(v[2], v[3]); return w; }

struct EpiA { static constexpr bool PERM = true;
    const float* P; bf16_t* zA; bf16_t* zB; bf16_t* zC; float* PA;
    DI void operator()(AccRef acc, const pg8::Unit& u, int wr, int wc, int fr, int fq) const {
        const int pn = u.pn; bf16_t* base; int ld, colt;
        if (pn < 3) { base = zA; ld = 768; colt = pn * 256; } else if (pn < 11) { base = zB; ld = 2048; colt = (pn - 3) * 256; } else { base = zC; ld = 1024; colt = (pn - 11) * 256; }
        const int row0 = u.pm * 256 + wr * 64 + fr, col0 = colt + wc * 32 + 8 * fq;
float rsv[2][4];
#pragma unroll
        for (int ai = 0; ai < 2; ++ai)
#pragma unroll
            for (int m = 0; m < 4; ++m) rsv[ai][m] = rsqrtf(row_ssq_q(P, 16, 4, row0 + ai * 128 + m * 16, fq) * (1.0f / 1024.0f) + EPS);
#pragma unroll
        for (int ai = 0; ai < 2; ++ai)
#pragma unroll
            for (int m = 0; m < 4; ++m) { const int row = row0 + ai * 128 + m * 16; const float rs = rsv[ai][m];
#pragma unroll
                for (int bj = 0; bj < 2; ++bj) { const f32x4 v0 = acc[ai][bj][m][0] * rs, v1 = acc[ai][bj][m][1] * rs;
                    if (pn < 3) { float s = dot4(v0) + dot4(v1); s += __shfl_xor(s, 16); s += __shfl_xor(s, 32); if (fq == 0) PA[(size_t)row * 32 + pn * 8 + bj * 4 + wc] = s; }
                    *(u32x4*)(base + (size_t)row * ld + col0 + bj * 128) = pk16(v0, v1); } }
    }
};
template <bool SIG> struct EpiPlain { static constexpr bool PERM = true;
    const float* P; bf16_t* O; int ldo; float scale;
    DI void operator()(AccRef acc, const pg8::Unit& u, int wr, int wc, int fr, int fq) const {
        const int row0 = u.pm * 256 + wr * 64 + fr, col0 = u.pn * 256 + wc * 32 + 8 * fq;
float rsv[2][4];
#pragma unroll
        for (int ai = 0; ai < 2; ++ai)
#pragma unroll
            for (int m = 0; m < 4; ++m) rsv[ai][m] = rsqrtf(row_ssq_q(P, 16, 4, row0 + ai * 128 + m * 16, fq) * (1.0f / 1024.0f) + EPS) * scale;
#pragma unroll
        for (int ai = 0; ai < 2; ++ai)
#pragma unroll
            for (int m = 0; m < 4; ++m) { const int row = row0 + ai * 128 + m * 16; const float rs = rsv[ai][m];
#pragma unroll
                for (int bj = 0; bj < 2; ++bj) { f32x4 v0 = acc[ai][bj][m][0] * rs, v1 = acc[ai][bj][m][1] * rs;
                    if (SIG) {
#pragma unroll
                        for (int e = 0; e < 4; ++e) { v0[e] = sigm(v0[e]); v1[e] = sigm(v1[e]); } }
                    *(u32x4*)(O + (size_t)row * ldo + col0 + bj * 128) = pk16(v0, v1); } }
    }
};
struct EpiQ { static constexpr bool PERM = false;
    const float* PA; const float* CS; bf16_t* Q;
    DI void operator()(AccRef acc, const pg8::Unit& u, int wr, int wc, int fr, int fq) const {
        const int row0 = u.pm * 256 + wr * 64 + fr;
float rsv[2][4];
#pragma unroll
        for (int ai = 0; ai < 2; ++ai)
#pragma unroll
            for (int m = 0; m < 4; ++m) rsv[ai][m] = rsqrtf(row_ssq_q(PA, 32, 3, row0 + ai * 128 + m * 16, fq) * (1.0f / 384.0f) + EPS);
#pragma unroll
        for (int ai = 0; ai < 2; ++ai)
#pragma unroll
            for (int m = 0; m < 4; ++m) { const int row = row0 + ai * 128 + m * 16;
                const float rs = rsv[ai][m];
                const f32x4 cs = *(const f32x4*)(CS + (size_t)row * 32 + 4 * fq), sn = *(const f32x4*)(CS + (size_t)row * 32 + 16 + 4 * fq);
#pragma unroll
                for (int bj = 0; bj < 2; ++bj) { const int g32 = u.pn * 8 + bj * 4 + wc;
                    f32x4 v0 = acc[ai][bj][m][0] * rs, v1 = acc[ai][bj][m][1] * rs;
                    if ((g32 % 3) == 2) { const f32x4 y0 = v0 * cs - v1 * sn, y1 = v0 * sn + v1 * cs; v0 = y0; v1 = y1; }
                    v0 = v0 * QSC; v1 = v1 * QSC;
                    bf16_t* o = Q + (size_t)row * 768 + u.pn * 256 + bj * 128 + wc * 32 + 4 * fq;
                    *(u32x2*)(o) = pk8(v0); *(u32x2*)(o + 16) = pk8(v1); } }
    }
};
struct EpiKV { static constexpr bool PERM = true;
    const float* PA; bf16_t* Kn; bf16_t* Vt;
    DI void operator()(AccRef acc, const pg8::Unit& u, int wr, int wc, int fr, int fq) const {
        const int row0 = u.pm * 256 + wr * 64 + fr;
float rsv[2][4];
#pragma unroll
        for (int ai = 0; ai < 2; ++ai)
#pragma unroll
            for (int m = 0; m < 4; ++m) rsv[ai][m] = rsqrtf(row_ssq_q(PA + 12, 32, 2, row0 + ai * 128 + m * 16, fq) * (1.0f / 256.0f) + EPS);
#pragma unroll
        for (int ai = 0; ai < 2; ++ai)
#pragma unroll
            for (int m = 0; m < 4; ++m) { const int row = row0 + ai * 128 + m * 16;
                const float rs = rsv[ai][m];
                const int b = row / SEQ, tok = row % SEQ;
#pragma unroll
                for (int bj = 0; bj < 2; ++bj) { const int h = 2 * u.pn + bj;
                    const f32x4 v0 = acc[ai][bj][m][0] * rs, v1 = acc[ai][bj][m][1] * rs;
                    if (wc < 2) { *(u32x4*)(Kn + (size_t)row * 512 + h * 64 + wc * 32 + 8 * fq) = pk16(v0, v1); }
                    else { bf16_t* vp = Vt + ((size_t)(b * 8 + h) * 64 + (wc - 2) * 32 + 8 * fq) * SEQ + tok;
#pragma unroll
                        for (int e = 0; e < 4; ++e) { vp[(size_t)e * SEQ] = f2bf(v0[e]); vp[(size_t)(4 + e) * SEQ] = f2bf(v1[e]); } } } }
    }
};
struct EpiBr { static constexpr bool PERM = true;
    const bf16_t* G; bf16_t* MX; int j;
    DI void operator()(AccRef acc, const pg8::Unit& u, int wr, int wc, int fr, int fq) const {
        const int row0 = u.pm * 256 + wr * 64 + fr, col0 = u.pn * 256 + wc * 32 + 8 * fq;
#pragma unroll
        for (int ai = 0; ai < 2; ++ai) {
            u32x4 gw[4][2], ow[4][2];
#pragma unroll
            for (int m = 0; m < 4; ++m)
#pragma unroll
                for (int bj = 0; bj < 2; ++bj) { const int row = row0 + ai * 128 + m * 16, col = col0 + bj * 128;
                    gw[m][bj] = *(const u32x4*)(G + (size_t)row * 3072 + j * 1024 + col);
                    ow[m][bj] = (j > 0) ? *(const u32x4*)(MX + (size_t)row * 1024 + col) : (u32x4){0u, 0u, 0u, 0u}; }
#pragma unroll
            for (int m = 0; m < 4; ++m)
#pragma unroll
                for (int bj = 0; bj < 2; ++bj) { const int row = row0 + ai * 128 + m * 16, col = col0 + bj * 128;
                    const u32x4 g4 = gw[m][bj], o4 = ow[m][bj];
                    f32x4 v0 = acc[ai][bj][m][0], v1 = acc[ai][bj][m][1];
                    v0[0] = v0[0] * bflo(g4.x) + bflo(o4.x); v0[1] = v0[1] * bfhi(g4.x) + bfhi(o4.x); v0[2] = v0[2] * bflo(g4.y) + bflo(o4.y); v0[3] = v0[3] * bfhi(g4.y) + bfhi(o4.y);
                    v1[0] = v1[0] * bflo(g4.z) + bflo(o4.z); v1[1] = v1[1] * bfhi(g4.z) + bfhi(o4.z); v1[2] = v1[2] * bflo(g4.w) + bflo(o4.w); v1[3] = v1[3] * bfhi(g4.w) + bfhi(o4.w);
                    *(u32x4*)(MX + (size_t)row * 1024 + col) = pk16(v0, v1); }
        }
    }
};
struct EpiRes { static constexpr bool PERM = false;
    const float* xin; float* xout; bf16_t* xb; float* P;
    DI void operator()(AccRef acc, const pg8::Unit& u, int wr, int wc, int fr, int fq) const {
        const int row0 = u.pm * 256 + wr * 64 + fr, col0 = u.pn * 256 + wc * 32 + 4 * fq;
#pragma unroll
        for (int ai = 0; ai < 2; ++ai)
#pragma unroll
            for (int mh = 0; mh < 2; ++mh) {
                f32x4 xv[2][2][2];
#pragma unroll
                for (int mm = 0; mm < 2; ++mm)
#pragma unroll
                    for (int bj = 0; bj < 2; ++bj)
#pragma unroll
                        for (int n = 0; n < 2; ++n) xv[mm][bj][n] = *(const f32x4*)(xin + (size_t)(row0 + ai * 128 + (2 * mh + mm) * 16) * 1024 + col0 + bj * 128 + n * 16);
#pragma unroll
                for (int mm = 0; mm < 2; ++mm) { const int m = 2 * mh + mm; const int row = row0 + ai * 128 + m * 16; float s = 0.f;
#pragma unroll
                    for (int bj = 0; bj < 2; ++bj)
#pragma unroll
                        for (int n = 0; n < 2; ++n) { const size_t off = (size_t)row * 1024 + col0 + bj * 128 + n * 16;
                            const f32x4 xo = xv[mm][bj][n] + acc[ai][bj][m][n];
                            *(f32x4*)(xout + off) = xo; *(u32x2*)(xb + off) = pk8(xo); s += dot4(xo); }
                    s += __shfl_xor(s, 16); s += __shfl_xor(s, 32);
                    if (fq == 0) P[(size_t)row * 16 + u.pn * 4 + wc] = s; }
            }
    }
};
struct EpiKVm { static constexpr bool PERM = true;
    const float* mrstd; bf16_t* Km; bf16_t* Vmt;
    DI void operator()(AccRef acc, const pg8::Unit& u, int wr, int wc, int fr, int fq) const {
        const int row0 = u.pm * 256 + wr * 64 + fr;
#pragma unroll
        for (int ai = 0; ai < 2; ++ai)
#pragma unroll
            for (int m = 0; m < 4; ++m) { const int row = row0 + ai * 128 + m * 16; const float rs = mrstd[row];
                const int b = row >> 8, key = row & 255;
#pragma unroll
                for (int bj = 0; bj < 2; ++bj) { const f32x4 v0 = acc[ai][bj][m][0] * rs, v1 = acc[ai][bj][m][1] * rs;
                    const int c = u.pn * 256 + bj * 128 + wc * 32 + 8 * fq;
                    if (u.pn < 4) { *(u32x4*)(Km + (size_t)row * 1024 + c) = pk16(v0, v1); }
                    else { const int c2 = c - 1024, h = c2 >> 8, dv = c2 & 255;
                        bf16_t* vp = Vmt + ((size_t)(b * 4 + h) * 256 + dv) * 256 + key;
#pragma unroll
                        for (int e = 0; e < 4; ++e) { vp[e * 256] = f2bf(v0[e]); vp[(4 + e) * 256] = f2bf(v1[e]); } } } }
    }
};
struct EpiFF { static constexpr bool PERM = false;
    const float* P; bf16_t* ACT;
    DI void operator()(AccRef acc, const pg8::Unit& u, int wr, int wc, int fr, int fq) const {
        const int row0 = u.pm * 256 + wr * 64 + fr;
float rsv[2][4];
#pragma unroll
        for (int ai = 0; ai < 2; ++ai)
#pragma unroll
            for (int m = 0; m < 4; ++m) rsv[ai][m] = rsqrtf(row_ssq_q(P, 16, 4, row0 + ai * 128 + m * 16, fq) * (1.0f / 1024.0f) + EPS);
#pragma unroll
        for (int ai = 0; ai < 2; ++ai)
#pragma unroll
            for (int m = 0; m < 4; ++m) { const int row = row0 + ai * 128 + m * 16; const float rs = rsv[ai][m];
#pragma unroll
                for (int bj = 0; bj < 2; ++bj) { const int G = u.pn * 8 + bj * 4 + wc;
                    const f32x4 gt = acc[ai][bj][m][0] * rs, up = acc[ai][bj][m][1] * rs; f32x4 a;
#pragma unroll
                    for (int e = 0; e < 4; ++e) a[e] = gt[e] * sigm(gt[e]) * up[e];
                    *(u32x2*)(ACT + (size_t)row * DFF + 16 * G + 4 * fq) = pk8(a); } }
    }
};

DI int srccol(int mode, int np) {
    if (mode == 1) return np < 672 ? np : (np < 768 ? -1 : np - 96);
    if (mode == 2) { const int G = np >> 5, s = (np >> 4) & 1, j = np & 15; return s * DFF + 16 * G + j; }
    return np;
}
DI void conv_item(const float* W, int K, int N, int Np, int mode, const float* gain, bf16_t* WT, LAS float* scr, int item, int lane) {
    const int nblk = Np / 64, kb = item / nblk, nb = item % nblk, k0 = 64 * kb, n0 = 64 * nb;
    const int r = lane >> 4, c4 = (lane & 15) * 4;
    const int sc = srccol(mode, n0 + c4);
    f32x4 v[16];
#pragma unroll
    for (int i = 0; i < 16; ++i) v[i] = (sc >= 0) ? *(const f32x4*)(W + (size_t)(k0 + 4 * i + r) * N + sc) : (f32x4){0.f, 0.f, 0.f, 0.f};
#pragma unroll
    for (int i = 0; i < 16; ++i) { const int row = 4 * i + r; const float gn = gain ? gain[k0 + row] : 1.0f; LAS float* d = scr + row * 65 + c4;
        d[0] = v[i][0] * gn; d[1] = v[i][1] * gn; d[2] = v[i][2] * gn; d[3] = v[i][3] * gn; }
    asm volatile("s_waitcnt lgkmcnt(0)" ::: "memory");
    const int c = lane & 7;
#pragma unroll
    for (int jj = 0; jj < 8; ++jj) { const int n = (lane >> 3) + 8 * jj; const LAS float* sp = scr + (8 * c) * 65 + n;
        u32x4 o; o.x = cvt_pk(sp[0 * 65], sp[1 * 65]); o.y = cvt_pk(sp[2 * 65], sp[3 * 65]); o.z = cvt_pk(sp[4 * 65], sp[5 * 65]); o.w = cvt_pk(sp[6 * 65], sp[7 * 65]);
        *(u32x4*)(WT + (size_t)(n0 + n) * K + k0 + 8 * c) = o; }
    asm volatile("s_waitcnt lgkmcnt(0)" ::: "memory");
}

DI void attn_unit(LAS unsigned char* lds, const bf16_t* Q, const bf16_t* Kn, const bf16_t* Kr, const bf16_t* Vt, bf16_t* Oa, int b, int h, int qb, int wv) {
    const int tid = otid(wv), lane = tid & 63, w = wv, l32 = lane & 31, hi = lane >> 5;
    constexpr int KST = 208, VST = 264, KBUF = 128 * KST, VBUF = 64 * VST, VOFF = 2 * KBUF;
    const size_t rowb = (size_t)b * SEQ;
    const int qrow = qb * 256 + 32 * w + l32;
    bf16x8 qf[6];
#pragma unroll
    for (int ks = 0; ks < 6; ++ks) qf[ks] = *(const bf16x8*)(Q + (rowb + qrow) * 768 + h * 96 + 16 * ks + 8 * hi);
    f32x16 o0, o1;
#pragma unroll
    for (int r = 0; r < 16; ++r) { o0[r] = 0.f; o1[r] = 0.f; }
    float mrun = -INFINITY, lrun = 0.f;
    const int NT = 2 * qb + 2, tlast = 2 * qb + (w >> 2);
    const int kkey = tid >> 3, kch = tid & 7, rkey = tid >> 2, rch = tid & 3, vdv = tid >> 4, vch = tid & 15;
    const bf16_t* gK = Kn + (rowb + kkey) * 512 + h * 64 + kch * 8;
    const bf16_t* gR = Kr + (rowb + rkey) * 32 + rch * 8;
    const bf16_t* gV = Vt + ((size_t)(b * 8 + h) * 64 + vdv) * SEQ + vch * 8;
    u32x4 rk0, rk1, rr, rv0, rv1;
#define ATT_LOAD(t) do { rk0 = *(const u32x4*)(gK + (size_t)(t) * 128 * 512); rk1 = *(const u32x4*)(gK + (size_t)(t) * 128 * 512 + 64 * 512); \
        rr = *(const u32x4*)(gR + (size_t)(t) * 128 * 32); rv0 = *(const u32x4*)(gV + (size_t)(t) * 128); rv1 = *(const u32x4*)(gV + (size_t)(t) * 128 + (size_t)32 * SEQ); } while (0)
#define ATT_STORE(kd, vd) do { *(LAS u32x4*)((kd) + kkey * KST + kch * 16) = rk0; *(LAS u32x4*)((kd) + (64 + kkey) * KST + kch * 16) = rk1; \
        *(LAS u32x4*)((kd) + rkey * KST + 128 + rch * 16) = rr; \
        *(LAS u32x2*)((vd) + vdv * VST + vch * 16) = (u32x2){rv0.x, rv0.y}; *(LAS u32x2*)((vd) + vdv * VST + vch * 16 + 8) = (u32x2){rv0.z, rv0.w}; \
        *(LAS u32x2*)((vd) + (32 + vdv) * VST + vch * 16) = (u32x2){rv1.x, rv1.y}; *(LAS u32x2*)((vd) + (32 + vdv) * VST + vch * 16 + 8) = (u32x2){rv1.z, rv1.w}; } while (0)
    ATT_LOAD(0);
    ATT_STORE(lds, lds + VOFF);
    __syncthreads();
#pragma unroll
    for (int ks = 0; ks < 6; ++ks) asm volatile("" : "+v"(qf[ks]));
    for (int t = 0; t < NT; ++t) {
        const int cur = t & 1;
        if (t + 1 < NT) ATT_LOAD(t + 1);
        if (t <= tlast) {
            const LAS unsigned char* kb_ = lds + cur * KBUF;
            const LAS unsigned char* vb_ = lds + VOFF + cur * VBUF;
            f32x16 s[4];
#pragma unroll
            for (int kb = 0; kb < 4; ++kb)
#pragma unroll
                for (int r = 0; r < 16; ++r) s[kb][r] = 0.f;
            bf16x8 ka[2][4];
            u32x2 vl[2][2], vh[2][2];
#pragma unroll
            for (int kb = 0; kb < 4; ++kb) ka[0][kb] = *(const LAS bf16x8*)(kb_ + (32 * kb + l32) * KST + (8 * hi) * 2);
            __builtin_amdgcn_sched_barrier(0);
#pragma unroll
            for (int ks = 0; ks < 6; ++ks) {
                if (ks + 1 < 6) {
#pragma unroll
                    for (int kb = 0; kb < 4; ++kb) ka[(ks + 1) & 1][kb] = *(const LAS bf16x8*)(kb_ + (32 * kb + l32) * KST + (16 * (ks + 1) + 8 * hi) * 2);
                } else {
                    vl[0][0] = *(const LAS u32x2*)(vb_ + l32 * VST + (4 * hi) * 2); vh[0][0] = *(const LAS u32x2*)(vb_ + l32 * VST + (4 * hi) * 2 + 16);
                    vl[0][1] = *(const LAS u32x2*)(vb_ + (32 + l32) * VST + (4 * hi) * 2); vh[0][1] = *(const LAS u32x2*)(vb_ + (32 + l32) * VST + (4 * hi) * 2 + 16);
                }
                __builtin_amdgcn_sched_barrier(0);
#pragma unroll
                for (int kb = 0; kb < 4; ++kb) s[kb] = MFMA32(ka[ks & 1][kb], qf[ks], s[kb]);
                __builtin_amdgcn_sched_barrier(0);
            }
            if (t == tlast) {
#pragma unroll
                for (int kb = 0; kb < 4; ++kb)
#pragma unroll
                    for (int r = 0; r < 16; ++r) { const int key = 128 * t + 32 * kb + crow(r, hi); if (key > qrow) s[kb][r] = -INFINITY; }
            }
            float mx = fmaxf(fmaxf(s[0][0], s[1][0]), fmaxf(s[2][0], s[3][0]));
#pragma unroll
            for (int r = 1; r < 16; ++r) mx = fmaxf(mx, fmaxf(fmaxf(s[0][r], s[1][r]), fmaxf(s[2][r], s[3][r])));
            mx = fmaxf(mx, __shfl_xor(mx, 32));
            const float mnew = fmaxf(mrun, mx);
            if (__builtin_amdgcn_ballot_w64(mnew > mrun) != 0ull) {
                const float alpha = __builtin_amdgcn_exp2f(mrun - mnew);
                mrun = mnew; lrun *= alpha;
#pragma unroll
                for (int r = 0; r < 16; ++r) { o0[r] *= alpha; o1[r] *= alpha; }
            }
            const f32x2 m2 = {mrun, mrun};
            f32x2 ps2 = {0.f, 0.f};
#pragma unroll
            for (int kb = 0; kb < 4; ++kb)
#pragma unroll
                for (int r = 0; r < 16; r += 2) { f32x2 v = {s[kb][r], s[kb][r + 1]}; v = v - m2;
                    v.x = __builtin_amdgcn_exp2f(v.x); v.y = __builtin_amdgcn_exp2f(v.y); ps2 = ps2 + v; s[kb][r] = v.x; s[kb][r + 1] = v.y; }
            lrun += ps2.x + ps2.y;
#pragma unroll
            for (int j = 0; j < 8; ++j) {
                const int kb = j >> 1, sub = j & 1;
                if (j + 1 < 8) {
                    const int koffn = (32 * ((j + 1) >> 1) + 16 * ((j + 1) & 1) + 4 * hi) * 2;
                    vl[(j + 1) & 1][0] = *(const LAS u32x2*)(vb_ + l32 * VST + koffn); vh[(j + 1) & 1][0] = *(const LAS u32x2*)(vb_ + l32 * VST + koffn + 16);
                    vl[(j + 1) & 1][1] = *(const LAS u32x2*)(vb_ + (32 + l32) * VST + koffn); vh[(j + 1) & 1][1] = *(const LAS u32x2*)(vb_ + (32 + l32) * VST + koffn + 16);
                }
                const bf16x8 P = pack8(s[kb][8 * sub + 0], s[kb][8 * sub + 1], s[kb][8 * sub + 2], s[kb][8 * sub + 3], s[kb][8 * sub + 4], s[kb][8 * sub + 5], s[kb][8 * sub + 6], s[kb][8 * sub + 7]);
                __builtin_amdgcn_sched_barrier(0);
                o0 = MFMA32(mk8(vl[j & 1][0], vh[j & 1][0]), P, o0); o1 = MFMA32(mk8(vl[j & 1][1], vh[j & 1][1]), P, o1);
                __builtin_amdgcn_sched_barrier(0);
            }
        }
        if (t + 1 < NT) ATT_STORE(lds + (cur ^ 1) * KBUF, lds + VOFF + (cur ^ 1) * VBUF);
        __syncthreads();
    }
#undef ATT_LOAD
#undef ATT_STORE
    const float lt = lrun + __shfl_xor(lrun, 32);
    const float inv = 1.0f / lt;
    bf16_t* op = Oa + (rowb + qrow) * 512 + h * 64;
#pragma unroll
    for (int g = 0; g < 4; ++g) {
        u32x2 w0, w1;
        w0.x = cvt_pk(o0[4 * g] * inv, o0[4 * g + 1] * inv); w0.y = cvt_pk(o0[4 * g + 2] * inv, o0[4 * g + 3] * inv);
        w1.x = cvt_pk(o1[4 * g] * inv, o1[4 * g + 1] * inv); w1.y = cvt_pk(o1[4 * g + 2] * inv, o1[4 * g + 3] * inv);
        *(u32x2*)(op + 8 * g + 4 * hi) = w0; *(u32x2*)(op + 32 + 8 * g + 4 * hi) = w1;
    }
}

DI void xattn_unit(LAS unsigned char* lds, bf16_t* QX, const bf16_t* Km, const bf16_t* Vmt, int b, int h, int qb, int wv) {
    const int tid = otid(wv), lane = tid & 63, w = __builtin_amdgcn_readfirstlane(tid >> 6), l32 = lane & 31, hi = lane >> 5;
    constexpr int KST = 272, VST = 520, BUF = 128 * KST;
    const size_t row = (size_t)b * SEQ + qb * 256 + 32 * w + l32;
    bf16_t* qp = QX + row * 1024 + h * 256;
    f32x16 sacc[8];
#pragma unroll
    for (int i = 0; i < 8; ++i)
#pragma unroll
        for (int r = 0; r < 16; ++r) sacc[i][r] = 0.f;
    unsigned pp[8][8];
    bf16x8 qf[8];
    u32x4 pf[4];
#define XLOAD(i) do { if ((i) < 4) { const int dh_ = (i) >> 1, kt_ = (i) & 1; \
        _Pragma("unroll") for (int j = 0; j < 4; ++j) { const int id = tid + 512 * j, key = id >> 4, ch = id & 15; \
            pf[j] = *(const u32x4*)(Km + ((size_t)(b * 256 + 128 * kt_ + key)) * 1024 + h * 256 + 128 * dh_ + 8 * ch); } } \
      else { const int c_ = (i) - 4; \
        _Pragma("unroll") for (int j = 0; j < 4; ++j) { const int id = tid + 512 * j, dv = id >> 5, ch = id & 31; \
            pf[j] = *(const u32x4*)(Vmt + ((size_t)((b * 4 + h) * 256 + 64 * c_ + dv)) * 256 + 8 * ch); } } } while (0)
#define XSTORE(i, bufp) do { if ((i) < 4) { \
        _Pragma("unroll") for (int j = 0; j < 4; ++j) { const int id = tid + 512 * j, key = id >> 4, ch = id & 15; *(LAS u32x4*)((bufp) + key * KST + ch * 16) = pf[j]; } } \
      else { \
        _Pragma("unroll") for (int j = 0; j < 4; ++j) { const int id = tid + 512 * j, dv = id >> 5, ch = id & 31; \
            *(LAS u32x2*)((bufp) + dv * VST + ch * 16) = (u32x2){pf[j].x, pf[j].y}; *(LAS u32x2*)((bufp) + dv * VST + ch * 16 + 8) = (u32x2){pf[j].z, pf[j].w}; } } } while (0)
    XLOAD(0); XSTORE(0, lds);
    __syncthreads();
#pragma unroll
    for (int i = 0; i < 8; ++i) {
        const LAS unsigned char* cb_ = lds + (i & 1) * BUF;
        if (i + 1 < 8) XLOAD(i + 1);
        if (i < 4) {
            const int dh = i >> 1, kt = i & 1;
            if (kt == 0) {
#pragma unroll
                for (int ks = 0; ks < 8; ++ks) qf[ks] = *(const bf16x8*)(qp + 128 * dh + 16 * ks + 8 * hi);
            }
#pragma unroll
            for (int ks = 0; ks < 8; ++ks) {
#pragma unroll
                for (int j = 0; j < 4; ++j) {
                    const bf16x8 a0 = *(const LAS bf16x8*)(cb_ + (32 * j + l32) * KST + (16 * ks + 8 * hi) * 2);
                    sacc[4 * kt + j] = MFMA32(a0, qf[ks], sacc[4 * kt + j]);
                }
            }
            if (i == 3) {
                float mx = sacc[0][0];
#pragma unroll
                for (int j = 0; j < 8; ++j)
#pragma unroll
                    for (int r = 0; r < 16; ++r) mx = fmaxf(mx, sacc[j][r]);
                mx = fmaxf(mx, __shfl_xor(mx, 32));
                float ps = 0.f;
#pragma unroll
                for (int j = 0; j < 8; ++j)
#pragma unroll
                    for (int r = 0; r < 16; ++r) { sacc[j][r] = __builtin_amdgcn_exp2f(sacc[j][r] - mx); ps += sacc[j][r]; }
                ps += __shfl_xor(ps, 32);
                const float inv = 1.0f / ps;
#pragma unroll
                for (int j = 0; j < 8; ++j)
#pragma unroll
                    for (int r2 = 0; r2 < 8; ++r2) pp[j][r2] = cvt_pk(sacc[j][2 * r2] * inv, sacc[j][2 * r2 + 1] * inv);
            }
        } else {
            const int c = i - 4;
            f32x16 o0, o1;
#pragma unroll
            for (int r = 0; r < 16; ++r) { o0[r] = 0.f; o1[r] = 0.f; }
#pragma unroll
            for (int s = 0; s < 16; ++s) {
                const int kb = s >> 1, sub = s & 1;
                const u32x4 pw = {pp[kb][4 * sub], pp[kb][4 * sub + 1], pp[kb][4 * sub + 2], pp[kb][4 * sub + 3]};
                const bf16x8 P = __builtin_bit_cast(bf16x8, pw);
                const int koff = (32 * kb + 16 * sub + 4 * hi) * 2;
                const u32x2 a0l = *(const LAS u32x2*)(cb_ + l32 * VST + koff), a0h = *(const LAS u32x2*)(cb_ + l32 * VST + koff + 16);
                const u32x2 a1l = *(const LAS u32x2*)(cb_ + (32 + l32) * VST + koff), a1h = *(const LAS u32x2*)(cb_ + (32 + l32) * VST + koff + 16);
                o0 = MFMA32(mk8(a0l, a0h), P, o0); o1 = MFMA32(mk8(a1l, a1h), P, o1);
            }
#pragma unroll
            for (int g = 0; g < 4; ++g) {
                u32x2 w0, w1;
                w0.x = cvt_pk(o0[4 * g], o0[4 * g + 1]); w0.y = cvt_pk(o0[4 * g + 2], o0[4 * g + 3]);
                w1.x = cvt_pk(o1[4 * g], o1[4 * g + 1]); w1.y = cvt_pk(o1[4 * g + 2], o1[4 * g + 3]);
                *(u32x2*)(qp + 64 * c + 8 * g + 4 * hi) = w0; *(u32x2*)(qp + 64 * c + 32 + 8 * g + 4 * hi) = w1;
            }
        }
        if (i + 1 < 8) XSTORE(i + 1, lds + ((i + 1) & 1) * BUF);
        __syncthreads();
    }
#undef XLOAD
#undef XSTORE
}

DI void memkv_tile(LAS unsigned char* lds, const bf16_t* memb, const bf16_t* Wt, const float* mrstd, bf16_t* Km, bf16_t* Vmt, int tile, int wv) {
    const int tid = otid(wv), lane = tid & 63, w = wv, l32 = lane & 31, hi = lane >> 5;
    const int r0 = (tile >> 5) * 64, c0 = (tile & 31) * 64;
    f32x16 acc[2][2];
#pragma unroll
    for (int i = 0; i < 2; ++i)
#pragma unroll
        for (int j = 0; j < 2; ++j)
#pragma unroll
            for (int r = 0; r < 16; ++r) acc[i][j][r] = 0.f;
    const bf16_t* ap = memb + (size_t)(r0 + l32) * 1024 + 128 * w + 8 * hi;
    const bf16_t* bp = Wt + (size_t)(c0 + l32) * 1024 + 128 * w + 8 * hi;
#pragma unroll
    for (int ks = 0; ks < 8; ++ks) {
        const bf16x8 a0 = *(const bf16x8*)(ap + 16 * ks), a1 = *(const bf16x8*)(ap + 32 * 1024 + 16 * ks);
        const bf16x8 b0 = *(const bf16x8*)(bp + 16 * ks), b1 = *(const bf16x8*)(bp + 32 * 1024 + 16 * ks);
        acc[0][0] = MFMA32(b0, a0, acc[0][0]); acc[0][1] = MFMA32(b1, a0, acc[0][1]);
        acc[1][0] = MFMA32(b0, a1, acc[1][0]); acc[1][1] = MFMA32(b1, a1, acc[1][1]);
    }
    LAS float* red = (LAS float*)lds;
#pragma unroll
    for (int i = 0; i < 2; ++i)
#pragma unroll
        for (int j = 0; j < 2; ++j)
#pragma unroll
            for (int r = 0; r < 16; ++r) red[((w * 4 + i * 2 + j) * 16 + r) * 64 + lane] = acc[i][j][r];
    LBAR();
#pragma unroll
    for (int q = 0; q < 8; ++q) {
        const int idx = tid + 512 * q, ln = idx & 63, r = (idx >> 6) & 15, blk = idx >> 10;
        float s = 0.f;
#pragma unroll
        for (int ww = 0; ww < 8; ++ww) s += red[ww * 4096 + idx];
        const int i = blk >> 1, j = blk & 1;
        const int col = c0 + 32 * j + crow(r, ln >> 5), row = r0 + 32 * i + (ln & 31);
        const float val = s * mrstd[row];
        if (col < 1024) Km[(size_t)row * 1024 + col] = f2bf(val);
        else { const int c2 = col - 1024, h = c2 >> 8, dv = c2 & 255, b = row >> 8, key = row & 255; Vmt[((size_t)(b * 4 + h) * 256 + dv) * 256 + key] = f2bf(val); }
    }
    LBAR();
}

DI void gmlp_unit(LAS unsigned char* lds, bf16_t* zC, const float* ln_g, const float* ln_b, const float* w_s, const float* b_s, int chunk, int gp, int wv) {
    const int tid = otid(wv), lane = tid & 63, w = __builtin_amdgcn_readfirstlane(tid >> 6), l32 = lane & 31, hi = lane >> 5;
    constexpr int VST = 272;
    const size_t row0 = (size_t)chunk * 128;
    LAS bf16_t* vnT = (LAS bf16_t*)lds;
    {
        f32x4 lg0, lg1, lb0, lb1;
        lg0 = *(const f32x4*)(ln_g + 8 * lane); lg1 = *(const f32x4*)(ln_g + 8 * lane + 4);
        lb0 = *(const f32x4*)(ln_b + 8 * lane); lb1 = *(const f32x4*)(ln_b + 8 * lane + 4);
        u32x4 rawv[16];
#pragma unroll
        for (int tt = 0; tt < 16; ++tt) rawv[tt] = *(const u32x4*)(zC + (row0 + 16 * w + tt) * 1024 + 512 + 8 * lane);
#pragma unroll
        for (int tt = 0; tt < 16; ++tt) {
            const int t = 16 * w + tt;
            const u32x4 raw = rawv[tt];
            float x[8];
            x[0] = gelu_erf(bflo(raw.x)); x[1] = gelu_erf(bfhi(raw.x)); x[2] = gelu_erf(bflo(raw.y)); x[3] = gelu_erf(bfhi(raw.y));
            x[4] = gelu_erf(bflo(raw.z)); x[5] = gelu_erf(bfhi(raw.z)); x[6] = gelu_erf(bflo(raw.w)); x[7] = gelu_erf(bfhi(raw.w));
            float s = 0.f;
#pragma unroll
            for (int e = 0; e < 8; ++e) s += x[e];
            const float mean = wave_sum(s) * (1.0f / 512.0f);
            float q = 0.f;
#pragma unroll
            for (int e = 0; e < 8; ++e) { x[e] -= mean; q += x[e] * x[e]; }
            const float rstd = rsqrtf(wave_sum(q) * (1.0f / 512.0f) + EPS);
            if ((lane >> 5) == gp) {
                const int cl = 8 * (lane & 15) + 128 * ((lane >> 4) & 1);
                vnT[(cl + 0) * (VST / 2) + t] = f2bf(x[0] * rstd * lg0[0] + lb0[0]); vnT[(cl + 1) * (VST / 2) + t] = f2bf(x[1] * rstd * lg0[1] + lb0[1]);
                vnT[(cl + 2) * (VST / 2) + t] = f2bf(x[2] * rstd * lg0[2] + lb0[2]); vnT[(cl + 3) * (VST / 2) + t] = f2bf(x[3] * rstd * lg0[3] + lb0[3]);
                vnT[(cl + 4) * (VST / 2) + t] = f2bf(x[4] * rstd * lg1[0] + lb1[0]); vnT[(cl + 5) * (VST / 2) + t] = f2bf(x[5] * rstd * lg1[1] + lb1[1]);
                vnT[(cl + 6) * (VST / 2) + t] = f2bf(x[6] * rstd * lg1[2] + lb1[2]); vnT[(cl + 7) * (VST / 2) + t] = f2bf(x[7] * rstd * lg1[3] + lb1[3]);
            }
        }
    }
    LBAR();
#pragma unroll 1
    for (int gl = 0; gl < 2; ++gl) {
        const int g = 2 * gp + gl; const LAS unsigned char* vb_ = lds + gl * 128 * VST;
        const int tb = w >> 1, cb0 = 2 * (w & 1);
        f32x16 a0, a1;
#pragma unroll
        for (int r = 0; r < 16; ++r) { a0[r] = 0.f; a1[r] = 0.f; }
        const int trow = 32 * tb + l32;
        const float* wrow = w_s + ((size_t)(g * 128 + trow)) * 128;
        f32x4 wq0[8], wq1[8];
#pragma unroll
        for (int ks = 0; ks < 8; ++ks) { wq0[ks] = (f32x4){0.f, 0.f, 0.f, 0.f}; wq1[ks] = wq0[ks];
            if (ks <= 2 * tb + 1) { wq0[ks] = *(const f32x4*)(wrow + 16 * ks + 8 * hi); wq1[ks] = *(const f32x4*)(wrow + 16 * ks + 8 * hi + 4); } }
#pragma unroll
        for (int ks = 0; ks < 8; ++ks) {
            if (ks > 2 * tb + 1) break;
            const int s0 = 16 * ks + 8 * hi;
            f32x4 w0 = wq0[ks], w1 = wq1[ks];
#pragma unroll
            for (int e = 0; e < 4; ++e) { if (s0 + e > trow) w0[e] = 0.f; if (s0 + 4 + e > trow) w1[e] = 0.f; }
            const bf16x8 A = pack8(w0[0], w0[1], w0[2], w0[3], w1[0], w1[1], w1[2], w1[3]);
            const bf16x8 B0 = *(const LAS bf16x8*)(vb_ + (32 * cb0 + l32) * VST + s0 * 2);
            const bf16x8 B1 = *(const LAS bf16x8*)(vb_ + (32 * (cb0 + 1) + l32) * VST + s0 * 2);
            a0 = MFMA32(A, B0, a0); a1 = MFMA32(A, B1, a1);
        }
#pragma unroll
        for (int r = 0; r < 16; ++r) {
            const int t = 32 * tb + crow(r, hi);
            const float bs = b_s[g * 128 + t];
            bf16_t* up0 = zC + (row0 + t) * 1024 + g * 128 + 32 * cb0 + l32;
            const float u0 = gelu_erf(bf2f(up0[0])), u1 = gelu_erf(bf2f(up0[32]));
            up0[0] = f2bf((a0[r] + bs) * u0); up0[32] = f2bf((a1[r] + bs) * u1);
        }
    }
    LBAR();
}

#define HG_IDS() \
    const int k = tid & 127, seg = tid >> 7; \
    const size_t row0 = (size_t)b * SEQ + (size_t)c * 64 + 16 * seg; \
    bf16_t hfr[16], vrw[16]; \
    _Pragma("unroll") for (int i = 0; i < 16; ++i) { hfr[i] = zB[(row0 + i) * 2048 + 512 + h * 128 + k]; vrw[i] = zB[(row0 + i) * 2048 + 1024 + h * 128 + k]; }
#define HG_PREP() \
    float cum[16], kv[16]; float bref, blast; \
    { const float lb = lbv[h * 128 + k]; float run = 0.f; \
      _Pragma("unroll") for (int i = 0; i < 16; ++i) { const float fr_ = bf2f(hfr[i]); \
          const float e_ = __expf(-fr_), sg_ = __builtin_amdgcn_rcpf(1.f + e_); const float f_ = lb + (1.f - lb) * sg_; \
          run += __logf(f_); cum[i] = run; kv[i] = (1.f - lb) * e_ * sg_; } \
      segs[seg * 128 + k] = run; LBAR(); \
      const float s0_ = segs[k], s1_ = segs[128 + k], s2_ = segs[256 + k], s3_ = segs[384 + k]; \
      const float off_ = (seg > 0 ? s0_ : 0.f) + (seg > 1 ? s1_ : 0.f) + (seg > 2 ? s2_ : 0.f); \
      bref = s0_ + s1_; blast = (s0_ + s1_) + (s2_ + s3_); \
      _Pragma("unroll") for (int i = 0; i < 16; ++i) cum[i] += off_; }

constexpr int HG_QR = 0, HG_KR = 17408, HG_QD = 34816, HG_VT = 52224, HG_KDT = 70656, HG_SEG = 89088, HG_SSL = 91136;

DI void hg_u_unit(LAS unsigned char* lds, const bf16_t* zB, const float* lbv, bf16_t* ST, float* dC, int b, int h, int c, int wv) {
    const int tid = otid(wv), lane = tid & 63, w = __builtin_amdgcn_readfirstlane(tid >> 6), l32 = lane & 31, hi = lane >> 5;
    LAS float* segs = (LAS float*)(lds + HG_SEG);
    HG_IDS();
    HG_PREP();
    const int unit = (b * 4 + h) * 128 + c;
    {
        float kd[16]; unsigned vr[8];
#pragma unroll
        for (int i = 0; i < 16; ++i) kd[i] = kv[i] * __expf(blast - cum[i]);
#pragma unroll
        for (int i = 0; i < 8; ++i) { const unsigned lo = vrw[2 * i], hi2 = vrw[2 * i + 1]; vr[i] = lo | (hi2 << 16); }
        LAS unsigned char* kp = lds + HG_KDT + k * 144 + seg * 32;
        *(LAS u32x4*)kp = (u32x4){cvt_pk(kd[0], kd[1]), cvt_pk(kd[2], kd[3]), cvt_pk(kd[4], kd[5]), cvt_pk(kd[6], kd[7])};
        *(LAS u32x4*)(kp + 16) = (u32x4){cvt_pk(kd[8], kd[9]), cvt_pk(kd[10], kd[11]), cvt_pk(kd[12], kd[13]), cvt_pk(kd[14], kd[15])};
        LAS unsigned char* vp = lds + HG_VT + k * 144 + seg * 32;
        *(LAS u32x4*)vp = (u32x4){vr[0], vr[1], vr[2], vr[3]};
        *(LAS u32x4*)(vp + 16) = (u32x4){vr[4], vr[5], vr[6], vr[7]};
        if (seg == 0) dC[(size_t)unit * 128 + k] = __expf(blast);
    }
    LBAR();
    {
        const int vb = w & 3;
#pragma unroll
        for (int kbi = 0; kbi < 2; ++kbi) {
            const int kb = 2 * (w >> 2) + kbi;
            f32x16 acc;
#pragma unroll
            for (int r = 0; r < 16; ++r) acc[r] = 0.f;
#pragma unroll
            for (int ks = 0; ks < 4; ++ks) {
                const bf16x8 A = *(const LAS bf16x8*)(lds + HG_VT + (32 * vb + l32) * 144 + (16 * ks + 8 * hi) * 2);
                const bf16x8 B = *(const LAS bf16x8*)(lds + HG_KDT + (32 * kb + l32) * 144 + (16 * ks + 8 * hi) * 2);
                acc = MFMA32(A, B, acc);
            }
            bf16_t* sp = ST + (size_t)unit * 16384 + 32 * kb + l32;
#pragma unroll
            for (int r = 0; r < 16; ++r) sp[(32 * vb + crow(r, hi)) * 128] = f2bf(acc[r]);
        }
    }
    LBAR();
}

DI void hg_out_unit(LAS unsigned char* lds, const bf16_t* zB, const float* lbv, const bf16_t* ST, const float* hnorm, bf16_t* Ob, int b, int h, int c, int wv) {
    const int tid = otid(wv), lane = tid & 63, w = __builtin_amdgcn_readfirstlane(tid >> 6), l32 = lane & 31, hi = lane >> 5;
    LAS float* segs = (LAS float*)(lds + HG_SEG);
    LAS float* ssl = (LAS float*)(lds + HG_SSL);
    HG_IDS();
    const int unit = (b * 4 + h) * 128 + c;
    const int vb = w & 3, tb = w >> 2;
    bf16_t hqr[16];
#pragma unroll
    for (int i = 0; i < 16; ++i) hqr[i] = zB[(row0 + i) * 2048 + h * 128 + k];
    bf16x8 stf[8];
    {
        const bf16_t* sp = ST + (size_t)unit * 16384 + (size_t)(32 * vb + l32) * 128 + 8 * hi;
#pragma unroll
        for (int ks = 0; ks < 8; ++ks) stf[ks] = *(const bf16x8*)(sp + 16 * ks);
    }
    u32x2 grw[4];
    {
        const size_t rowg = (size_t)b * SEQ + (size_t)c * 64 + 32 * tb + l32;
#pragma unroll
        for (int g = 0; g < 4; ++g) grw[g] = *(const u32x2*)(zB + rowg * 2048 + 1536 + h * 128 + 32 * vb + 8 * g + 4 * hi);
    }
    HG_PREP();
    {
        LAS bf16_t* Qr = (LAS bf16_t*)(lds + HG_QR); LAS bf16_t* Kr = (LAS bf16_t*)(lds + HG_KR); LAS bf16_t* Qd = (LAS bf16_t*)(lds + HG_QD);
        unsigned vr[8];
#pragma unroll
        for (int i = 0; i < 16; ++i) { const int t = 16 * seg + i;
            const float qraw = bf2f(hqr[i]); const float q = qraw * sigm(qraw);
            Qr[t * 136 + k] = f2bf(q * __expf(cum[i] - bref)); Kr[t * 136 + k] = f2bf(kv[i] * __expf(bref - cum[i])); Qd[t * 136 + k] = f2bf(q * __expf(cum[i])); }
#pragma unroll
        for (int i = 0; i < 8; ++i) { const unsigned lo = vrw[2 * i], hi2 = vrw[2 * i + 1]; vr[i] = lo | (hi2 << 16); }
        LAS unsigned char* vp = lds + HG_VT + k * 144 + seg * 32;
        *(LAS u32x4*)vp = (u32x4){vr[0], vr[1], vr[2], vr[3]};
        *(LAS u32x4*)(vp + 16) = (u32x4){vr[4], vr[5], vr[6], vr[7]};
    }
    LBAR();
    f32x16 o;
#pragma unroll
    for (int r = 0; r < 16; ++r) o[r] = 0.f;
    {
#pragma unroll
        for (int ks = 0; ks < 8; ++ks) {
            const bf16x8 A = stf[ks];
            const bf16x8 B = *(const LAS bf16x8*)(lds + HG_QD + (32 * tb + l32) * 272 + (16 * ks + 8 * hi) * 2);
            o = MFMA32(A, B, o);
        }
    }
#pragma unroll
    for (int sb = 0; sb < 2; ++sb) {
        if (sb <= tb) {
            f32x16 at;
#pragma unroll
            for (int r = 0; r < 16; ++r) at[r] = 0.f;
#pragma unroll
            for (int ks = 0; ks < 8; ++ks) {
                const bf16x8 A = *(const LAS bf16x8*)(lds + HG_KR + (32 * sb + l32) * 272 + (16 * ks + 8 * hi) * 2);
                const bf16x8 B = *(const LAS bf16x8*)(lds + HG_QR + (32 * tb + l32) * 272 + (16 * ks + 8 * hi) * 2);
                at = MFMA32(A, B, at);
            }
            if (sb == tb) {
#pragma unroll
                for (int r = 0; r < 16; ++r) if (crow(r, hi) > l32) at[r] = 0.f;
            }
#pragma unroll
            for (int sub = 0; sub < 2; ++sub) {
                const bf16x8 P = pack8(at[8 * sub + 0], at[8 * sub + 1], at[8 * sub + 2], at[8 * sub + 3], at[8 * sub + 4], at[8 * sub + 5], at[8 * sub + 6], at[8 * sub + 7]);
                const int koff = (32 * sb + 16 * sub + 4 * hi) * 2;
                const u32x2 al = *(const LAS u32x2*)(lds + HG_VT + (32 * vb + l32) * 144 + koff), ah = *(const LAS u32x2*)(lds + HG_VT + (32 * vb + l32) * 144 + koff + 16);
                o = MFMA32(mk8(al, ah), P, o);
            }
        }
    }
    float ss = 0.f;
#pragma unroll
    for (int r = 0; r < 16; ++r) ss += o[r] * o[r];
    ss += __shfl_xor(ss, 32);
    if (hi == 0) ssl[vb * 64 + 32 * tb + l32] = ss;
    LBAR();
    {
        const int t = 32 * tb + l32;
        const float tot = (ssl[t] + ssl[64 + t]) + (ssl[128 + t] + ssl[192 + t]);
        const float rstd = rsqrtf(tot * (1.0f / 128.0f) + EPS);
        const size_t row = (size_t)b * SEQ + (size_t)c * 64 + t;
#pragma unroll
        for (int g = 0; g < 4; ++g) {
            const int v0 = 32 * vb + 8 * g + 4 * hi;
            const u32x2 gr = grw[g];
            const f32x4 hn = *(const f32x4*)(hnorm + v0);
            const float g0 = bflo(gr.x), g1 = bfhi(gr.x), g2 = bflo(gr.y), g3 = bfhi(gr.y);
            u32x2 ow;
            ow.x = cvt_pk(o[4 * g] * rstd * hn[0] * (g0 * sigm(g0)), o[4 * g + 1] * rstd * hn[1] * (g1 * sigm(g1)));
            ow.y = cvt_pk(o[4 * g + 2] * rstd * hn[2] * (g2 * sigm(g2)), o[4 * g + 3] * rstd * hn[3] * (g3 * sigm(g3)));
            *(u32x2*)(Ob + row * 512 + h * 128 + v0) = ow;
        }
    }
    LBAR();
}


#define XB_TMO      128
#define XB_XCNT(j)  (256  + 64 * (j))
#define XB_XSUB(j)  (1280 + 64 * (j))
#define XB_XGEN(j)  (2304 + 64 * (j))
#define XB_TOP      3328
#define XB_TOPGEN   3392
#define XCD_BAR_WORDS 3456
#define XB_SPIN_CAP (1u << 18)
DI unsigned xb_ld(unsigned* p)              { return __hip_atomic_load(p, __ATOMIC_RELAXED, __HIP_MEMORY_SCOPE_AGENT); }
DI unsigned xb_add(unsigned* p, unsigned v) { return __hip_atomic_fetch_add(p, v, __ATOMIC_RELAXED, __HIP_MEMORY_SCOPE_AGENT); }
DI unsigned xb_xcc_id() { return (unsigned)__builtin_amdgcn_s_getreg((3 << 11) | 20) & 0xFu; }
#define XB_SPIN(cond, bar) do { unsigned _sp = 0; while (cond) { __builtin_amdgcn_s_sleep(1); \
    if ((++_sp & 255u) == 0u) { if (xb_ld(&(bar)[XB_TMO])) break; if (_sp > XB_SPIN_CAP) { atomicAdd(&(bar)[XB_TMO], 1u); break; } } } } while (0)
DI void xcd_barrier_complete(unsigned* bar, unsigned x, unsigned& nloc, unsigned& nx) {
    const unsigned G = gridDim.x * gridDim.y * gridDim.z;
    unsigned sum, cnt, mine, sp = 0u;
    for (;;) {
        sum = 0u; cnt = 0u; mine = 0u;
#pragma unroll
        for (unsigned j = 0; j < 16; ++j) { const unsigned c = xb_ld(&bar[XB_XCNT(j)]); sum += c; cnt += (c > 0u) ? 1u : 0u; mine = (j == x) ? c : mine; }
        if (sum == G) break;
        __builtin_amdgcn_s_sleep(1);
        if ((++sp & 255u) == 0u) { if (xb_ld(&bar[XB_TMO])) break; if (sp > XB_SPIN_CAP) { atomicAdd(&bar[XB_TMO], 1u); break; } }
    }
    nloc = mine > 0u ? mine : 1u; nx = cnt > 0u ? cnt : 1u;
}
DI void xcd_barrier(unsigned* bar, volatile LAS unsigned* st) {
    asm volatile("s_waitcnt vmcnt(0)" ::: "memory");
    __syncthreads();
    if (threadIdx.x == 0) {
        const unsigned x = xb_xcc_id();
        __builtin_amdgcn_s_waitcnt(0);
        unsigned nloc = st[0], nx = st[1];
        if (nloc == 0u) { xcd_barrier_complete(bar, x, nloc, nx); st[0] = nloc; st[1] = nx; }
        const unsigned old = xb_add(&bar[XB_XSUB(x)], 1u);
        const unsigned gen = old / nloc;
        if (old + 1u == (gen + 1u) * nloc) {
            __builtin_amdgcn_fence(__ATOMIC_RELEASE, "agent");
            asm volatile("s_waitcnt vmcnt(0)" ::: "memory");
            const unsigned og = xb_add(&bar[XB_TOP], 1u);
            const unsigned tg = og / nx;
            if (og + 1u == (tg + 1u) * nx) xb_add(&bar[XB_TOPGEN], 1u);
            else XB_SPIN(xb_ld(&bar[XB_TOPGEN]) == tg, bar);
            __builtin_amdgcn_fence(__ATOMIC_ACQUIRE, "agent");
            xb_add(&bar[XB_XGEN(x)], 1u);
            asm volatile("s_waitcnt vmcnt(0)" ::: "memory");
        } else {
            XB_SPIN(xb_ld(&bar[XB_XGEN(x)]) == gen, bar);
            __builtin_amdgcn_fence(__ATOMIC_ACQUIRE, "agent");
            asm volatile("s_waitcnt vmcnt(0)" ::: "memory");
        }
    }
    __syncthreads();
}

constexpr size_t MiB = 1u << 20;
constexpr size_t WS_X0 = 0, WS_R2 = 32 * MiB, WS_R3 = 96 * MiB, WS_X1 = 128 * MiB, WS_R1 = 160 * MiB, WS_R4 = 184 * MiB, WS_RW = 216 * MiB;
constexpr size_t WS_CTL = 250 * MiB + 512 * 1024, CTL_BYTES = 16384;
constexpr size_t WS_P = 241 * MiB, WS_PA = 242 * MiB, WS_CS = 244 * MiB, WS_DC = 246 * MiB, WS_MEMB = 247 * MiB, WS_KM = 248 * MiB, WS_VMT = 249 * MiB, WS_MISC = 250 * MiB, WS_END = 251 * MiB;
constexpr size_t W1_IN = 0, W1_UQ = W1_IN + (size_t)6912 * 1024, W1_UKV = W1_UQ + (size_t)768 * 384, W1_BA = W1_UKV + (size_t)1024 * 256, W1_BB = W1_BA + (size_t)1024 * 512,
                 W1_BC = W1_BB + (size_t)1024 * 512, W1_MIX = W1_BC + (size_t)1024 * 512, W1_END = W1_MIX + (size_t)1024 * 1024;
constexpr size_t W2_XQ = 0, W2_XKV = W2_XQ + (size_t)1024 * 1024, W2_XO = W2_XKV + (size_t)2048 * 1024, W2_FI = W2_XO + (size_t)1024 * 1024, W2_FO = W2_FI + (size_t)5632 * 1024, W2_END = W2_FO + (size_t)1024 * 2816;
static_assert(W1_END * 2 <= 25 * MiB && W2_END * 2 <= 25 * MiB, "weight region");

constexpr int LDS_BYTES = 147456;

struct Args { const float* in[28]; float* out; unsigned char* ws; };

constexpr int PTAB_OFF = 135168;
DI void* ldptr(LAS unsigned char* lds, int i) {
    unsigned off_ = PTAB_OFF + 8 * i; asm volatile("" : "+v"(off_));
    const LAS unsigned* t = (const LAS unsigned*)(lds + off_);
    const unsigned lo = __builtin_amdgcn_readfirstlane(t[0]), hi = __builtin_amdgcn_readfirstlane(t[1]);
    typedef __attribute__((address_space(1))) unsigned char* gptr_t;
    return (void*)(gptr_t)(((unsigned long long)hi << 32) | (unsigned long long)lo);
}
#define INP(i) ((const float*)ldptr(lds, (i)))
#define PH_HEAD() \
    int G = G0_, bid = bid0_; asm volatile("" : "+s"(G), "+s"(bid)); \
    int wv = wv0_; asm volatile("" : "+s"(wv)); const int tid = otid(wv), lane = tid & 63, wave = wv; \
    const int gw = bid * 8 + wave, NGW = G * 8; (void)lane; (void)gw; (void)NGW; \
    unsigned char* ws = (unsigned char*)ldptr(lds, 29); \
    bf16_t* const X0 = (bf16_t*)(ws + WS_X0); bf16_t* const X1 = (bf16_t*)(ws + WS_X1); \
    bf16_t* const R1 = (bf16_t*)(ws + WS_R1); bf16_t* const R2 = (bf16_t*)(ws + WS_R2); bf16_t* const R3 = (bf16_t*)(ws + WS_R3); bf16_t* const R4 = (bf16_t*)(ws + WS_R4); \
    bf16_t* const RW = (bf16_t*)(ws + WS_RW); \
    float* const P = (float*)(ws + WS_P); float* const PA = (float*)(ws + WS_PA); float* const CS = (float*)(ws + WS_CS); float* const dC = (float*)(ws + WS_DC); \
    bf16_t* const memb = (bf16_t*)(ws + WS_MEMB); bf16_t* const Km = (bf16_t*)(ws + WS_KM); bf16_t* const Vmt = (bf16_t*)(ws + WS_VMT); \
    float* const mrstd = (float*)(ws + WS_MISC); float* const lbv = mrstd + 512; \
    bf16_t* const xcur = par ? X1 : X0; bf16_t* const xfree = par ? X0 : X1; \
    bf16_t* const zA = R1; bf16_t* const zB = R2; bf16_t* const zC = R4; \
    bf16_t* const Qb = R3; bf16_t* const Krb = R3 + (size_t)MTOK * 768; \
    bf16_t* const Knb = xfree; bf16_t* const Vtb = xfree + (size_t)MTOK * 512; \
    bf16_t* const Oa = R1; bf16_t* const Ob = xfree; bf16_t* const STb = R3; bf16_t* const Gt = R2; bf16_t* const MX = xcur; \
    bf16_t* const QX = R2; bf16_t* const ACT = R2; float* const xres = (float*)ldptr(lds, 28); \
    (void)X0; (void)X1; (void)R1; (void)R2; (void)R3; (void)R4; (void)RW; (void)P; (void)PA; (void)CS; (void)dC; (void)memb; (void)Km; (void)Vmt; (void)mrstd; (void)lbv; \
    (void)xcur; (void)xfree; (void)zA; (void)zB; (void)zC; (void)Qb; (void)Krb; (void)Knb; (void)Vtb; (void)Oa; (void)Ob; (void)STb; (void)Gt; (void)MX; (void)QX; (void)ACT; (void)xres;

#ifdef TPROBE
#define TSTAMP(cls) do { if (blockIdx.x == 0 && threadIdx.x == 0) { LAS unsigned long long* tp_ = (LAS unsigned long long*)(lds + PTAB_OFF + 512); \
    const unsigned long long now_ = __builtin_amdgcn_s_memrealtime(); tp_[1 + (cls)] += now_ - tp_[0]; tp_[0] = now_; } } while (0)
#else
#define TSTAMP(cls) do { } while (0)
#endif
#define GSYNC() xcd_barrier((unsigned*)((unsigned char*)ldptr(lds, 29) + WS_CTL), (volatile LAS unsigned*)(lds + PTAB_OFF + 256))
__global__ void __launch_bounds__(512, 2) mega_fwd(Args args) {
    extern __shared__ __attribute__((aligned(16))) unsigned char lds_raw[];
    LAS unsigned char* lds = (LAS unsigned char*)lds_raw;
    cg::grid_group grid = cg::this_grid();
    const int G0_ = gridDim.x, bid0_ = blockIdx.x, wv0_ = __builtin_amdgcn_readfirstlane(threadIdx.x >> 6);
    int par = 0;
    if (threadIdx.x == 0) {
        LAS unsigned long long* pt = (LAS unsigned long long*)(lds + PTAB_OFF);
#pragma unroll
        for (int i = 0; i < 28; ++i) pt[i] = (unsigned long long)args.in[i];
        pt[28] = (unsigned long long)args.out; pt[29] = (unsigned long long)args.ws;
        pt[32] = 0ull;
#ifdef TPROBE
        for (int i = 0; i < 8; ++i) pt[64 + i] = 0ull; pt[64] = __builtin_amdgcn_s_memrealtime();
#endif
        (void)xb_add((unsigned*)(args.ws + WS_CTL) + XB_XCNT(xb_xcc_id()), 1u);
    }
    __syncthreads();

    for (int l = 0; l < 2; ++l) {
        {
            PH_HEAD();
            LAS float* scr = (LAS float*)(lds + wave * 16640);
            const float* w_in = INP(4) + (size_t)l * 1024 * INW; const float* mixn = INP(3) + l * 1024;
            const float* wuq = INP(6) + (size_t)l * 384 * 768; const float* qn = INP(5) + l * 384;
            const float* wukv = INP(8) + (size_t)l * 256 * 1024; const float* kvn = INP(7) + l * 256;
            const float* wba = INP(15) + (size_t)l * 512 * 1024; const float* wbb = INP(16) + (size_t)l * 512 * 1024; const float* wbc = INP(17) + (size_t)l * 512 * 1024;
            const float* wmx = INP(18) + (size_t)l * 1024 * 1024;
            constexpr int I_IN = 16 * 108, I_UQ = 6 * 12, I_UKV = 4 * 16, I_B = 8 * 16, I_MX = 16 * 16;
            constexpr int NIT = I_IN + I_UQ + I_UKV + 3 * I_B + I_MX;
            for (int it = gw; it < NIT; it += NGW) {
                int r = it;
                if (r < I_IN) { conv_item(w_in, 1024, INW, 6912, 1, mixn, RW + W1_IN, scr, r, lane); continue; } r -= I_IN;
                if (r < I_UQ) { conv_item(wuq, 384, 768, 768, 0, qn, RW + W1_UQ, scr, r, lane); continue; } r -= I_UQ;
                if (r < I_UKV) { conv_item(wukv, 256, 1024, 1024, 0, kvn, RW + W1_UKV, scr, r, lane); continue; } r -= I_UKV;
                if (r < I_B) { conv_item(wba, 512, 1024, 1024, 0, nullptr, RW + W1_BA, scr, r, lane); continue; } r -= I_B;
                if (r < I_B) { conv_item(wbb, 512, 1024, 1024, 0, nullptr, RW + W1_BB, scr, r, lane); continue; } r -= I_B;
                if (r < I_B) { conv_item(wbc, 512, 1024, 1024, 0, nullptr, RW + W1_BC, scr, r, lane); continue; } r -= I_B;
                conv_item(wmx, 1024, 1024, 1024, 0, nullptr, RW + W1_MIX, scr, r, lane);
            }
            if (l == 0) {
                const float* xin0 = INP(0);
                for (int m0 = 4 * gw; m0 < MTOK; m0 += 4 * NGW) {
                    f32x4 vv[4][4];
#pragma unroll
                    for (int q = 0; q < 4; ++q)
#pragma unroll
                        for (int j = 0; j < 4; ++j) vv[q][j] = ((const f32x4*)(xin0 + (size_t)(m0 + q) * 1024) + lane)[64 * j];
#pragma unroll
                    for (int q = 0; q < 4; ++q) { const int m = m0 + q; float s = 0.f;
                        unsigned long long* o8 = (unsigned long long*)(xcur + (size_t)m * 1024) + lane;
#pragma unroll
                        for (int j = 0; j < 4; ++j) { const f32x4 v = vv[q][j]; s += dot4(v); o8[64 * j] = (unsigned long long)cvt_pk(v.x, v.y) | ((unsigned long long)cvt_pk(v.z, v.w) << 32); }
                        s = wave_sum(s);
                        if (lane < 16) P[(size_t)m * 16 + lane] = (lane == 0) ? s : 0.f; }
                }
                for (int m = gw; m < NB * NMEM; m += NGW) {
                    const f32x4* xr = (const f32x4*)(INP(1) + (size_t)m * 1024) + lane; float s = 0.f;
                    unsigned long long* o8 = (unsigned long long*)(memb + (size_t)m * 1024) + lane;
#pragma unroll
                    for (int j = 0; j < 4; ++j) { const f32x4 v = xr[64 * j]; s += dot4(v); o8[64 * j] = (unsigned long long)cvt_pk(v.x, v.y) | ((unsigned long long)cvt_pk(v.z, v.w) << 32); }
                    s = wave_sum(s);
                    if (lane == 0) mrstd[m] = rsqrtf(s * (1.0f / 1024.0f) + EPS);
                }
                const int* pos = (const int*)INP(2);
                for (int idx = bid * 512 + tid; idx < MTOK * 16; idx += G * 512) {
                    const int row = idx >> 4, j = idx & 15;
                    const float invf = powf(10000.0f, -(float)(2 * j) / 32.0f);
                    const float ang = (float)pos[row] * invf;
                    double tt = (double)ang * 0.15915494309189535; tt -= rint(tt);
                    const float rv = (float)tt;
                    CS[(size_t)row * 32 + j] = __builtin_amdgcn_cosf(rv); CS[(size_t)row * 32 + 16 + j] = __builtin_amdgcn_sinf(rv);
                }
                for (int idx = bid * 512 + tid; idx < 512; idx += G * 512) {
                    const float p0 = INP(9)[idx], p1 = INP(9)[512 + idx];
                    lbv[idx] = 0.f; lbv[512 + idx] = 1.0f / (1.0f + expf(p0 - p1));
                }
            }
        }
        __syncthreads();
        if (l == 0) grid.sync(); else GSYNC();
        TSTAMP(0);
        {
            PH_HEAD();
            pg8::Gemm g{xcur, RW + W1_IN, MTOK, 3840, 1024, 1024, 1024}; pg8::StaticOrder S; S.init(MTOK, 3840, G, bid);
            EpiA E{P, zA, zB, zC, PA};
            pg8::gemm_phase<EpiA>(lds, g, S, E, wv);
        }
        GSYNC();
        TSTAMP(1);
        {
            PH_HEAD();
            for (int idx = bid * 512 + tid; idx < MTOK * 16; idx += G * 512) {
                const int row = idx >> 4, j = idx & 15;
                const float x1 = bf2f(zA[(size_t)row * 768 + 640 + j]), x2 = bf2f(zA[(size_t)row * 768 + 656 + j]);
                const float cs = CS[(size_t)row * 32 + j], sn = CS[(size_t)row * 32 + 16 + j];
                Krb[(size_t)row * 32 + j] = f2bf(x1 * cs - x2 * sn); Krb[(size_t)row * 32 + 16 + j] = f2bf(x1 * sn + x2 * cs);
            }
            { pg8::Gemm g{zA, RW + W1_UQ, MTOK, 768, 384, 768, 384}; pg8::StaticOrder S; S.init(MTOK, 768, G, bid);
              EpiQ E{PA, CS, Qb}; pg8::gemm_phase<EpiQ>(lds, g, S, E, wv); }
            { pg8::Gemm g{zA + 384, RW + W1_UKV, MTOK, 1024, 256, 768, 256}; pg8::StaticOrder S; S.init(MTOK, 1024, G, bid);
              EpiKV E{PA, Knb, Vtb}; pg8::gemm_phase<EpiKV>(lds, g, S, E, wv); }
        }
        __syncthreads();
        GSYNC();
        TSTAMP(1);
        {
            PH_HEAD();
            for (int item = bid; item < 256; item += G) {
                const int b = item >> 7, h = (item >> 4) & 7, s = item & 15;
                attn_unit(lds, Qb, Knb, Krb, Vtb, Oa, b, h, 31 - s, wv);
                attn_unit(lds, Qb, Knb, Krb, Vtb, Oa, b, h, s, wv);
            }
#ifdef TPROBE
            GSYNC(); TSTAMP(2);
#endif
            const float* lng = INP(11) + l * 512; const float* lnb = INP(12) + l * 512;
            const float* wsp = INP(13) + (size_t)l * 4 * 128 * 128; const float* bsp = INP(14) + l * 512;
            for (int u = bid; u < 256; u += G) gmlp_unit(lds, zC, lng, lnb, wsp, bsp, u >> 1, u & 1, wv);
        }
        GSYNC();
#ifdef TPROBE
        TSTAMP(5);
#else
        TSTAMP(2);
#endif
        {
            PH_HEAD();
            for (int u = bid; u < 1024; u += G) hg_u_unit(lds, zB, lbv + l * 512, STb, dC, u >> 9, (u >> 7) & 3, u & 127, wv);
        }
        GSYNC();
        TSTAMP(3);
        {
            PH_HEAD();
            if (tid < 256) {
                for (int p = bid * 256 + tid; p < 65536; p += G * 256) {
                    const int bh = p >> 13, e2 = p & 8191;
                    unsigned* sp = (unsigned*)STb + (size_t)bh * 128 * 8192 + e2;
                    const float* dp = dC + (size_t)bh * 128 * 128 + ((2 * e2) & 127);
                    float S0 = 0.f, S1 = 0.f;
                    for (int c0 = 0; c0 < 128; c0 += 32) {
                        unsigned uu[32]; f32x2 dd[32];
#pragma unroll
                        for (int i = 0; i < 32; ++i) { uu[i] = sp[(size_t)(c0 + i) * 8192]; dd[i] = *(const f32x2*)(dp + (size_t)(c0 + i) * 128); }
#pragma unroll
                        for (int i = 0; i < 32; ++i) { sp[(size_t)(c0 + i) * 8192] = cvt_pk(S0, S1); S0 = dd[i].x * S0 + bflo(uu[i]); S1 = dd[i].y * S1 + bfhi(uu[i]); }
                    }
                }
            }
        }
        GSYNC();
        TSTAMP(3);
        {
            PH_HEAD();
            for (int u = bid; u < 1024; u += G) hg_out_unit(lds, zB, lbv + l * 512, STb, INP(10) + l * 128, Ob, u >> 9, (u >> 7) & 3, u & 127, wv);
        }
        GSYNC();
        TSTAMP(3);
        {
            PH_HEAD();
            pg8::Gemm g{xcur, RW + W1_IN + (size_t)3840 * 1024, MTOK, 3072, 1024, 1024, 1024}; pg8::StaticOrder S; S.init(MTOK, 3072, G, bid);
            EpiPlain<true> E{P, Gt, 3072, 1.0f};
            pg8::gemm_phase<EpiPlain<true>>(lds, g, S, E, wv);
        }
        GSYNC();
        TSTAMP(1);
        {
            PH_HEAD();
            pg8::StaticOrder S; S.init(MTOK, 1024, G, bid);
            { pg8::Gemm g{Oa, RW + W1_BA, MTOK, 1024, 512, 512, 512}; EpiBr E{Gt, MX, 0}; pg8::gemm_phase<EpiBr>(lds, g, S, E, wv); }
            { pg8::Gemm g{Ob, RW + W1_BB, MTOK, 1024, 512, 512, 512}; EpiBr E{Gt, MX, 1}; pg8::gemm_phase<EpiBr>(lds, g, S, E, wv); }
            { pg8::Gemm g{zC, RW + W1_BC, MTOK, 1024, 512, 1024, 512}; EpiBr E{Gt, MX, 2}; pg8::gemm_phase<EpiBr>(lds, g, S, E, wv); }
        }
        GSYNC();
        TSTAMP(1);
        {
            PH_HEAD();
            pg8::Gemm g{MX, RW + W1_MIX, MTOK, 1024, 1024, 1024, 1024}; pg8::StaticOrder S; S.init(MTOK, 1024, G, bid);
            EpiRes E{l == 0 ? INP(0) : (const float*)xres, xres, xfree, P};
            pg8::gemm_phase<EpiRes>(lds, g, S, E, wv);
        }
        par ^= 1;
        GSYNC();
        TSTAMP(1);
        {
            PH_HEAD();
            LAS float* scr = (LAS float*)(lds + wave * 16640);
            const float* wxq = INP(21) + (size_t)l * 1024 * 1024; const float* xan = INP(19) + l * 1024;
            const float* wxkv = INP(22) + (size_t)l * 1024 * 2048; const float* memn = INP(20) + l * 1024;
            const float* wxo = INP(23) + (size_t)l * 1024 * 1024;
            const float* wfi = INP(25) + (size_t)l * 1024 * 2 * DFF; const float* ffn = INP(24) + l * 1024;
            const float* wfo = INP(26) + (size_t)l * DFF * 1024;
            constexpr int I_XQ = 16 * 16, I_XKV = 16 * 32, I_FI = 16 * 88, I_FO = 44 * 16;
            constexpr int NIT = 2 * I_XQ + I_XKV + I_FI + I_FO;
            for (int it = gw; it < NIT; it += NGW) {
                int r = it;
                if (r < I_XQ) { conv_item(wxq, 1024, 1024, 1024, 0, xan, RW + W2_XQ, scr, r, lane); continue; } r -= I_XQ;
                if (r < I_XKV) { conv_item(wxkv, 1024, 2048, 2048, 0, memn, RW + W2_XKV, scr, r, lane); continue; } r -= I_XKV;
                if (r < I_XQ) { conv_item(wxo, 1024, 1024, 1024, 0, nullptr, RW + W2_XO, scr, r, lane); continue; } r -= I_XQ;
                if (r < I_FI) { conv_item(wfi, 1024, 2 * DFF, 2 * DFF, 2, ffn, RW + W2_FI, scr, r, lane); continue; } r -= I_FI;
                conv_item(wfo, DFF, 1024, 1024, 0, nullptr, RW + W2_FO, scr, r, lane);
            }
        }
        __syncthreads();
        GSYNC();
        TSTAMP(0);
        {
            PH_HEAD();
            { pg8::Gemm g{xcur, RW + W2_XQ, MTOK, 1024, 1024, 1024, 1024}; pg8::StaticOrder S; S.init(MTOK, 1024, G, bid);
              EpiPlain<false> E{P, QX, 1024, XSC}; pg8::gemm_phase<EpiPlain<false>>(lds, g, S, E, wv); }
            for (int t = bid; t < 256; t += G) memkv_tile(lds, memb, RW + W2_XKV, mrstd, Km, Vmt, t, wv);
        }
        GSYNC();
        TSTAMP(1);
        {
            PH_HEAD();
            for (int u = bid; u < 256; u += G) xattn_unit(lds, QX, Km, Vmt, u >> 7, (u >> 5) & 3, u & 31, wv);
        }
        GSYNC();
        TSTAMP(4);
        {
            PH_HEAD();
            pg8::Gemm g{QX, RW + W2_XO, MTOK, 1024, 1024, 1024, 1024}; pg8::StaticOrder S; S.init(MTOK, 1024, G, bid);
            EpiRes E{xres, xres, xcur, P};
            pg8::gemm_phase<EpiRes>(lds, g, S, E, wv);
        }
        GSYNC();
        TSTAMP(1);
        {
            PH_HEAD();
            pg8::Gemm g{xcur, RW + W2_FI, MTOK, 2 * DFF, 1024, 1024, 1024}; pg8::StaticOrder S; S.init(MTOK, 2 * DFF, G, bid);
            EpiFF E{P, ACT};
            pg8::gemm_phase<EpiFF>(lds, g, S, E, wv);
        }
        GSYNC();
        TSTAMP(1);
        {
            PH_HEAD();
            pg8::Gemm g{ACT, RW + W2_FO, MTOK, 1024, DFF, DFF, DFF}; pg8::StaticOrder S; S.init(MTOK, 1024, G, bid);
            EpiRes E{xres, xres, xcur, P};
            pg8::gemm_phase<EpiRes>(lds, g, S, E, wv);
        }
        GSYNC();
        TSTAMP(1);
    }
    {
        PH_HEAD();
        const float* fn = INP(27);
        const f32x4* gp = (const f32x4*)fn + lane;
        f32x4 gg[4];
#pragma unroll
        for (int j = 0; j < 4; ++j) gg[j] = gp[64 * j];
        for (int m0 = 4 * gw; m0 < MTOK; m0 += 4 * NGW) {
            f32x4 vv[4][4]; float rs[4];
#pragma unroll
            for (int q = 0; q < 4; ++q) { rs[q] = row_rstd16(P, m0 + q);
#pragma unroll
                for (int j = 0; j < 4; ++j) vv[q][j] = ((const f32x4*)(xres + (size_t)(m0 + q) * 1024) + lane)[64 * j]; }
#pragma unroll
            for (int q = 0; q < 4; ++q)
#pragma unroll
                for (int j = 0; j < 4; ++j) ((f32x4*)(xres + (size_t)(m0 + q) * 1024) + lane)[64 * j] = vv[q][j] * rs[q] * gg[j];
        }
#ifdef TPROBE
        GSYNC(); TSTAMP(6);
        if (blockIdx.x == 0) {
            __syncthreads();
            LAS unsigned long long* tp_ = (LAS unsigned long long*)(lds + PTAB_OFF + 512);
            const float ta = (float)tp_[1 + TPA] * 0.01f, tb = (float)tp_[1 + TPB] * 0.01f;
            if (tid == 0) xres[0] = 10.0f * ta;
            for (int i = tid; i < 10000; i += 512) xres[16 + i] = tb;
        }
#endif
    }
}

extern "C" void kernel_launch(void* const* d_in, const int* in_sizes, int n_in, void* d_out, int out_size, void* d_ws, size_t ws_size, hipStream_t stream) {
    static int grid = 0;
    if (grid == 0) {
        if (n_in != 28 || out_size != MTOK * DM || ws_size < WS_END) { fprintf(stderr, "kernel_launch: unexpected problem (n_in %d out %d ws %zu)\n", n_in, out_size, ws_size); grid = -1; return; }
        int dev = 0, cus = 0, per_cu = 0;
        (void)hipGetDevice(&dev);
        (void)hipDeviceGetAttribute(&cus, hipDeviceAttributeMultiprocessorCount, dev);
        (void)hipFuncSetAttribute((const void*)mega_fwd, hipFuncAttributeMaxDynamicSharedMemorySize, LDS_BYTES);
        (void)hipOccupancyMaxActiveBlocksPerMultiprocessor(&per_cu, (const void*)mega_fwd, 512, LDS_BYTES);
        if (per_cu < 1 || cus < 1) { fprintf(stderr, "kernel_launch: occupancy query gave %d blocks/CU on %d CUs\n", per_cu, cus); grid = -1; return; }
        grid = cus;
    }
    if (grid < 0) return;
    (void)hipMemsetAsync((char*)d_ws + WS_CTL, 0, CTL_BYTES, stream);
    Args a{};
    for (int i = 0; i < 28; ++i) a.in[i] = (const float*)d_in[i];
    a.out = (float*)d_out; a.ws = (unsigned char*)d_ws;
    void* kargs[] = {&a};
    hipError_t e = hipLaunchCooperativeKernel((const void*)mega_fwd, dim3(grid), dim3(512), kargs, LDS_BYTES, stream);
    if (e != hipSuccess) fprintf(stderr, "cooperative launch failed: %s (grid %d)\n", hipGetErrorString(e), grid);
}
```

```cpp
#include <hip/hip_runtime.h>
#include <hip/hip_cooperative_groups.h>
#include <cstdio>
#include <cstdint>
namespace cg = cooperative_groups;

#define LAS __attribute__((address_space(3)))
#define DI __device__ __forceinline__
typedef unsigned short bf16_t;
typedef short bf16x8 __attribute__((ext_vector_type(8)));
typedef float f32x2 __attribute__((ext_vector_type(2)));
typedef float f32x4 __attribute__((ext_vector_type(4)));
typedef float f32x16 __attribute__((ext_vector_type(16)));
typedef unsigned u32x2 __attribute__((ext_vector_type(2)));
typedef unsigned u32x4 __attribute__((ext_vector_type(4)));

constexpr int SEQ = 8192, NB = 2, MTOK = NB * SEQ, DM = 1024, NMEM = 256;
constexpr int INW = 6816, DFF = 2816;
constexpr float EPS = 1e-6f;
constexpr float QSC = 0.10206207261596575f * 1.4426950408889634f;
constexpr float XSC = 0.0625f * 1.4426950408889634f;

DI unsigned cvt_pk(float lo, float hi) {
    typedef __bf16 b2 __attribute__((ext_vector_type(2)));
    f32x2 v = {lo, hi}; b2 b = __builtin_convertvector(v, b2); return __builtin_bit_cast(unsigned, b);
}
DI bf16_t f2bf(float f) { return (bf16_t)(cvt_pk(f, 0.f) & 0xffffu); }
DI float bf2f(bf16_t h) { return __uint_as_float((unsigned)h << 16); }
DI float bflo(unsigned w) { return __uint_as_float(w << 16); }
DI float bfhi(unsigned w) { return __uint_as_float(w & 0xffff0000u); }
DI int olane() { int t = __builtin_amdgcn_mbcnt_hi(~0u, __builtin_amdgcn_mbcnt_lo(~0u, 0u)); asm volatile("" : "+v"(t)); return t; }
DI int otid(int wv) { return wv * 64 + olane(); }
DI float wave_sum(float v) {
#pragma unroll
    for (int o = 1; o < 64; o <<= 1) v += __shfl_xor(v, o);
    return v;
}
DI float sigm(float x) { return __builtin_amdgcn_rcpf(1.f + __expf(-x)); }
DI void sigm2(float a, float b, float& sa, float& sb) {
    const float da = 1.f + __expf(-a), db = 1.f + __expf(-b); const float r = __builtin_amdgcn_rcpf(da * db); sa = r * db; sb = r * da; }
DI float gelu_erf(float v) {
    const float av = fabsf(v), t = __builtin_amdgcn_rcpf(av * 0.2316418882f + 1.0f);
    float q = t * 0.5307027145f + (-0.7265760135f); q = q * t + 0.7107068705f; q = q * t + (-0.142248368f); q = q * t + 0.127414796f; q = q * t;
    const float e = __builtin_amdgcn_exp2f((v * v) * (-0.72134752044f));
    const float m = v * (q * e);
    return v < 0.f ? m : v - m;
}
DI int crow(int r, int h) { return (r & 3) + 8 * (r >> 2) + 4 * h; }
DI float dot4(f32x4 a) { return (a.x * a.x + a.y * a.y) + (a.z * a.z + a.w * a.w); }
DI float sum4(f32x4 a) { return (a.x + a.y) + (a.z + a.w); }
#define LBAR() do { asm volatile("s_waitcnt lgkmcnt(0)" ::: "memory"); __builtin_amdgcn_s_barrier(); asm volatile("" ::: "memory"); } while (0)
#define MFMA32(a, b, c) __builtin_amdgcn_mfma_f32_32x32x16_bf16((a), (b), (c), 0, 0, 0)
DI bf16x8 mk8(u32x2 lo, u32x2 hi) { u32x4 v = {lo.x, lo.y, hi.x, hi.y}; return __builtin_bit_cast(bf16x8, v); }
DI bf16x8 pack8(float a0, float a1, float a2, float a3, float a4, float a5, float a6, float a7) {
    u32x4 v = {cvt_pk(a0, a1), cvt_pk(a2, a3), cvt_pk(a4, a5), cvt_pk(a6, a7)}; return __builtin_bit_cast(bf16x8, v);
}

namespace pg8 {
constexpr int BM = 256, BK = 64, HALF = 128, HTB = HALF * BK * 2, STAGE_BYTES = 8 * HTB, NXCD = 8, WGM = 8;
DI int lds_byte(int r, int c) { const int st = (r >> 4) * 2 + (c >> 5), rr = r & 15, cc = c & 31, ob = rr * 64 + cc * 2; return st * 1024 + (ob ^ (((ob >> 9) & 1) << 5)); }
DI void stage_rc(int b, int& R, int& C) { const int st = b / 1024, sb = b % 1024, swz = sb ^ (((sb >> 9) & 1) << 5); R = (st >> 1) * 16 + swz / 64; C = (st & 1) * 32 + (swz % 64) / 2; }
DI int perm32(int rho) { const int n = rho >> 4, i = rho & 15; return 8 * (i >> 2) + 4 * n + (i & 3); }
struct Unit { int pm, pn; };
struct Gemm { const bf16_t* A; const bf16_t* Bt; int M, N, K, lda, ldb; };
struct StaticOrder {
    int nM, nN, nwg, G, c;
    DI void init(int M, int N, int G_, int c_) { nM = M / BM; nN = N / BM; nwg = nM * nN; G = G_; c = c_; }
    DI bool next(int i, Unit& u) const {
        const long L = (long)i * G + c; if (L >= nwg) return false;
        int wgid = (int)L; { const int q = nwg / NXCD, r = nwg % NXCD, xcd = wgid % NXCD, off = wgid / NXCD; wgid = (xcd < r ? xcd * (q + 1) : r * (q + 1) + (xcd - r) * q) + off; }
        const int nig = WGM * nN, gid = wgid / nig, fm = gid * WGM, gsz = (nM - fm) < WGM ? (nM - fm) : WGM;
        u.pm = fm + ((wgid % nig) % gsz); u.pn = (wgid % nig) / gsz; return true;
    }
};
template <class Epi>
DI void gemm_phase(LAS unsigned char* lds, const Gemm g, const StaticOrder& S, const Epi& E, int wv) {
    const int tid = otid(wv), wid = __builtin_amdgcn_readfirstlane(tid >> 6), lane = tid & 63, wr = wid >> 2, wc = wid & 3, fr = lane & 15, fq = lane >> 4;
    const int K = g.K, nt = K / BK;
    unsigned voffA[2], voffB[2];
#pragma unroll
    for (int i = 0; i < 2; ++i) { int R, C; stage_rc(tid * 16 + i * 8192, R, C); const int Rb = Epi::PERM ? ((R & ~31) + perm32(R & 31)) : R;
        voffA[i] = (unsigned)(R * g.lda + C) * 2u; voffB[i] = (unsigned)(Rb * g.ldb + C) * 2u; }
    const size_t kstep = (size_t)(BK * 2);
    const size_t hsA = (size_t)HALF * g.lda * 2, hsB = (size_t)HALF * g.ldb * 2;
    const size_t tsA = 2 * hsA, tsB = 2 * hsB;
    const unsigned ldsw = (unsigned)wid * 1024u;
    const int aoff = lds_byte(wr * 64 + fr, fq * 8), boff = lds_byte(wc * 32 + fr, fq * 8);
#define PG8_SA(b, h) (((b) * 2 + (h)) * HTB)
#define PG8_SB(b, h) ((4 + (b) * 2 + (h)) * HTB)
#define PG8_STAGE(bufoff, gbase, voff) do { const char* gb_ = (const char*)(gbase); asm volatile("" : "+s"(gb_)); _Pragma("unroll") for (int _i = 0; _i < 2; ++_i) { unsigned vo_ = (voff)[_i]; asm volatile("" : "+v"(vo_)); \
        __builtin_amdgcn_global_load_lds((const unsigned*)(gb_ + vo_), (LAS unsigned*)(lds + (bufoff) + ldsw + _i * 8192), 16, 0, 0); } } while (0)
#define PG8_LDA(dst, b, h) do { _Pragma("unroll") for (int m = 0; m < 4; ++m) _Pragma("unroll") for (int k = 0; k < 2; ++k) dst[m][k] = *(const LAS bf16x8*)(lds + PG8_SA(b, h) + aoff + m * 2048 + k * 1024); } while (0)
#define PG8_LDB(dst, b, h) do { _Pragma("unroll") for (int n = 0; n < 2; ++n) _Pragma("unroll") for (int k = 0; k < 2; ++k) dst[n][k] = *(const LAS bf16x8*)(lds + PG8_SB(b, h) + boff + n * 2048 + k * 1024); } while (0)
#define PG8_MMA(ai, bj, At, Bt) do { __builtin_amdgcn_s_setprio(1); _Pragma("unroll") for (int m = 0; m < 4; ++m) _Pragma("unroll") for (int n = 0; n < 2; ++n) _Pragma("unroll") for (int k = 0; k < 2; ++k) \
        acc[ai][bj][m][n] = __builtin_amdgcn_mfma_f32_16x16x32_bf16(Bt[n][k], At[m][k], acc[ai][bj][m][n], 0, 0, 0); __builtin_amdgcn_s_setprio(0); } while (0)
#define PG8_WAIT_V(n) asm volatile("s_waitcnt vmcnt(" #n ")" ::: "memory")
#define PG8_WAIT_L(n) asm volatile("s_waitcnt lgkmcnt(" #n ")" ::: "memory")
#define PG8_BAR __builtin_amdgcn_s_barrier()
#define PG8_SCHED __builtin_amdgcn_sched_barrier(0)
    Unit cur, nxt; int ui = 0;
    if (!S.next(0, cur)) return;
    f32x4 acc[2][2][4][2];
#pragma unroll
    for (int a = 0; a < 2; ++a)
#pragma unroll
        for (int b = 0; b < 2; ++b)
#pragma unroll
            for (int m = 0; m < 4; ++m)
#pragma unroll
                for (int n = 0; n < 2; ++n) acc[a][b][m][n] = (f32x4){0.f, 0.f, 0.f, 0.f};
    bf16x8 At[4][2], B0[2][2], B1[2][2];
    const char* cA = (const char*)g.A + (size_t)cur.pm * tsA; const char* cB = (const char*)g.Bt + (size_t)cur.pn * tsB;
    PG8_STAGE(PG8_SB(0, 0), cB, voffB); PG8_STAGE(PG8_SB(0, 1), cB + hsB, voffB); PG8_STAGE(PG8_SA(0, 0), cA, voffA); PG8_STAGE(PG8_SA(0, 1), cA + hsA, voffA);
    if (wr == 1) PG8_BAR;
    PG8_WAIT_V(2); PG8_BAR;
    PG8_STAGE(PG8_SB(1, 0), cB + kstep, voffB); PG8_STAGE(PG8_SA(1, 0), cA + kstep, voffA); PG8_STAGE(PG8_SB(1, 1), cB + hsB + kstep, voffB);
    PG8_WAIT_V(6); PG8_BAR;
    for (;;) {
        const bool has_next = S.next(ui + 1, nxt);
        const char* nA = has_next ? (const char*)g.A + (size_t)nxt.pm * tsA : cA; const char* nB = has_next ? (const char*)g.Bt + (size_t)nxt.pn * tsB : cB;
        for (int t = 0; t < nt; t += 2) {
            const bool last = (t == nt - 2);
            const char* a1 = cA + (size_t)(t + 1) * kstep;
            const char* a2 = last ? nA : cA + (size_t)(t + 2) * kstep; const char* b2 = last ? nB : cB + (size_t)(t + 2) * kstep;
            const char* a3 = a2 + kstep; const char* b3 = b2 + kstep;
            PG8_LDB(B0, 0, 0); PG8_LDB(B1, 0, 1); PG8_SCHED; PG8_LDA(At, 0, 0); PG8_STAGE(PG8_SA(1, 1), a1 + hsA, voffA);
            PG8_WAIT_V(8); PG8_WAIT_L(0); PG8_BAR; PG8_MMA(0, 0, At, B0); PG8_MMA(0, 1, At, B1); PG8_BAR; PG8_SCHED;
            PG8_LDA(At, 0, 1); PG8_STAGE(PG8_SB(0, 0), b2, voffB); PG8_STAGE(PG8_SB(0, 1), b2 + hsB, voffB); PG8_STAGE(PG8_SA(0, 0), a2, voffA);
            PG8_WAIT_V(8); PG8_WAIT_L(0); PG8_BAR; PG8_MMA(1, 0, At, B0); PG8_MMA(1, 1, At, B1); PG8_BAR; PG8_SCHED;
            PG8_LDB(B0, 1, 0); PG8_LDB(B1, 1, 1); PG8_SCHED; PG8_LDA(At, 1, 0); PG8_STAGE(PG8_SA(0, 1), a2 + hsA, voffA);
            PG8_WAIT_V(8); PG8_WAIT_L(0); PG8_BAR; PG8_MMA(0, 0, At, B0); PG8_MMA(0, 1, At, B1); PG8_BAR; PG8_SCHED;
            PG8_LDA(At, 1, 1); PG8_STAGE(PG8_SB(1, 0), b3, voffB); PG8_STAGE(PG8_SB(1, 1), b3 + hsB, voffB); PG8_STAGE(PG8_SA(1, 0), a3, voffA);
            PG8_WAIT_V(8); PG8_WAIT_L(0); PG8_BAR; PG8_MMA(1, 0, At, B0); PG8_MMA(1, 1, At, B1); PG8_BAR; PG8_SCHED;
        }
        if (wr == 0) PG8_BAR;
        { const int ln_ = olane(); E(acc, cur, wr, wc, ln_ & 15, ln_ >> 4); }
        if (!has_next) break;
#pragma unroll
        for (int a = 0; a < 2; ++a)
#pragma unroll
            for (int b = 0; b < 2; ++b)
#pragma unroll
                for (int m = 0; m < 4; ++m)
#pragma unroll
                    for (int n = 0; n < 2; ++n) acc[a][b][m][n] = (f32x4){0.f, 0.f, 0.f, 0.f};
        cur = nxt; cA = nA; cB = nB; ++ui;
        if (wr == 1) PG8_BAR;
    }
    PG8_WAIT_V(0);
    PG8_BAR;
#undef PG8_SA
#undef PG8_SB
#undef PG8_STAGE
#undef PG8_LDA
#undef PG8_LDB
#undef PG8_MMA
#undef PG8_WAIT_V
#undef PG8_WAIT_L
#undef PG8_BAR
#undef PG8_SCHED
}
}
typedef const f32x4 (&AccRef)[2][2][4][2];

DI float row_rstd16(const float* P, int row) {
    const f32x4* p = (const f32x4*)(P + (size_t)row * 16);
    const float s = (sum4(p[0]) + sum4(p[1])) + (sum4(p[2]) + sum4(p[3]));
    return rsqrtf(s * (1.0f / 1024.0f) + EPS);
}
DI float row_ssq_q(const float* Pq, int stride, int nq, int row, int fq) {
    float s = 0.f;
    if (fq < nq) s = sum4(*(const f32x4*)(Pq + (size_t)row * stride + 4 * fq));
    s += __shfl_xor(s, 16); s += __shfl_xor(s, 32);
    return s;
}
DI u32x4 pk16(f32x4 v0, f32x4 v1) { u32x4 w; w.x = cvt_pk(v0[0], v0[1]); w.y = cvt_pk(v0[2], v0[3]); w.z = cvt_pk(v1[0], v1[1]); w.w = cvt_pk(v1[2], v1[3]); return w; }
DI u32x2 pk8(f32x4 v) { u32x2 w; w.x = cvt_pk(v[0], v[1]); w.y = cvt_pk(v[2], v[3]); return w; }

struct EpiA { static constexpr bool PERM = true;
    const float* P; bf16_t* zA; bf16_t* zB; bf16_t* zC; float* PA;
    DI void operator()(AccRef acc, const pg8::Unit& u, int wr, int wc, int fr, int fq) const {
        const int pn = u.pn; bf16_t* base; int ld, colt;
        if (pn < 3) { base = zA; ld = 768; colt = pn * 256; } else if (pn < 11) { base = zB; ld = 2048; colt = (pn - 3) * 256; } else { base = zC; ld = 1024; colt = (pn - 11) * 256; }
        const int row0 = u.pm * 256 + wr * 64 + fr, col0 = colt + wc * 32 + 8 * fq;
float rsv[2][4];
#pragma unroll
        for (int ai = 0; ai < 2; ++ai)
#pragma unroll
            for (int m = 0; m < 4; ++m) rsv[ai][m] = rsqrtf(row_ssq_q(P, 16, 4, row0 + ai * 128 + m * 16, fq) * (1.0f / 1024.0f) + EPS);
#pragma unroll
        for (int ai = 0; ai < 2; ++ai)
#pragma unroll
            for (int m = 0; m < 4; ++m) { const int row = row0 + ai * 128 + m * 16; const float rs = rsv[ai][m];
#pragma unroll
                for (int bj = 0; bj < 2; ++bj) { const f32x4 v0 = acc[ai][bj][m][0] * rs, v1 = acc[ai][bj][m][1] * rs;
                    if (pn < 3) { float s = dot4(v0) + dot4(v1); s += __shfl_xor(s, 16); s += __shfl_xor(s, 32); if (fq == 0) PA[(size_t)row * 32 + pn * 8 + bj * 4 + wc] = s; }
                    *(u32x4*)(base + (size_t)row * ld + col0 + bj * 128) = pk16(v0, v1); } }
    }
};
template <bool SIG> struct EpiPlain { static constexpr bool PERM = true;
    const float* P; bf16_t* O; int ldo; float scale;
    DI void operator()(AccRef acc, const pg8::Unit& u, int wr, int wc, int fr, int fq) const {
        const int row0 = u.pm * 256 + wr * 64 + fr, col0 = u.pn * 256 + wc * 32 + 8 * fq;
float rsv[2][4];
#pragma unroll
        for (int ai = 0; ai < 2; ++ai)
#pragma unroll
            for (int m = 0; m < 4; ++m) rsv[ai][m] = rsqrtf(row_ssq_q(P, 16, 4, row0 + ai * 128 + m * 16, fq) * (1.0f / 1024.0f) + EPS) * scale;
#pragma unroll
        for (int ai = 0; ai < 2; ++ai)
#pragma unroll
            for (int m = 0; m < 4; ++m) { const int row = row0 + ai * 128 + m * 16; const float rs = rsv[ai][m];
#pragma unroll
                for (int bj = 0; bj < 2; ++bj) { f32x4 v0 = acc[ai][bj][m][0] * rs, v1 = acc[ai][bj][m][1] * rs;
                    if (SIG) {
#pragma unroll
                        for (int e = 0; e < 4; ++e) { float sa, sb; sigm2(v0[e], v1[e], sa, sb); v0[e] = sa; v1[e] = sb; } }
                    *(u32x4*)(O + (size_t)row * ldo + col0 + bj * 128) = pk16(v0, v1); } }
    }
};
struct EpiQ { static constexpr bool PERM = false;
    const float* PA; const float* CS; bf16_t* Q;
    DI void operator()(AccRef acc, const pg8::Unit& u, int wr, int wc, int fr, int fq) const {
        const int row0 = u.pm * 256 + wr * 64 + fr;
float rsv[2][4];
#pragma unroll
        for (int ai = 0; ai < 2; ++ai)
#pragma unroll
            for (int m = 0; m < 4; ++m) rsv[ai][m] = rsqrtf(row_ssq_q(PA, 32, 3, row0 + ai * 128 + m * 16, fq) * (1.0f / 384.0f) + EPS);
#pragma unroll
        for (int ai = 0; ai < 2; ++ai)
#pragma unroll
            for (int m = 0; m < 4; ++m) { const int row = row0 + ai * 128 + m * 16;
                const float rs = rsv[ai][m];
                const f32x4 cs = *(const f32x4*)(CS + (size_t)row * 32 + 4 * fq), sn = *(const f32x4*)(CS + (size_t)row * 32 + 16 + 4 * fq);
#pragma unroll
                for (int bj = 0; bj < 2; ++bj) { const int g32 = u.pn * 8 + bj * 4 + wc;
                    f32x4 v0 = acc[ai][bj][m][0] * rs, v1 = acc[ai][bj][m][1] * rs;
                    if ((g32 % 3) == 2) { const f32x4 y0 = v0 * cs - v1 * sn, y1 = v0 * sn + v1 * cs; v0 = y0; v1 = y1; }
                    v0 = v0 * QSC; v1 = v1 * QSC;
                    bf16_t* o = Q + (size_t)row * 768 + u.pn * 256 + bj * 128 + wc * 32 + 4 * fq;
                    *(u32x2*)(o) = pk8(v0); *(u32x2*)(o + 16) = pk8(v1); } }
    }
};
struct EpiKV { static constexpr bool PERM = true;
    const float* PA; bf16_t* Kn; bf16_t* Vt;
    DI void operator()(AccRef acc, const pg8::Unit& u, int wr, int wc, int fr, int fq) const {
        const int row0 = u.pm * 256 + wr * 64 + fr;
float rsv[2][4];
#pragma unroll
        for (int ai = 0; ai < 2; ++ai)
#pragma unroll
            for (int m = 0; m < 4; ++m) rsv[ai][m] = rsqrtf(row_ssq_q(PA + 12, 32, 2, row0 + ai * 128 + m * 16, fq) * (1.0f / 256.0f) + EPS);
#pragma unroll
        for (int ai = 0; ai < 2; ++ai)
#pragma unroll
            for (int m = 0; m < 4; ++m) { const int row = row0 + ai * 128 + m * 16;
                const float rs = rsv[ai][m];
                const int b = row / SEQ, tok = row % SEQ;
#pragma unroll
                for (int bj = 0; bj < 2; ++bj) { const int h = 2 * u.pn + bj;
                    const f32x4 v0 = acc[ai][bj][m][0] * rs, v1 = acc[ai][bj][m][1] * rs;
                    if (wc < 2) { *(u32x4*)(Kn + (size_t)row * 512 + h * 64 + wc * 32 + 8 * fq) = pk16(v0, v1); }
                    else { bf16_t* vp = Vt + ((size_t)(b * 8 + h) * 64 + (wc - 2) * 32 + 8 * fq) * SEQ + tok;
#pragma unroll
                        for (int e = 0; e < 4; ++e) { vp[(size_t)e * SEQ] = f2bf(v0[e]); vp[(size_t)(4 + e) * SEQ] = f2bf(v1[e]); } } } }
    }
};
struct EpiBr { static constexpr bool PERM = true;
    const bf16_t* G; bf16_t* MX; int j;
    DI void operator()(AccRef acc, const pg8::Unit& u, int wr, int wc, int fr, int fq) const {
        const int row0 = u.pm * 256 + wr * 64 + fr, col0 = u.pn * 256 + wc * 32 + 8 * fq;
#pragma unroll
        for (int ai = 0; ai < 2; ++ai) {
            u32x4 gw[4][2], ow[4][2];
#pragma unroll
            for (int m = 0; m < 4; ++m)
#pragma unroll
                for (int bj = 0; bj < 2; ++bj) { const int row = row0 + ai * 128 + m * 16, col = col0 + bj * 128;
                    gw[m][bj] = *(const u32x4*)(G + (size_t)row * 3072 + j * 1024 + col);
                    ow[m][bj] = (j > 0) ? *(const u32x4*)(MX + (size_t)row * 1024 + col) : (u32x4){0u, 0u, 0u, 0u}; }
#pragma unroll
            for (int m = 0; m < 4; ++m)
#pragma unroll
                for (int bj = 0; bj < 2; ++bj) { const int row = row0 + ai * 128 + m * 16, col = col0 + bj * 128;
                    const u32x4 g4 = gw[m][bj], o4 = ow[m][bj];
                    f32x4 v0 = acc[ai][bj][m][0], v1 = acc[ai][bj][m][1];
                    v0[0] = v0[0] * bflo(g4.x) + bflo(o4.x); v0[1] = v0[1] * bfhi(g4.x) + bfhi(o4.x); v0[2] = v0[2] * bflo(g4.y) + bflo(o4.y); v0[3] = v0[3] * bfhi(g4.y) + bfhi(o4.y);
                    v1[0] = v1[0] * bflo(g4.z) + bflo(o4.z); v1[1] = v1[1] * bfhi(g4.z) + bfhi(o4.z); v1[2] = v1[2] * bflo(g4.w) + bflo(o4.w); v1[3] = v1[3] * bfhi(g4.w) + bfhi(o4.w);
                    *(u32x4*)(MX + (size_t)row * 1024 + col) = pk16(v0, v1); }
        }
    }
};
struct EpiRes { static constexpr bool PERM = false;
    const float* xin; float* xout; bf16_t* xb; float* P;
    DI void operator()(AccRef acc, const pg8::Unit& u, int wr, int wc, int fr, int fq) const {
        const int row0 = u.pm * 256 + wr * 64 + fr, col0 = u.pn * 256 + wc * 32 + 4 * fq;
#pragma unroll
        for (int ai = 0; ai < 2; ++ai)
#pragma unroll
            for (int mh = 0; mh < 2; ++mh) {
                f32x4 xv[2][2][2];
#pragma unroll
                for (int mm = 0; mm < 2; ++mm)
#pragma unroll
                    for (int bj = 0; bj < 2; ++bj)
#pragma unroll
                        for (int n = 0; n < 2; ++n) xv[mm][bj][n] = *(const f32x4*)(xin + (size_t)(row0 + ai * 128 + (2 * mh + mm) * 16) * 1024 + col0 + bj * 128 + n * 16);
#pragma unroll
                for (int mm = 0; mm < 2; ++mm) { const int m = 2 * mh + mm; const int row = row0 + ai * 128 + m * 16; float s = 0.f;
#pragma unroll
                    for (int bj = 0; bj < 2; ++bj)
#pragma unroll
                        for (int n = 0; n < 2; ++n) { const size_t off = (size_t)row * 1024 + col0 + bj * 128 + n * 16;
                            const f32x4 xo = xv[mm][bj][n] + acc[ai][bj][m][n];
                            *(f32x4*)(xout + off) = xo; *(u32x2*)(xb + off) = pk8(xo); s += dot4(xo); }
                    s += __shfl_xor(s, 16); s += __shfl_xor(s, 32);
                    if (fq == 0) P[(size_t)row * 16 + u.pn * 4 + wc] = s; }
            }
    }
};
struct EpiKVm { static constexpr bool PERM = true;
    const float* mrstd; bf16_t* Km; bf16_t* Vmt;
    DI void operator()(AccRef acc, const pg8::Unit& u, int wr, int wc, int fr, int fq) const {
        const int row0 = u.pm * 256 + wr * 64 + fr;
#pragma unroll
        for (int ai = 0; ai < 2; ++ai)
#pragma unroll
            for (int m = 0; m < 4; ++m) { const int row = row0 + ai * 128 + m * 16; const float rs = mrstd[row];
                const int b = row >> 8, key = row & 255;
#pragma unroll
                for (int bj = 0; bj < 2; ++bj) { const f32x4 v0 = acc[ai][bj][m][0] * rs, v1 = acc[ai][bj][m][1] * rs;
                    const int c = u.pn * 256 + bj * 128 + wc * 32 + 8 * fq;
                    if (u.pn < 4) { *(u32x4*)(Km + (size_t)row * 1024 + c) = pk16(v0, v1); }
                    else { const int c2 = c - 1024, h = c2 >> 8, dv = c2 & 255;
                        bf16_t* vp = Vmt + ((size_t)(b * 4 + h) * 256 + dv) * 256 + key;
#pragma unroll
                        for (int e = 0; e < 4; ++e) { vp[e * 256] = f2bf(v0[e]); vp[(4 + e) * 256] = f2bf(v1[e]); } } } }
    }
};
struct EpiFF { static constexpr bool PERM = true;
    const float* P; bf16_t* ACT;
    DI void operator()(AccRef acc, const pg8::Unit& u, int wr, int wc, int fr, int fq) const {
        const int row0 = u.pm * 256 + wr * 64 + fr;
        float rsv[2][4];
#pragma unroll
        for (int ai = 0; ai < 2; ++ai)
#pragma unroll
            for (int m = 0; m < 4; ++m) rsv[ai][m] = rsqrtf(row_ssq_q(P, 16, 4, row0 + ai * 128 + m * 16, fq) * (1.0f / 1024.0f) + EPS);
#pragma unroll
        for (int ai = 0; ai < 2; ++ai)
#pragma unroll
            for (int m = 0; m < 4; ++m) { const int row = row0 + ai * 128 + m * 16; const float rs = rsv[ai][m];
                f32x4 a0, a1;
                const f32x4 g0 = acc[ai][0][m][0] * rs, g1 = acc[ai][0][m][1] * rs, u0 = acc[ai][1][m][0] * rs, u1 = acc[ai][1][m][1] * rs;
#pragma unroll
                for (int e = 0; e < 4; ++e) { float sa, sb; sigm2(g0[e], g1[e], sa, sb); a0[e] = g0[e] * sa * u0[e]; a1[e] = g1[e] * sb * u1[e]; }
                *(u32x4*)(ACT + (size_t)row * DFF + 128 * u.pn + 32 * wc + 8 * fq) = pk16(a0, a1); }
    }
};

DI int srccol(int mode, int np) {
    if (mode == 1) return np < 672 ? np : (np < 768 ? -1 : np - 96);
    if (mode == 2) { const int T = np >> 8, half = (np >> 7) & 1, j = np & 127; return half * DFF + 128 * T + j; }
    return np;
}
DI void conv_item(const float* W, int K, int N, int Np, int mode, const float* gain, bf16_t* WT, LAS float* scr, int item, int lane) {
    const int nblk = Np / 64, kb = item / nblk, nb = item % nblk, k0 = 64 * kb, n0 = 64 * nb;
    const int r = lane >> 4, c4 = (lane & 15) * 4;
    const int sc = srccol(mode, n0 + c4);
    f32x4 v[16];
#pragma unroll
    for (int i = 0; i < 16; ++i) v[i] = (sc >= 0) ? *(const f32x4*)(W + (size_t)(k0 + 4 * i + r) * N + sc) : (f32x4){0.f, 0.f, 0.f, 0.f};
#pragma unroll
    for (int i = 0; i < 16; ++i) { const int row = 4 * i + r; const float gn = gain ? gain[k0 + row] : 1.0f; LAS float* d = scr + row * 65 + c4;
        d[0] = v[i][0] * gn; d[1] = v[i][1] * gn; d[2] = v[i][2] * gn; d[3] = v[i][3] * gn; }
    asm volatile("s_waitcnt lgkmcnt(0)" ::: "memory");
    const int c = lane & 7;
#pragma unroll
    for (int jj = 0; jj < 8; ++jj) { const int n = (lane >> 3) + 8 * jj; const LAS float* sp = scr + (8 * c) * 65 + n;
        u32x4 o; o.x = cvt_pk(sp[0 * 65], sp[1 * 65]); o.y = cvt_pk(sp[2 * 65], sp[3 * 65]); o.z = cvt_pk(sp[4 * 65], sp[5 * 65]); o.w = cvt_pk(sp[6 * 65], sp[7 * 65]);
        *(u32x4*)(WT + (size_t)(n0 + n) * K + k0 + 8 * c) = o; }
    asm volatile("s_waitcnt lgkmcnt(0)" ::: "memory");
}

DI void attn_unit(LAS unsigned char* lds, const bf16_t* Q, const bf16_t* Kn, const bf16_t* Kr, const bf16_t* Vt, bf16_t* Oa, int b, int h, int qb, int wv) {
    const int tid = otid(wv), lane = tid & 63, w = wv, l32 = lane & 31, hi = lane >> 5;
    constexpr int KST = 208, VST = 264, KBUF = 128 * KST, VBUF = 64 * VST, VOFF = 2 * KBUF;
    const size_t rowb = (size_t)b * SEQ;
    const int qrow = qb * 256 + 32 * w + l32;
    bf16x8 qf[6];
#pragma unroll
    for (int ks = 0; ks < 6; ++ks) qf[ks] = *(const bf16x8*)(Q + (rowb + qrow) * 768 + h * 96 + 16 * ks + 8 * hi);
    f32x16 o0, o1;
#pragma unroll
    for (int r = 0; r < 16; ++r) { o0[r] = 0.f; o1[r] = 0.f; }
    float mrun = -INFINITY, lrun = 0.f;
    const int NT = 2 * qb + 2, tlast = 2 * qb + (w >> 2);
    const int kkey = tid >> 3, kch = tid & 7, rkey = tid >> 2, rch = tid & 3, vdv = tid >> 4, vch = tid & 15;
    const bf16_t* gK = Kn + (rowb + kkey) * 512 + h * 64 + kch * 8;
    const bf16_t* gR = Kr + (rowb + rkey) * 32 + rch * 8;
    const bf16_t* gV = Vt + ((size_t)(b * 8 + h) * 64 + vdv) * SEQ + vch * 8;
    u32x4 rk0, rk1, rr, rv0, rv1;
#define ATT_LOAD(t) do { rk0 = *(const u32x4*)(gK + (size_t)(t) * 128 * 512); rk1 = *(const u32x4*)(gK + (size_t)(t) * 128 * 512 + 64 * 512); \
        rr = *(const u32x4*)(gR + (size_t)(t) * 128 * 32); rv0 = *(const u32x4*)(gV + (size_t)(t) * 128); rv1 = *(const u32x4*)(gV + (size_t)(t) * 128 + (size_t)32 * SEQ); } while (0)
#define ATT_STORE(kd, vd) do { *(LAS u32x4*)((kd) + kkey * KST + kch * 16) = rk0; *(LAS u32x4*)((kd) + (64 + kkey) * KST + kch * 16) = rk1; \
        *(LAS u32x4*)((kd) + rkey * KST + 128 + rch * 16) = rr; \
        *(LAS u32x2*)((vd) + vdv * VST + vch * 16) = (u32x2){rv0.x, rv0.y}; *(LAS u32x2*)((vd) + vdv * VST + vch * 16 + 8) = (u32x2){rv0.z, rv0.w}; \
        *(LAS u32x2*)((vd) + (32 + vdv) * VST + vch * 16) = (u32x2){rv1.x, rv1.y}; *(LAS u32x2*)((vd) + (32 + vdv) * VST + vch * 16 + 8) = (u32x2){rv1.z, rv1.w}; } while (0)
    ATT_LOAD(0);
    ATT_STORE(lds, lds + VOFF);
    __syncthreads();
#pragma unroll
    for (int ks = 0; ks < 6; ++ks) asm volatile("" : "+v"(qf[ks]));
    for (int t = 0; t < NT; ++t) {
        const int cur = t & 1;
        if (t + 1 < NT) ATT_LOAD(t + 1);
        if (t <= tlast) {
            const LAS unsigned char* kb_ = lds + cur * KBUF;
            const LAS unsigned char* vb_ = lds + VOFF + cur * VBUF;
            f32x16 s[4];
#pragma unroll
            for (int kb = 0; kb < 4; ++kb)
#pragma unroll
                for (int r = 0; r < 16; ++r) s[kb][r] = 0.f;
            bf16x8 ka[2][4];
            u32x2 vl[2][2], vh[2][2];
#pragma unroll
            for (int kb = 0; kb < 4; ++kb) ka[0][kb] = *(const LAS bf16x8*)(kb_ + (32 * kb + l32) * KST + (8 * hi) * 2);
            __builtin_amdgcn_sched_barrier(0);
#pragma unroll
            for (int ks = 0; ks < 6; ++ks) {
                if (ks + 1 < 6) {
#pragma unroll
                    for (int kb = 0; kb < 4; ++kb) ka[(ks + 1) & 1][kb] = *(const LAS bf16x8*)(kb_ + (32 * kb + l32) * KST + (16 * (ks + 1) + 8 * hi) * 2);
                } else {
                    vl[0][0] = *(const LAS u32x2*)(vb_ + l32 * VST + (4 * hi) * 2); vh[0][0] = *(const LAS u32x2*)(vb_ + l32 * VST + (4 * hi) * 2 + 16);
                    vl[0][1] = *(const LAS u32x2*)(vb_ + (32 + l32) * VST + (4 * hi) * 2); vh[0][1] = *(const LAS u32x2*)(vb_ + (32 + l32) * VST + (4 * hi) * 2 + 16);
                }
                __builtin_amdgcn_sched_barrier(0);
#pragma unroll
                for (int kb = 0; kb < 4; ++kb) s[kb] = MFMA32(ka[ks & 1][kb], qf[ks], s[kb]);
                __builtin_amdgcn_sched_barrier(0);
            }
            if (t == tlast) {
#pragma unroll
                for (int kb = 0; kb < 4; ++kb)
#pragma unroll
                    for (int r = 0; r < 16; ++r) { const int key = 128 * t + 32 * kb + crow(r, hi); if (key > qrow) s[kb][r] = -INFINITY; }
            }
            float mx = fmaxf(fmaxf(s[0][0], s[1][0]), fmaxf(s[2][0], s[3][0]));
#pragma unroll
            for (int r = 1; r < 16; ++r) mx = fmaxf(mx, fmaxf(fmaxf(s[0][r], s[1][r]), fmaxf(s[2][r], s[3][r])));
            mx = fmaxf(mx, __shfl_xor(mx, 32));
            const float mnew = fmaxf(mrun, mx);
            if (__builtin_amdgcn_ballot_w64(mnew > mrun) != 0ull) {
                const float alpha = __builtin_amdgcn_exp2f(mrun - mnew);
                mrun = mnew; lrun *= alpha;
#pragma unroll
                for (int r = 0; r < 16; ++r) { o0[r] *= alpha; o1[r] *= alpha; }
            }
            const f32x2 m2 = {mrun, mrun};
            f32x2 ps2 = {0.f, 0.f};
#pragma unroll
            for (int kb = 0; kb < 4; ++kb)
#pragma unroll
                for (int r = 0; r < 16; r += 2) { f32x2 v = {s[kb][r], s[kb][r + 1]}; v = v - m2;
                    v.x = __builtin_amdgcn_exp2f(v.x); v.y = __builtin_amdgcn_exp2f(v.y); ps2 = ps2 + v; s[kb][r] = v.x; s[kb][r + 1] = v.y; }
            lrun += ps2.x + ps2.y;
#pragma unroll
            for (int j = 0; j < 8; ++j) {
                const int kb = j >> 1, sub = j & 1;
                if (j + 1 < 8) {
                    const int koffn = (32 * ((j + 1) >> 1) + 16 * ((j + 1) & 1) + 4 * hi) * 2;
                    vl[(j + 1) & 1][0] = *(const LAS u32x2*)(vb_ + l32 * VST + koffn); vh[(j + 1) & 1][0] = *(const LAS u32x2*)(vb_ + l32 * VST + koffn + 16);
                    vl[(j + 1) & 1][1] = *(const LAS u32x2*)(vb_ + (32 + l32) * VST + koffn); vh[(j + 1) & 1][1] = *(const LAS u32x2*)(vb_ + (32 + l32) * VST + koffn + 16);
                }
                const bf16x8 P = pack8(s[kb][8 * sub + 0], s[kb][8 * sub + 1], s[kb][8 * sub + 2], s[kb][8 * sub + 3], s[kb][8 * sub + 4], s[kb][8 * sub + 5], s[kb][8 * sub + 6], s[kb][8 * sub + 7]);
                __builtin_amdgcn_sched_barrier(0);
                o0 = MFMA32(mk8(vl[j & 1][0], vh[j & 1][0]), P, o0); o1 = MFMA32(mk8(vl[j & 1][1], vh[j & 1][1]), P, o1);
                __builtin_amdgcn_sched_barrier(0);
            }
        }
        if (t + 1 < NT) ATT_STORE(lds + (cur ^ 1) * KBUF, lds + VOFF + (cur ^ 1) * VBUF);
        __syncthreads();
    }
#undef ATT_LOAD
#undef ATT_STORE
    const float lt = lrun + __shfl_xor(lrun, 32);
    const float inv = 1.0f / lt;
    bf16_t* op = Oa + (rowb + qrow) * 512 + h * 64;
#pragma unroll
    for (int g = 0; g < 4; ++g) {
        u32x2 w0, w1;
        w0.x = cvt_pk(o0[4 * g] * inv, o0[4 * g + 1] * inv); w0.y = cvt_pk(o0[4 * g + 2] * inv, o0[4 * g + 3] * inv);
        w1.x = cvt_pk(o1[4 * g] * inv, o1[4 * g + 1] * inv); w1.y = cvt_pk(o1[4 * g + 2] * inv, o1[4 * g + 3] * inv);
        *(u32x2*)(op + 8 * g + 4 * hi) = w0; *(u32x2*)(op + 32 + 8 * g + 4 * hi) = w1;
    }
}

DI void xattn_unit(LAS unsigned char* lds, bf16_t* QX, const bf16_t* Km, const bf16_t* Vmt, int b, int h, int qb, int wv) {
    const int tid = otid(wv), lane = tid & 63, w = __builtin_amdgcn_readfirstlane(tid >> 6), l32 = lane & 31, hi = lane >> 5;
    constexpr int KST = 272, VST = 520, BUF = 128 * KST;
    const size_t row = (size_t)b * SEQ + qb * 256 + 32 * w + l32;
    bf16_t* qp = QX + row * 1024 + h * 256;
    f32x16 sacc[8];
#pragma unroll
    for (int i = 0; i < 8; ++i)
#pragma unroll
        for (int r = 0; r < 16; ++r) sacc[i][r] = 0.f;
    unsigned pp[8][8];
    bf16x8 qf[8];
    u32x4 pf[4];
#define XLOAD(i) do { if ((i) < 4) { const int dh_ = (i) >> 1, kt_ = (i) & 1; \
        _Pragma("unroll") for (int j = 0; j < 4; ++j) { const int id = tid + 512 * j, key = id >> 4, ch = id & 15; \
            pf[j] = *(const u32x4*)(Km + ((size_t)(b * 256 + 128 * kt_ + key)) * 1024 + h * 256 + 128 * dh_ + 8 * ch); } } \
      else { const int c_ = (i) - 4; \
        _Pragma("unroll") for (int j = 0; j < 4; ++j) { const int id = tid + 512 * j, dv = id >> 5, ch = id & 31; \
            pf[j] = *(const u32x4*)(Vmt + ((size_t)((b * 4 + h) * 256 + 64 * c_ + dv)) * 256 + 8 * ch); } } } while (0)
#define XSTORE(i, bufp) do { if ((i) < 4) { \
        _Pragma("unroll") for (int j = 0; j < 4; ++j) { const int id = tid + 512 * j, key = id >> 4, ch = id & 15; *(LAS u32x4*)((bufp) + key * KST + ch * 16) = pf[j]; } } \
      else { \
        _Pragma("unroll") for (int j = 0; j < 4; ++j) { const int id = tid + 512 * j, dv = id >> 5, ch = id & 31; \
            *(LAS u32x2*)((bufp) + dv * VST + ch * 16) = (u32x2){pf[j].x, pf[j].y}; *(LAS u32x2*)((bufp) + dv * VST + ch * 16 + 8) = (u32x2){pf[j].z, pf[j].w}; } } } while (0)
    XLOAD(0); XSTORE(0, lds);
    __syncthreads();
#pragma unroll
    for (int i = 0; i < 8; ++i) {
        const LAS unsigned char* cb_ = lds + (i & 1) * BUF;
        if (i + 1 < 8) XLOAD(i + 1);
        if (i < 4) {
            const int dh = i >> 1, kt = i & 1;
            if (kt == 0) {
#pragma unroll
                for (int ks = 0; ks < 8; ++ks) qf[ks] = *(const bf16x8*)(qp + 128 * dh + 16 * ks + 8 * hi);
            }
#pragma unroll
            for (int ks = 0; ks < 8; ++ks) {
#pragma unroll
                for (int j = 0; j < 4; ++j) {
                    const bf16x8 a0 = *(const LAS bf16x8*)(cb_ + (32 * j + l32) * KST + (16 * ks + 8 * hi) * 2);
                    sacc[4 * kt + j] = MFMA32(a0, qf[ks], sacc[4 * kt + j]);
                }
            }
            if (i == 3) {
                float mx = sacc[0][0];
#pragma unroll
                for (int j = 0; j < 8; ++j)
#pragma unroll
                    for (int r = 0; r < 16; ++r) mx = fmaxf(mx, sacc[j][r]);
                mx = fmaxf(mx, __shfl_xor(mx, 32));
                float ps = 0.f;
#pragma unroll
                for (int j = 0; j < 8; ++j)
#pragma unroll
                    for (int r = 0; r < 16; ++r) { sacc[j][r] = __builtin_amdgcn_exp2f(sacc[j][r] - mx); ps += sacc[j][r]; }
                ps += __shfl_xor(ps, 32);
                const float inv = 1.0f / ps;
#pragma unroll
                for (int j = 0; j < 8; ++j)
#pragma unroll
                    for (int r2 = 0; r2 < 8; ++r2) pp[j][r2] = cvt_pk(sacc[j][2 * r2] * inv, sacc[j][2 * r2 + 1] * inv);
            }
        } else {
            const int c = i - 4;
            f32x16 o0, o1;
#pragma unroll
            for (int r = 0; r < 16; ++r) { o0[r] = 0.f; o1[r] = 0.f; }
#pragma unroll
            for (int s = 0; s < 16; ++s) {
                const int kb = s >> 1, sub = s & 1;
                const u32x4 pw = {pp[kb][4 * sub], pp[kb][4 * sub + 1], pp[kb][4 * sub + 2], pp[kb][4 * sub + 3]};
                const bf16x8 P = __builtin_bit_cast(bf16x8, pw);
                const int koff = (32 * kb + 16 * sub + 4 * hi) * 2;
                const u32x2 a0l = *(const LAS u32x2*)(cb_ + l32 * VST + koff), a0h = *(const LAS u32x2*)(cb_ + l32 * VST + koff + 16);
                const u32x2 a1l = *(const LAS u32x2*)(cb_ + (32 + l32) * VST + koff), a1h = *(const LAS u32x2*)(cb_ + (32 + l32) * VST + koff + 16);
                o0 = MFMA32(mk8(a0l, a0h), P, o0); o1 = MFMA32(mk8(a1l, a1h), P, o1);
            }
#pragma unroll
            for (int g = 0; g < 4; ++g) {
                u32x2 w0, w1;
                w0.x = cvt_pk(o0[4 * g], o0[4 * g + 1]); w0.y = cvt_pk(o0[4 * g + 2], o0[4 * g + 3]);
                w1.x = cvt_pk(o1[4 * g], o1[4 * g + 1]); w1.y = cvt_pk(o1[4 * g + 2], o1[4 * g + 3]);
                *(u32x2*)(qp + 64 * c + 8 * g + 4 * hi) = w0; *(u32x2*)(qp + 64 * c + 32 + 8 * g + 4 * hi) = w1;
            }
        }
        if (i + 1 < 8) XSTORE(i + 1, lds + ((i + 1) & 1) * BUF);
        __syncthreads();
    }
#undef XLOAD
#undef XSTORE
}

DI void memkv_tile(LAS unsigned char* lds, const bf16_t* memb, const bf16_t* Wt, const float* mrstd, bf16_t* Km, bf16_t* Vmt, int tile, int wv) {
    const int tid = otid(wv), lane = tid & 63, w = wv, l32 = lane & 31, hi = lane >> 5;
    const int r0 = (tile >> 5) * 64, c0 = (tile & 31) * 64;
    f32x16 acc[2][2];
#pragma unroll
    for (int i = 0; i < 2; ++i)
#pragma unroll
        for (int j = 0; j < 2; ++j)
#pragma unroll
            for (int r = 0; r < 16; ++r) acc[i][j][r] = 0.f;
    const bf16_t* ap = memb + (size_t)(r0 + l32) * 1024 + 128 * w + 8 * hi;
    const bf16_t* bp = Wt + (size_t)(c0 + l32) * 1024 + 128 * w + 8 * hi;
#pragma unroll
    for (int ks = 0; ks < 8; ++ks) {
        const bf16x8 a0 = *(const bf16x8*)(ap + 16 * ks), a1 = *(const bf16x8*)(ap + 32 * 1024 + 16 * ks);
        const bf16x8 b0 = *(const bf16x8*)(bp + 16 * ks), b1 = *(const bf16x8*)(bp + 32 * 1024 + 16 * ks);
        acc[0][0] = MFMA32(b0, a0, acc[0][0]); acc[0][1] = MFMA32(b1, a0, acc[0][1]);
        acc[1][0] = MFMA32(b0, a1, acc[1][0]); acc[1][1] = MFMA32(b1, a1, acc[1][1]);
    }
    LAS float* red = (LAS float*)lds;
#pragma unroll
    for (int i = 0; i < 2; ++i)
#pragma unroll
        for (int j = 0; j < 2; ++j)
#pragma unroll
            for (int r = 0; r < 16; ++r) red[((w * 4 + i * 2 + j) * 16 + r) * 64 + lane] = acc[i][j][r];
    LBAR();
#pragma unroll
    for (int q = 0; q < 8; ++q) {
        const int idx = tid + 512 * q, ln = idx & 63, r = (idx >> 6) & 15, blk = idx >> 10;
        float s = 0.f;
#pragma unroll
        for (int ww = 0; ww < 8; ++ww) s += red[ww * 4096 + idx];
        const int i = blk >> 1, j = blk & 1;
        const int col = c0 + 32 * j + crow(r, ln >> 5), row = r0 + 32 * i + (ln & 31);
        const float val = s * mrstd[row];
        if (col < 1024) Km[(size_t)row * 1024 + col] = f2bf(val);
        else { const int c2 = col - 1024, h = c2 >> 8, dv = c2 & 255, b = row >> 8, key = row & 255; Vmt[((size_t)(b * 4 + h) * 256 + dv) * 256 + key] = f2bf(val); }
    }
    LBAR();
}

DI void gmlp_unit(LAS unsigned char* lds, bf16_t* zC, const float* ln_g, const float* ln_b, const float* w_s, const float* b_s, int chunk, int gp, int wv) {
    const int tid = otid(wv), lane = tid & 63, w = __builtin_amdgcn_readfirstlane(tid >> 6), l32 = lane & 31, hi = lane >> 5;
    constexpr int VST = 272;
    const size_t row0 = (size_t)chunk * 128;
    LAS bf16_t* vnT = (LAS bf16_t*)lds;
    {
        f32x4 lg0, lg1, lb0, lb1;
        lg0 = *(const f32x4*)(ln_g + 8 * lane); lg1 = *(const f32x4*)(ln_g + 8 * lane + 4);
        lb0 = *(const f32x4*)(ln_b + 8 * lane); lb1 = *(const f32x4*)(ln_b + 8 * lane + 4);
        u32x4 rawv[16];
#pragma unroll
        for (int tt = 0; tt < 16; ++tt) rawv[tt] = *(const u32x4*)(zC + (row0 + 16 * w + tt) * 1024 + 512 + 8 * lane);
#pragma unroll
        for (int tt = 0; tt < 16; ++tt) {
            const int t = 16 * w + tt;
            const u32x4 raw = rawv[tt];
            float x[8];
            x[0] = gelu_erf(bflo(raw.x)); x[1] = gelu_erf(bfhi(raw.x)); x[2] = gelu_erf(bflo(raw.y)); x[3] = gelu_erf(bfhi(raw.y));
            x[4] = gelu_erf(bflo(raw.z)); x[5] = gelu_erf(bfhi(raw.z)); x[6] = gelu_erf(bflo(raw.w)); x[7] = gelu_erf(bfhi(raw.w));
            float s = 0.f;
#pragma unroll
            for (int e = 0; e < 8; ++e) s += x[e];
            const float mean = wave_sum(s) * (1.0f / 512.0f);
            float q = 0.f;
#pragma unroll
            for (int e = 0; e < 8; ++e) { x[e] -= mean; q += x[e] * x[e]; }
            const float rstd = rsqrtf(wave_sum(q) * (1.0f / 512.0f) + EPS);
            if ((lane >> 5) == gp) {
                const int cl = 8 * (lane & 15) + 128 * ((lane >> 4) & 1);
                vnT[(cl + 0) * (VST / 2) + t] = f2bf(x[0] * rstd * lg0[0] + lb0[0]); vnT[(cl + 1) * (VST / 2) + t] = f2bf(x[1] * rstd * lg0[1] + lb0[1]);
                vnT[(cl + 2) * (VST / 2) + t] = f2bf(x[2] * rstd * lg0[2] + lb0[2]); vnT[(cl + 3) * (VST / 2) + t] = f2bf(x[3] * rstd * lg0[3] + lb0[3]);
                vnT[(cl + 4) * (VST / 2) + t] = f2bf(x[4] * rstd * lg1[0] + lb1[0]); vnT[(cl + 5) * (VST / 2) + t] = f2bf(x[5] * rstd * lg1[1] + lb1[1]);
                vnT[(cl + 6) * (VST / 2) + t] = f2bf(x[6] * rstd * lg1[2] + lb1[2]); vnT[(cl + 7) * (VST / 2) + t] = f2bf(x[7] * rstd * lg1[3] + lb1[3]);
            }
        }
    }
    LBAR();
#pragma unroll 1
    for (int gl = 0; gl < 2; ++gl) {
        const int g = 2 * gp + gl; const LAS unsigned char* vb_ = lds + gl * 128 * VST;
        const int tb = w >> 1, cb0 = 2 * (w & 1);
        f32x16 a0, a1;
#pragma unroll
        for (int r = 0; r < 16; ++r) { a0[r] = 0.f; a1[r] = 0.f; }
        const int trow = 32 * tb + l32;
        const float* wrow = w_s + ((size_t)(g * 128 + trow)) * 128;
        f32x4 wq0[8], wq1[8];
#pragma unroll
        for (int ks = 0; ks < 8; ++ks) { wq0[ks] = (f32x4){0.f, 0.f, 0.f, 0.f}; wq1[ks] = wq0[ks];
            if (ks <= 2 * tb + 1) { wq0[ks] = *(const f32x4*)(wrow + 16 * ks + 8 * hi); wq1[ks] = *(const f32x4*)(wrow + 16 * ks + 8 * hi + 4); } }
#pragma unroll
        for (int ks = 0; ks < 8; ++ks) {
            if (ks > 2 * tb + 1) break;
            const int s0 = 16 * ks + 8 * hi;
            f32x4 w0 = wq0[ks], w1 = wq1[ks];
#pragma unroll
            for (int e = 0; e < 4; ++e) { if (s0 + e > trow) w0[e] = 0.f; if (s0 + 4 + e > trow) w1[e] = 0.f; }
            const bf16x8 A = pack8(w0[0], w0[1], w0[2], w0[3], w1[0], w1[1], w1[2], w1[3]);
            const bf16x8 B0 = *(const LAS bf16x8*)(vb_ + (32 * cb0 + l32) * VST + s0 * 2);
            const bf16x8 B1 = *(const LAS bf16x8*)(vb_ + (32 * (cb0 + 1) + l32) * VST + s0 * 2);
            a0 = MFMA32(A, B0, a0); a1 = MFMA32(A, B1, a1);
        }
#pragma unroll
        for (int r = 0; r < 16; ++r) {
            const int t = 32 * tb + crow(r, hi);
            const float bs = b_s[g * 128 + t];
            bf16_t* up0 = zC + (row0 + t) * 1024 + g * 128 + 32 * cb0 + l32;
            const float u0 = gelu_erf(bf2f(up0[0])), u1 = gelu_erf(bf2f(up0[32]));
            up0[0] = f2bf((a0[r] + bs) * u0); up0[32] = f2bf((a1[r] + bs) * u1);
        }
    }
    LBAR();
}

#define HG_IDS() \
    const int k = tid & 127, seg = tid >> 7; \
    const size_t row0 = (size_t)b * SEQ + (size_t)c * 64 + 16 * seg; \
    bf16_t hfr[16], vrw[16]; \
    _Pragma("unroll") for (int i = 0; i < 16; ++i) { hfr[i] = zB[(row0 + i) * 2048 + 512 + h * 128 + k]; vrw[i] = zB[(row0 + i) * 2048 + 1024 + h * 128 + k]; }
#define HG_PREP() \
    float cum[16], kv[16]; float bref, blast; \
    { const float lb = lbv[h * 128 + k]; float run = 0.f; \
      _Pragma("unroll") for (int i = 0; i < 16; ++i) { const float fr_ = bf2f(hfr[i]); \
          const float e_ = __expf(-fr_), sg_ = __builtin_amdgcn_rcpf(1.f + e_); const float f_ = lb + (1.f - lb) * sg_; \
          run += __logf(f_); cum[i] = run; kv[i] = (1.f - lb) * e_ * sg_; } \
      segs[seg * 128 + k] = run; LBAR(); \
      const float s0_ = segs[k], s1_ = segs[128 + k], s2_ = segs[256 + k], s3_ = segs[384 + k]; \
      const float off_ = (seg > 0 ? s0_ : 0.f) + (seg > 1 ? s1_ : 0.f) + (seg > 2 ? s2_ : 0.f); \
      bref = s0_ + s1_; blast = (s0_ + s1_) + (s2_ + s3_); \
      _Pragma("unroll") for (int i = 0; i < 16; ++i) cum[i] += off_; }

constexpr int HG_QR = 0, HG_KR = 17408, HG_QD = 34816, HG_VT = 52224, HG_KDT = 70656, HG_SEG = 89088, HG_SSL = 91136;

DI void hg_u_unit(LAS unsigned char* lds, const bf16_t* zB, const float* lbv, bf16_t* ST, float* dC, int b, int h, int c, int wv) {
    const int tid = otid(wv), lane = tid & 63, w = __builtin_amdgcn_readfirstlane(tid >> 6), l32 = lane & 31, hi = lane >> 5;
    LAS float* segs = (LAS float*)(lds + HG_SEG);
    HG_IDS();
    HG_PREP();
    const int unit = (b * 4 + h) * 128 + c;
    {
        float kd[16]; unsigned vr[8];
#pragma unroll
        for (int i = 0; i < 16; ++i) kd[i] = kv[i] * __expf(blast - cum[i]);
#pragma unroll
        for (int i = 0; i < 8; ++i) { const unsigned lo = vrw[2 * i], hi2 = vrw[2 * i + 1]; vr[i] = lo | (hi2 << 16); }
        LAS unsigned char* kp = lds + HG_KDT + k * 144 + seg * 32;
        *(LAS u32x4*)kp = (u32x4){cvt_pk(kd[0], kd[1]), cvt_pk(kd[2], kd[3]), cvt_pk(kd[4], kd[5]), cvt_pk(kd[6], kd[7])};
        *(LAS u32x4*)(kp + 16) = (u32x4){cvt_pk(kd[8], kd[9]), cvt_pk(kd[10], kd[11]), cvt_pk(kd[12], kd[13]), cvt_pk(kd[14], kd[15])};
        LAS unsigned char* vp = lds + HG_VT + k * 144 + seg * 32;
        *(LAS u32x4*)vp = (u32x4){vr[0], vr[1], vr[2], vr[3]};
        *(LAS u32x4*)(vp + 16) = (u32x4){vr[4], vr[5], vr[6], vr[7]};
        if (seg == 0) dC[(size_t)unit * 128 + k] = __expf(blast);
    }
    LBAR();
    {
        const int vb = w & 3;
#pragma unroll
        for (int kbi = 0; kbi < 2; ++kbi) {
            const int kb = 2 * (w >> 2) + kbi;
            f32x16 acc;
#pragma unroll
            for (int r = 0; r < 16; ++r) acc[r] = 0.f;
#pragma unroll
            for (int ks = 0; ks < 4; ++ks) {
                const bf16x8 A = *(const LAS bf16x8*)(lds + HG_VT + (32 * vb + l32) * 144 + (16 * ks + 8 * hi) * 2);
                const bf16x8 B = *(const LAS bf16x8*)(lds + HG_KDT + (32 * kb + l32) * 144 + (16 * ks + 8 * hi) * 2);
                acc = MFMA32(A, B, acc);
            }
            bf16_t* sp = ST + (size_t)unit * 16384 + 32 * kb + l32;
#pragma unroll
            for (int r = 0; r < 16; ++r) sp[(32 * vb + crow(r, hi)) * 128] = f2bf(acc[r]);
        }
    }
    LBAR();
}

DI void hg_out_unit(LAS unsigned char* lds, const bf16_t* zB, const float* lbv, const bf16_t* ST, const float* hnorm, bf16_t* Ob, int b, int h, int c, int wv) {
    const int tid = otid(wv), lane = tid & 63, w = __builtin_amdgcn_readfirstlane(tid >> 6), l32 = lane & 31, hi = lane >> 5;
    LAS float* segs = (LAS float*)(lds + HG_SEG);
    LAS float* ssl = (LAS float*)(lds + HG_SSL);
    HG_IDS();
    const int unit = (b * 4 + h) * 128 + c;
    const int vb = w & 3, tb = w >> 2;
    bf16_t hqr[16];
#pragma unroll
    for (int i = 0; i < 16; ++i) hqr[i] = zB[(row0 + i) * 2048 + h * 128 + k];
    bf16x8 stf[8];
    {
        const bf16_t* sp = ST + (size_t)unit * 16384 + (size_t)(32 * vb + l32) * 128 + 8 * hi;
#pragma unroll
        for (int ks = 0; ks < 8; ++ks) stf[ks] = *(const bf16x8*)(sp + 16 * ks);
    }
    u32x2 grw[4];
    {
        const size_t rowg = (size_t)b * SEQ + (size_t)c * 64 + 32 * tb + l32;
#pragma unroll
        for (int g = 0; g < 4; ++g) grw[g] = *(const u32x2*)(zB + rowg * 2048 + 1536 + h * 128 + 32 * vb + 8 * g + 4 * hi);
    }
    HG_PREP();
    {
        LAS bf16_t* Qr = (LAS bf16_t*)(lds + HG_QR); LAS bf16_t* Kr = (LAS bf16_t*)(lds + HG_KR); LAS bf16_t* Qd = (LAS bf16_t*)(lds + HG_QD);
        unsigned vr[8];
#pragma unroll
        for (int i = 0; i < 16; ++i) { const int t = 16 * seg + i;
            const float qraw = bf2f(hqr[i]); const float q = qraw * sigm(qraw);
            Qr[t * 136 + k] = f2bf(q * __expf(cum[i] - bref)); Kr[t * 136 + k] = f2bf(kv[i] * __expf(bref - cum[i])); Qd[t * 136 + k] = f2bf(q * __expf(cum[i])); }
#pragma unroll
        for (int i = 0; i < 8; ++i) { const unsigned lo = vrw[2 * i], hi2 = vrw[2 * i + 1]; vr[i] = lo | (hi2 << 16); }
        LAS unsigned char* vp = lds + HG_VT + k * 144 + seg * 32;
        *(LAS u32x4*)vp = (u32x4){vr[0], vr[1], vr[2], vr[3]};
        *(LAS u32x4*)(vp + 16) = (u32x4){vr[4], vr[5], vr[6], vr[7]};
    }
    LBAR();
    f32x16 o;
#pragma unroll
    for (int r = 0; r < 16; ++r) o[r] = 0.f;
    {
#pragma unroll
        for (int ks = 0; ks < 8; ++ks) {
            const bf16x8 A = stf[ks];
            const bf16x8 B = *(const LAS bf16x8*)(lds + HG_QD + (32 * tb + l32) * 272 + (16 * ks + 8 * hi) * 2);
            o = MFMA32(A, B, o);
        }
    }
#pragma unroll
    for (int sb = 0; sb < 2; ++sb) {
        if (sb <= tb) {
            f32x16 at;
#pragma unroll
            for (int r = 0; r < 16; ++r) at[r] = 0.f;
#pragma unroll
            for (int ks = 0; ks < 8; ++ks) {
                const bf16x8 A = *(const LAS bf16x8*)(lds + HG_KR + (32 * sb + l32) * 272 + (16 * ks + 8 * hi) * 2);
                const bf16x8 B = *(const LAS bf16x8*)(lds + HG_QR + (32 * tb + l32) * 272 + (16 * ks + 8 * hi) * 2);
                at = MFMA32(A, B, at);
            }
            if (sb == tb) {
#pragma unroll
                for (int r = 0; r < 16; ++r) if (crow(r, hi) > l32) at[r] = 0.f;
            }
#pragma unroll
            for (int sub = 0; sub < 2; ++sub) {
                const bf16x8 P = pack8(at[8 * sub + 0], at[8 * sub + 1], at[8 * sub + 2], at[8 * sub + 3], at[8 * sub + 4], at[8 * sub + 5], at[8 * sub + 6], at[8 * sub + 7]);
                const int koff = (32 * sb + 16 * sub + 4 * hi) * 2;
                const u32x2 al = *(const LAS u32x2*)(lds + HG_VT + (32 * vb + l32) * 144 + koff), ah = *(const LAS u32x2*)(lds + HG_VT + (32 * vb + l32) * 144 + koff + 16);
                o = MFMA32(mk8(al, ah), P, o);
            }
        }
    }
    float ss = 0.f;
#pragma unroll
    for (int r = 0; r < 16; ++r) ss += o[r] * o[r];
    ss += __shfl_xor(ss, 32);
    if (hi == 0) ssl[vb * 64 + 32 * tb + l32] = ss;
    LBAR();
    {
        const int t = 32 * tb + l32;
        const float tot = (ssl[t] + ssl[64 + t]) + (ssl[128 + t] + ssl[192 + t]);
        const float rstd = rsqrtf(tot * (1.0f / 128.0f) + EPS);
        const size_t row = (size_t)b * SEQ + (size_t)c * 64 + t;
#pragma unroll
        for (int g = 0; g < 4; ++g) {
            const int v0 = 32 * vb + 8 * g + 4 * hi;
            const u32x2 gr = grw[g];
            const f32x4 hn = *(const f32x4*)(hnorm + v0);
            const float g0 = bflo(gr.x), g1 = bfhi(gr.x), g2 = bflo(gr.y), g3 = bfhi(gr.y);
            u32x2 ow;
            ow.x = cvt_pk(o[4 * g] * rstd * hn[0] * (g0 * sigm(g0)), o[4 * g + 1] * rstd * hn[1] * (g1 * sigm(g1)));
            ow.y = cvt_pk(o[4 * g + 2] * rstd * hn[2] * (g2 * sigm(g2)), o[4 * g + 3] * rstd * hn[3] * (g3 * sigm(g3)));
            *(u32x2*)(Ob + row * 512 + h * 128 + v0) = ow;
        }
    }
    LBAR();
}


#define XB_TMO      128
#define XB_XCNT(j)  (256  + 64 * (j))
#define XB_XSUB(j)  (1280 + 64 * (j))
#define XB_XGEN(j)  (2304 + 64 * (j))
#define XB_TOP      3328
#define XB_TOPGEN   3392
#define XCD_BAR_WORDS 3456
#define XB_SPIN_CAP (1u << 18)
DI unsigned xb_ld(unsigned* p)              { return __hip_atomic_load(p, __ATOMIC_RELAXED, __HIP_MEMORY_SCOPE_AGENT); }
DI unsigned xb_add(unsigned* p, unsigned v) { return __hip_atomic_fetch_add(p, v, __ATOMIC_RELAXED, __HIP_MEMORY_SCOPE_AGENT); }
DI unsigned xb_xcc_id() { return (unsigned)__builtin_amdgcn_s_getreg((3 << 11) | 20) & 0xFu; }
#define XB_SPIN(cond, bar) do { unsigned _sp = 0; while (cond) { __builtin_amdgcn_s_sleep(1); \
    if ((++_sp & 255u) == 0u) { if (xb_ld(&(bar)[XB_TMO])) break; if (_sp > XB_SPIN_CAP) { atomicAdd(&(bar)[XB_TMO], 1u); break; } } } } while (0)
DI void xcd_barrier_complete(unsigned* bar, unsigned x, unsigned& nloc, unsigned& nx) {
    const unsigned G = gridDim.x * gridDim.y * gridDim.z;
    unsigned sum, cnt, mine, sp = 0u;
    for (;;) {
        sum = 0u; cnt = 0u; mine = 0u;
#pragma unroll
        for (unsigned j = 0; j < 16; ++j) { const unsigned c = xb_ld(&bar[XB_XCNT(j)]); sum += c; cnt += (c > 0u) ? 1u : 0u; mine = (j == x) ? c : mine; }
        if (sum == G) break;
        __builtin_amdgcn_s_sleep(1);
        if ((++sp & 255u) == 0u) { if (xb_ld(&bar[XB_TMO])) break; if (sp > XB_SPIN_CAP) { atomicAdd(&bar[XB_TMO], 1u); break; } }
    }
    nloc = mine > 0u ? mine : 1u; nx = cnt > 0u ? cnt : 1u;
}
DI void xcd_barrier(unsigned* bar, volatile LAS unsigned* st) {
    asm volatile("s_waitcnt vmcnt(0)" ::: "memory");
    __syncthreads();
    if (threadIdx.x == 0) {
        const unsigned x = xb_xcc_id();
        __builtin_amdgcn_s_waitcnt(0);
        unsigned nloc = st[0], nx = st[1];
        if (nloc == 0u) { xcd_barrier_complete(bar, x, nloc, nx); st[0] = nloc; st[1] = nx; }
        const unsigned old = xb_add(&bar[XB_XSUB(x)], 1u);
        const unsigned gen = old / nloc;
        if (old + 1u == (gen + 1u) * nloc) {
            __builtin_amdgcn_fence(__ATOMIC_RELEASE, "agent");
            asm volatile("s_waitcnt vmcnt(0)" ::: "memory");
            const unsigned og = xb_add(&bar[XB_TOP], 1u);
            const unsigned tg = og / nx;
            if (og + 1u == (tg + 1u) * nx) xb_add(&bar[XB_TOPGEN], 1u);
            else XB_SPIN(xb_ld(&bar[XB_TOPGEN]) == tg, bar);
            __builtin_amdgcn_fence(__ATOMIC_ACQUIRE, "agent");
            xb_add(&bar[XB_XGEN(x)], 1u);
            asm volatile("s_waitcnt vmcnt(0)" ::: "memory");
        } else {
            XB_SPIN(xb_ld(&bar[XB_XGEN(x)]) == gen, bar);
            __builtin_amdgcn_fence(__ATOMIC_ACQUIRE, "agent");
            asm volatile("s_waitcnt vmcnt(0)" ::: "memory");
        }
    }
    __syncthreads();
}

constexpr size_t MiB = 1u << 20;
constexpr size_t WS_X0 = 0, WS_R2 = 32 * MiB, WS_R3 = 96 * MiB, WS_X1 = 128 * MiB, WS_R1 = 160 * MiB, WS_R4 = 184 * MiB, WS_RW = 216 * MiB;
constexpr size_t WS_CTL = 250 * MiB + 512 * 1024, CTL_BYTES = 16384;
constexpr size_t WS_P = 241 * MiB, WS_PA = 242 * MiB, WS_CS = 244 * MiB, WS_DC = 246 * MiB, WS_MEMB = 247 * MiB, WS_KM = 248 * MiB, WS_VMT = 249 * MiB, WS_MISC = 250 * MiB, WS_END = 251 * MiB;
constexpr size_t W1_IN = 0, W1_UQ = W1_IN + (size_t)6912 * 1024, W1_UKV = W1_UQ + (size_t)768 * 384, W1_BA = W1_UKV + (size_t)1024 * 256, W1_BB = W1_BA + (size_t)1024 * 512,
                 W1_BC = W1_BB + (size_t)1024 * 512, W1_MIX = W1_BC + (size_t)1024 * 512, W1_END = W1_MIX + (size_t)1024 * 1024;
constexpr size_t W2_XQ = 0, W2_XKV = W2_XQ + (size_t)1024 * 1024, W2_XO = W2_XKV + (size_t)2048 * 1024, W2_FI = W2_XO + (size_t)1024 * 1024, W2_FO = W2_FI + (size_t)5632 * 1024, W2_END = W2_FO + (size_t)1024 * 2816;
static_assert(W1_END * 2 <= 25 * MiB && W2_END * 2 <= 25 * MiB, "weight region");

constexpr int LDS_BYTES = 147456;

struct Args { const float* in[28]; float* out; unsigned char* ws; };

constexpr int PTAB_OFF = 135168;
DI void* ldptr(LAS unsigned char* lds, int i) {
    unsigned off_ = PTAB_OFF + 8 * i; asm volatile("" : "+v"(off_));
    const LAS unsigned* t = (const LAS unsigned*)(lds + off_);
    const unsigned lo = __builtin_amdgcn_readfirstlane(t[0]), hi = __builtin_amdgcn_readfirstlane(t[1]);
    typedef __attribute__((address_space(1))) unsigned char* gptr_t;
    return (void*)(gptr_t)(((unsigned long long)hi << 32) | (unsigned long long)lo);
}
#define INP(i) ((const float*)ldptr(lds, (i)))
#define PH_HEAD() \
    int G = G0_, bid = bid0_; asm volatile("" : "+s"(G), "+s"(bid)); \
    int wv = wv0_; asm volatile("" : "+s"(wv)); const int tid = otid(wv), lane = tid & 63, wave = wv; \
    const int gw = bid * 8 + wave, NGW = G * 8; (void)lane; (void)gw; (void)NGW; \
    unsigned char* ws = (unsigned char*)ldptr(lds, 29); \
    bf16_t* const X0 = (bf16_t*)(ws + WS_X0); bf16_t* const X1 = (bf16_t*)(ws + WS_X1); \
    bf16_t* const R1 = (bf16_t*)(ws + WS_R1); bf16_t* const R2 = (bf16_t*)(ws + WS_R2); bf16_t* const R3 = (bf16_t*)(ws + WS_R3); bf16_t* const R4 = (bf16_t*)(ws + WS_R4); \
    bf16_t* const RW = (bf16_t*)(ws + WS_RW); \
    float* const P = (float*)(ws + WS_P); float* const PA = (float*)(ws + WS_PA); float* const CS = (float*)(ws + WS_CS); float* const dC = (float*)(ws + WS_DC); \
    bf16_t* const memb = (bf16_t*)(ws + WS_MEMB); bf16_t* const Km = (bf16_t*)(ws + WS_KM); bf16_t* const Vmt = (bf16_t*)(ws + WS_VMT); \
    float* const mrstd = (float*)(ws + WS_MISC); float* const lbv = mrstd + 512; \
    bf16_t* const xcur = par ? X1 : X0; bf16_t* const xfree = par ? X0 : X1; \
    bf16_t* const zA = R1; bf16_t* const zB = R2; bf16_t* const zC = R4; \
    bf16_t* const Qb = R3; bf16_t* const Krb = R3 + (size_t)MTOK * 768; \
    bf16_t* const Knb = xfree; bf16_t* const Vtb = xfree + (size_t)MTOK * 512; \
    bf16_t* const Oa = R1; bf16_t* const Ob = xfree; bf16_t* const STb = R3; bf16_t* const Gt = R2; bf16_t* const MX = xcur; \
    bf16_t* const QX = R2; bf16_t* const ACT = R2; float* const xres = (float*)ldptr(lds, 28); \
    (void)X0; (void)X1; (void)R1; (void)R2; (void)R3; (void)R4; (void)RW; (void)P; (void)PA; (void)CS; (void)dC; (void)memb; (void)Km; (void)Vmt; (void)mrstd; (void)lbv; \
    (void)xcur; (void)xfree; (void)zA; (void)zB; (void)zC; (void)Qb; (void)Krb; (void)Knb; (void)Vtb; (void)Oa; (void)Ob; (void)STb; (void)Gt; (void)MX; (void)QX; (void)ACT; (void)xres;

#ifdef TPROBE
#define TSTAMP(cls) do { if (blockIdx.x == 0 && threadIdx.x == 0) { LAS unsigned long long* tp_ = (LAS unsigned long long*)(lds + PTAB_OFF + 512); \
    const unsigned long long now_ = __builtin_amdgcn_s_memrealtime(); tp_[1 + (cls)] += now_ - tp_[0]; tp_[0] = now_; } } while (0)
#else
#define TSTAMP(cls) do { } while (0)
#endif
#define GSYNC() xcd_barrier((unsigned*)((unsigned char*)ldptr(lds, 29) + WS_CTL), (volatile LAS unsigned*)(lds + PTAB_OFF + 256))
__global__ void __launch_bounds__(512, 2) mega_fwd(Args args) {
    extern __shared__ __attribute__((aligned(16))) unsigned char lds_raw[];
    LAS unsigned char* lds = (LAS unsigned char*)lds_raw;
    cg::grid_group grid = cg::this_grid();
    const int G0_ = gridDim.x, bid0_ = blockIdx.x, wv0_ = __builtin_amdgcn_readfirstlane(threadIdx.x >> 6);
    int par = 0;
    if (threadIdx.x == 0) {
        LAS unsigned long long* pt = (LAS unsigned long long*)(lds + PTAB_OFF);
#pragma unroll
        for (int i = 0; i < 28; ++i) pt[i] = (unsigned long long)args.in[i];
        pt[28] = (unsigned long long)args.out; pt[29] = (unsigned long long)args.ws;
        pt[32] = 0ull;
#ifdef TPROBE
        for (int i = 0; i < 8; ++i) pt[64 + i] = 0ull; pt[64] = __builtin_amdgcn_s_memrealtime();
#endif
        (void)xb_add((unsigned*)(args.ws + WS_CTL) + XB_XCNT(xb_xcc_id()), 1u);
    }
    __syncthreads();

    for (int l = 0; l < 2; ++l) {
        {
            PH_HEAD();
            LAS float* scr = (LAS float*)(lds + wave * 16640);
            const float* w_in = INP(4) + (size_t)l * 1024 * INW; const float* mixn = INP(3) + l * 1024;
            const float* wuq = INP(6) + (size_t)l * 384 * 768; const float* qn = INP(5) + l * 384;
            const float* wukv = INP(8) + (size_t)l * 256 * 1024; const float* kvn = INP(7) + l * 256;
            const float* wba = INP(15) + (size_t)l * 512 * 1024; const float* wbb = INP(16) + (size_t)l * 512 * 1024; const float* wbc = INP(17) + (size_t)l * 512 * 1024;
            const float* wmx = INP(18) + (size_t)l * 1024 * 1024;
            constexpr int I_IN = 16 * 108, I_UQ = 6 * 12, I_UKV = 4 * 16, I_B = 8 * 16, I_MX = 16 * 16;
            constexpr int NIT = I_IN + I_UQ + I_UKV + 3 * I_B + I_MX;
            for (int it = gw; it < NIT; it += NGW) {
                int r = it;
                if (r < I_IN) { conv_item(w_in, 1024, INW, 6912, 1, mixn, RW + W1_IN, scr, r, lane); continue; } r -= I_IN;
                if (r < I_UQ) { conv_item(wuq, 384, 768, 768, 0, qn, RW + W1_UQ, scr, r, lane); continue; } r -= I_UQ;
                if (r < I_UKV) { conv_item(wukv, 256, 1024, 1024, 0, kvn, RW + W1_UKV, scr, r, lane); continue; } r -= I_UKV;
                if (r < I_B) { conv_item(wba, 512, 1024, 1024, 0, nullptr, RW + W1_BA, scr, r, lane); continue; } r -= I_B;
                if (r < I_B) { conv_item(wbb, 512, 1024, 1024, 0, nullptr, RW + W1_BB, scr, r, lane); continue; } r -= I_B;
                if (r < I_B) { conv_item(wbc, 512, 1024, 1024, 0, nullptr, RW + W1_BC, scr, r, lane); continue; } r -= I_B;
                conv_item(wmx, 1024, 1024, 1024, 0, nullptr, RW + W1_MIX, scr, r, lane);
            }
            if (l == 0) {
                const float* xin0 = INP(0);
                for (int m0 = 4 * gw; m0 < MTOK; m0 += 4 * NGW) {
                    f32x4 vv[4][4];
#pragma unroll
                    for (int q = 0; q < 4; ++q)
#pragma unroll
                        for (int j = 0; j < 4; ++j) vv[q][j] = ((const f32x4*)(xin0 + (size_t)(m0 + q) * 1024) + lane)[64 * j];
#pragma unroll
                    for (int q = 0; q < 4; ++q) { const int m = m0 + q; float s = 0.f;
                        unsigned long long* o8 = (unsigned long long*)(xcur + (size_t)m * 1024) + lane;
#pragma unroll
                        for (int j = 0; j < 4; ++j) { const f32x4 v = vv[q][j]; s += dot4(v); o8[64 * j] = (unsigned long long)cvt_pk(v.x, v.y) | ((unsigned long long)cvt_pk(v.z, v.w) << 32); }
                        s = wave_sum(s);
                        if (lane < 16) P[(size_t)m * 16 + lane] = (lane == 0) ? s : 0.f; }
                }
                for (int m = gw; m < NB * NMEM; m += NGW) {
                    const f32x4* xr = (const f32x4*)(INP(1) + (size_t)m * 1024) + lane; float s = 0.f;
                    unsigned long long* o8 = (unsigned long long*)(memb + (size_t)m * 1024) + lane;
#pragma unroll
                    for (int j = 0; j < 4; ++j) { const f32x4 v = xr[64 * j]; s += dot4(v); o8[64 * j] = (unsigned long long)cvt_pk(v.x, v.y) | ((unsigned long long)cvt_pk(v.z, v.w) << 32); }
                    s = wave_sum(s);
                    if (lane == 0) mrstd[m] = rsqrtf(s * (1.0f / 1024.0f) + EPS);
                }
                const int* pos = (const int*)INP(2);
                for (int idx = bid * 512 + tid; idx < MTOK * 16; idx += G * 512) {
                    const int row = idx >> 4, j = idx & 15;
                    const float invf = powf(10000.0f, -(float)(2 * j) / 32.0f);
                    const float ang = (float)pos[row] * invf;
                    double tt = (double)ang * 0.15915494309189535; tt -= rint(tt);
                    const float rv = (float)tt;
                    CS[(size_t)row * 32 + j] = __builtin_amdgcn_cosf(rv); CS[(size_t)row * 32 + 16 + j] = __builtin_amdgcn_sinf(rv);
                }
                for (int idx = bid * 512 + tid; idx < 512; idx += G * 512) {
                    const float p0 = INP(9)[idx], p1 = INP(9)[512 + idx];
                    lbv[idx] = 0.f; lbv[512 + idx] = 1.0f / (1.0f + expf(p0 - p1));
                }
            }
        }
        __syncthreads();
        if (l == 0) grid.sync(); else GSYNC();
        TSTAMP(0);
        {
            PH_HEAD();
            pg8::Gemm g{xcur, RW + W1_IN, MTOK, 3840, 1024, 1024, 1024}; pg8::StaticOrder S; S.init(MTOK, 3840, G, bid);
            EpiA E{P, zA, zB, zC, PA};
            pg8::gemm_phase<EpiA>(lds, g, S, E, wv);
        }
        GSYNC();
        TSTAMP(1);
        {
            PH_HEAD();
            for (int idx = bid * 512 + tid; idx < MTOK * 16; idx += G * 512) {
                const int row = idx >> 4, j = idx & 15;
                const float x1 = bf2f(zA[(size_t)row * 768 + 640 + j]), x2 = bf2f(zA[(size_t)row * 768 + 656 + j]);
                const float cs = CS[(size_t)row * 32 + j], sn = CS[(size_t)row * 32 + 16 + j];
                Krb[(size_t)row * 32 + j] = f2bf(x1 * cs - x2 * sn); Krb[(size_t)row * 32 + 16 + j] = f2bf(x1 * sn + x2 * cs);
            }
            { pg8::Gemm g{zA, RW + W1_UQ, MTOK, 768, 384, 768, 384}; pg8::StaticOrder S; S.init(MTOK, 768, G, bid);
              EpiQ E{PA, CS, Qb}; pg8::gemm_phase<EpiQ>(lds, g, S, E, wv); }
            { pg8::Gemm g{zA + 384, RW + W1_UKV, MTOK, 1024, 256, 768, 256}; pg8::StaticOrder S; S.init(MTOK, 1024, G, bid);
              EpiKV E{PA, Knb, Vtb}; pg8::gemm_phase<EpiKV>(lds, g, S, E, wv); }
        }
        __syncthreads();
        GSYNC();
        TSTAMP(1);
        {
            PH_HEAD();
            for (int item = bid; item < 256; item += G) {
                const int b = item >> 7, h = (item >> 4) & 7, s = item & 15;
                attn_unit(lds, Qb, Knb, Krb, Vtb, Oa, b, h, 31 - s, wv);
                attn_unit(lds, Qb, Knb, Krb, Vtb, Oa, b, h, s, wv);
            }
#ifdef TPROBE
            GSYNC(); TSTAMP(2);
#endif
            const float* lng = INP(11) + l * 512; const float* lnb = INP(12) + l * 512;
            const float* wsp = INP(13) + (size_t)l * 4 * 128 * 128; const float* bsp = INP(14) + l * 512;
            for (int u = bid; u < 256; u += G) gmlp_unit(lds, zC, lng, lnb, wsp, bsp, u >> 1, u & 1, wv);
        }
        GSYNC();
#ifdef TPROBE
        TSTAMP(5);
#else
        TSTAMP(2);
#endif
        {
            PH_HEAD();
            for (int u = bid; u < 1024; u += G) hg_u_unit(lds, zB, lbv + l * 512, STb, dC, u >> 9, (u >> 7) & 3, u & 127, wv);
        }
        GSYNC();
        TSTAMP(3);
        {
            PH_HEAD();
            if (tid < 256) {
                for (int p = bid * 256 + tid; p < 65536; p += G * 256) {
                    const int bh = p >> 13, e2 = p & 8191;
                    unsigned* sp = (unsigned*)STb + (size_t)bh * 128 * 8192 + e2;
                    const float* dp = dC + (size_t)bh * 128 * 128 + ((2 * e2) & 127);
                    float S0 = 0.f, S1 = 0.f;
                    for (int c0 = 0; c0 < 128; c0 += 32) {
                        unsigned uu[32]; f32x2 dd[32];
#pragma unroll
                        for (int i = 0; i < 32; ++i) { uu[i] = sp[(size_t)(c0 + i) * 8192]; dd[i] = *(const f32x2*)(dp + (size_t)(c0 + i) * 128); }
#pragma unroll
                        for (int i = 0; i < 32; ++i) { sp[(size_t)(c0 + i) * 8192] = cvt_pk(S0, S1); S0 = dd[i].x * S0 + bflo(uu[i]); S1 = dd[i].y * S1 + bfhi(uu[i]); }
                    }
                }
            }
        }
        GSYNC();
        TSTAMP(3);
        {
            PH_HEAD();
            for (int u = bid; u < 1024; u += G) hg_out_unit(lds, zB, lbv + l * 512, STb, INP(10) + l * 128, Ob, u >> 9, (u >> 7) & 3, u & 127, wv);
        }
        GSYNC();
        TSTAMP(3);
        {
            PH_HEAD();
            pg8::Gemm g{xcur, RW + W1_IN + (size_t)3840 * 1024, MTOK, 3072, 1024, 1024, 1024}; pg8::StaticOrder S; S.init(MTOK, 3072, G, bid);
            EpiPlain<true> E{P, Gt, 3072, 1.0f};
            pg8::gemm_phase<EpiPlain<true>>(lds, g, S, E, wv);
        }
        GSYNC();
        TSTAMP(1);
        {
            PH_HEAD();
            pg8::StaticOrder S; S.init(MTOK, 1024, G, bid);
            { pg8::Gemm g{Oa, RW + W1_BA, MTOK, 1024, 512, 512, 512}; EpiBr E{Gt, MX, 0}; pg8::gemm_phase<EpiBr>(lds, g, S, E, wv); }
            { pg8::Gemm g{Ob, RW + W1_BB, MTOK, 1024, 512, 512, 512}; EpiBr E{Gt, MX, 1}; pg8::gemm_phase<EpiBr>(lds, g, S, E, wv); }
            { pg8::Gemm g{zC, RW + W1_BC, MTOK, 1024, 512, 1024, 512}; EpiBr E{Gt, MX, 2}; pg8::gemm_phase<EpiBr>(lds, g, S, E, wv); }
        }
        GSYNC();
        TSTAMP(1);
        {
            PH_HEAD();
            pg8::Gemm g{MX, RW + W1_MIX, MTOK, 1024, 1024, 1024, 1024}; pg8::StaticOrder S; S.init(MTOK, 1024, G, bid);
            EpiRes E{l == 0 ? INP(0) : (const float*)xres, xres, xfree, P};
            pg8::gemm_phase<EpiRes>(lds, g, S, E, wv);
        }
        par ^= 1;
        GSYNC();
        TSTAMP(1);
        {
            PH_HEAD();
            LAS float* scr = (LAS float*)(lds + wave * 16640);
            const float* wxq = INP(21) + (size_t)l * 1024 * 1024; const float* xan = INP(19) + l * 1024;
            const float* wxkv = INP(22) + (size_t)l * 1024 * 2048; const float* memn = INP(20) + l * 1024;
            const float* wxo = INP(23) + (size_t)l * 1024 * 1024;
            const float* wfi = INP(25) + (size_t)l * 1024 * 2 * DFF; const float* ffn = INP(24) + l * 1024;
            const float* wfo = INP(26) + (size_t)l * DFF * 1024;
            constexpr int I_XQ = 16 * 16, I_XKV = 16 * 32, I_FI = 16 * 88, I_FO = 44 * 16;
            constexpr int NIT = 2 * I_XQ + I_XKV + I_FI + I_FO;
            for (int it = gw; it < NIT; it += NGW) {
                int r = it;
                if (r < I_XQ) { conv_item(wxq, 1024, 1024, 1024, 0, xan, RW + W2_XQ, scr, r, lane); continue; } r -= I_XQ;
                if (r < I_XKV) { conv_item(wxkv, 1024, 2048, 2048, 0, memn, RW + W2_XKV, scr, r, lane); continue; } r -= I_XKV;
                if (r < I_XQ) { conv_item(wxo, 1024, 1024, 1024, 0, nullptr, RW + W2_XO, scr, r, lane); continue; } r -= I_XQ;
                if (r < I_FI) { conv_item(wfi, 1024, 2 * DFF, 2 * DFF, 2, ffn, RW + W2_FI, scr, r, lane); continue; } r -= I_FI;
                conv_item(wfo, DFF, 1024, 1024, 0, nullptr, RW + W2_FO, scr, r, lane);
            }
        }
        __syncthreads();
        GSYNC();
        TSTAMP(0);
        {
            PH_HEAD();
            { pg8::Gemm g{xcur, RW + W2_XQ, MTOK, 1024, 1024, 1024, 1024}; pg8::StaticOrder S; S.init(MTOK, 1024, G, bid);
              EpiPlain<false> E{P, QX, 1024, XSC}; pg8::gemm_phase<EpiPlain<false>>(lds, g, S, E, wv); }
            for (int t = bid; t < 256; t += G) memkv_tile(lds, memb, RW + W2_XKV, mrstd, Km, Vmt, t, wv);
        }
        GSYNC();
        TSTAMP(1);
        {
            PH_HEAD();
            for (int u = bid; u < 256; u += G) xattn_unit(lds, QX, Km, Vmt, u >> 7, (u >> 5) & 3, u & 31, wv);
        }
        GSYNC();
        TSTAMP(4);
        {
            PH_HEAD();
            pg8::Gemm g{QX, RW + W2_XO, MTOK, 1024, 1024, 1024, 1024}; pg8::StaticOrder S; S.init(MTOK, 1024, G, bid);
            EpiRes E{xres, xres, xcur, P};
            pg8::gemm_phase<EpiRes>(lds, g, S, E, wv);
        }
        GSYNC();
        TSTAMP(1);
        {
            PH_HEAD();
            pg8::Gemm g{xcur, RW + W2_FI, MTOK, 2 * DFF, 1024, 1024, 1024}; pg8::StaticOrder S; S.init(MTOK, 2 * DFF, G, bid);
            EpiFF E{P, ACT};
            pg8::gemm_phase<EpiFF>(lds, g, S, E, wv);
        }
        GSYNC();
        TSTAMP(1);
        {
            PH_HEAD();
            pg8::Gemm g{ACT, RW + W2_FO, MTOK, 1024, DFF, DFF, DFF}; pg8::StaticOrder S; S.init(MTOK, 1024, G, bid);
            EpiRes E{xres, xres, xcur, P};
            pg8::gemm_phase<EpiRes>(lds, g, S, E, wv);
        }
        GSYNC();
        TSTAMP(1);
    }
    {
        PH_HEAD();
        const float* fn = INP(27);
        const f32x4* gp = (const f32x4*)fn + lane;
        f32x4 gg[4];
#pragma unroll
        for (int j = 0; j < 4; ++j) gg[j] = gp[64 * j];
        for (int m0 = 4 * gw; m0 < MTOK; m0 += 4 * NGW) {
            f32x4 vv[4][4]; float rs[4];
#pragma unroll
            for (int q = 0; q < 4; ++q) { rs[q] = row_rstd16(P, m0 + q);
#pragma unroll
                for (int j = 0; j < 4; ++j) vv[q][j] = ((const f32x4*)(xres + (size_t)(m0 + q) * 1024) + lane)[64 * j]; }
#pragma unroll
            for (int q = 0; q < 4; ++q)
#pragma unroll
                for (int j = 0; j < 4; ++j) ((f32x4*)(xres + (size_t)(m0 + q) * 1024) + lane)[64 * j] = vv[q][j] * rs[q] * gg[j];
        }
#ifdef TPROBE
        GSYNC(); TSTAMP(6);
        if (blockIdx.x == 0) {
            __syncthreads();
            LAS unsigned long long* tp_ = (LAS unsigned long long*)(lds + PTAB_OFF + 512);
            const float ta = (float)tp_[1 + TPA] * 0.01f, tb = (float)tp_[1 + TPB] * 0.01f;
            if (tid == 0) xres[0] = 10.0f * ta;
            for (int i = tid; i < 10000; i += 512) xres[16 + i] = tb;
        }
#endif
    }
}

extern "C" void kernel_launch(void* const* d_in, const int* in_sizes, int n_in, void* d_out, int out_size, void* d_ws, size_t ws_size, hipStream_t stream) {
    static int grid = 0;
    if (grid == 0) {
        if (n_in != 28 || out_size != MTOK * DM || ws_size < WS_END) { fprintf(stderr, "kernel_launch: unexpected problem (n_in %d out %d ws %zu)\n", n_in, out_size, ws_size); grid = -1; return; }
        int dev = 0, cus = 0, per_cu = 0;
        (void)hipGetDevice(&dev);
        (void)hipDeviceGetAttribute(&cus, hipDeviceAttributeMultiprocessorCount, dev);
        (void)hipFuncSetAttribute((const void*)mega_fwd, hipFuncAttributeMaxDynamicSharedMemorySize, LDS_BYTES);
        (void)hipOccupancyMaxActiveBlocksPerMultiprocessor(&per_cu, (const void*)mega_fwd, 512, LDS_BYTES);
        if (per_cu < 1 || cus < 1) { fprintf(stderr, "kernel_launch: occupancy query gave %d blocks/CU on %d CUs\n", per_cu, cus); grid = -1; return; }
        grid = cus;
    }
    if (grid < 0) return;
    (void)hipMemsetAsync((char*)d_ws + WS_CTL, 0, CTL_BYTES, stream);
    Args a{};
    for (int i = 0; i < 28; ++i) a.in[i] = (const float*)d_in[i];
    a.out = (float*)d_out; a.ws = (unsigned char*)d_ws;
    void* kargs[] = {&a};
    hipError_t e = hipLaunchCooperativeKernel((const void*)mega_fwd, dim3(grid), dim3(512), kargs, LDS_BYTES, stream);
    if (e != hipSuccess) fprintf(stderr, "cooperative launch failed: %s (grid %d)\n", hipGetErrorString(e), grid);
}
```
